# Optimizing an MI355X kernel written in HIP

```python
import math
import jax, jax.numpy as jnp
from jax import lax
import numpy as np

D_MODEL = 1024
BATCH = 32
SEQ = 2048
DEPTH = 4

N_MIXERS = 3
HEAD_DIM = 64
DIFF_HEADS = D_MODEL // (2 * HEAD_DIM)
GQA_HEADS = D_MODEL // HEAD_DIM
GQA_KV_HEADS = GQA_HEADS // 4
GRID_W = 64
WINDOW = 128
Q_BLOCK = 128
ROPE_THETA = 10000.0
N_EXPERTS = 16
EC_CAPACITY_FACTOR = 2
D_FF_EXPERT = 2 * D_MODEL
RMS_EPS = 1e-6
N_LAYERS_A = (DEPTH + 2) // 3
N_LAYERS_B = (DEPTH + 1) // 3
N_LAYERS_C = DEPTH // 3

kernel_name = "hybrid_diff_axial_window_ec_moe_encoder"


def rms_norm(x, g):
    xf = x.astype(jnp.float32)
    y = xf * lax.rsqrt(jnp.mean(xf * xf, axis=-1, keepdims=True) + RMS_EPS)
    return (y * g.astype(jnp.float32)).astype(x.dtype)


def rope_tables(pos, dim):
    inv = ROPE_THETA ** (-jnp.arange(0, dim, 2, dtype=jnp.float32) / dim)
    ang = pos.astype(jnp.float32)[:, None] * inv[None, :]
    return jnp.cos(ang), jnp.sin(ang)


def apply_rope(x, cos, sin):
    half = x.shape[-1] // 2
    x1, x2 = x[..., :half], x[..., half:]
    c = cos[None, :, None, :].astype(x.dtype)
    s = sin[None, :, None, :].astype(x.dtype)
    return jnp.concatenate([x1 * c - x2 * s, x2 * c + x1 * s], axis=-1)


def apply_axial_rope(x, row_cos, row_sin, col_cos, col_sin):
    half = x.shape[-1] // 2
    return jnp.concatenate([apply_rope(x[..., :half], row_cos, row_sin),
                            apply_rope(x[..., half:], col_cos, col_sin)], axis=-1)


def diff_attention(h, w_in, w_o, lq1, lk1, lq2, lk2, subln_g, lambda_init, cos, sin):
    B, S, _ = h.shape
    H, d = DIFF_HEADS, HEAD_DIM
    q, k, v = jnp.split(h @ w_in.astype(h.dtype), 3, axis=-1)
    q = apply_rope(q.reshape(B, S, 2 * H, d), cos, sin).reshape(B, S, H, 2, d)
    k = apply_rope(k.reshape(B, S, 2 * H, d), cos, sin).reshape(B, S, H, 2, d)
    v = v.reshape(B, S, H, 2 * d)
    lam = (jnp.exp(jnp.sum(lq1.astype(jnp.float32) * lk1.astype(jnp.float32)))
           - jnp.exp(jnp.sum(lq2.astype(jnp.float32) * lk2.astype(jnp.float32)))
           + lambda_init)
    nb = S // Q_BLOCK
    qb = q.reshape(B, nb, Q_BLOCK, H, 2, d).swapaxes(0, 1)
    scale = d ** -0.5

    def block(qblk):
        s = jnp.einsum('bqhcd,bshcd->bhcqs', qblk, k).astype(jnp.float32) * scale
        p = jax.nn.softmax(s, axis=-1)
        a = (p[:, :, 0] - lam * p[:, :, 1]).astype(v.dtype)
        return jnp.einsum('bhqs,bshe->bqhe', a, v)

    o = lax.map(block, qb).swapaxes(0, 1).reshape(B, S, H, 2 * d)
    o = rms_norm(o, subln_g) * (1.0 - lambda_init)
    return o.reshape(B, S, H * 2 * d) @ w_o.astype(h.dtype)


def split_gqa(h, w_in):
    B, S, _ = h.shape
    H, KV, d = GQA_HEADS, GQA_KV_HEADS, HEAD_DIM
    q, k, v = jnp.split(h @ w_in.astype(h.dtype), [H * d, H * d + KV * d], axis=-1)
    return q.reshape(B, S, H, d), k.reshape(B, S, KV, d), v.reshape(B, S, KV, d)


def axial_gqa(h, w_in, w_o, q_norm_g, k_norm_g, row_cos, row_sin, col_cos, col_sin):
    B, S, _ = h.shape
    H, KV, d = GQA_HEADS, GQA_KV_HEADS, HEAD_DIM
    G = H // KV
    q, k, v = split_gqa(h, w_in)
    q = apply_axial_rope(rms_norm(q, q_norm_g), row_cos, row_sin, col_cos, col_sin)
    k = apply_axial_rope(rms_norm(k, k_norm_g), row_cos, row_sin, col_cos, col_sin)
    nb = S // Q_BLOCK
    qb = q.reshape(B, nb, Q_BLOCK, KV, G, d).swapaxes(0, 1)
    scale = d ** -0.5

    def block(qblk):
        s = jnp.einsum('bqkgd,bskd->bkgqs', qblk, k).astype(jnp.float32) * scale
        p = jax.nn.softmax(s, axis=-1).astype(v.dtype)
        return jnp.einsum('bkgqs,bskd->bqkgd', p, v)

    o = lax.map(block, qb).swapaxes(0, 1).reshape(B, S, H * d)
    return o @ w_o.astype(h.dtype)


def window_gqa_sink(h, w_in, w_o, sinks, cos, sin):
    B, S, _ = h.shape
    H, KV, d = GQA_HEADS, GQA_KV_HEADS, HEAD_DIM
    G = H // KV
    L = Q_BLOCK + 2 * WINDOW
    q, k, v = split_gqa(h, w_in)
    q = apply_rope(q, cos, sin).reshape(B, S, KV, G, d)
    k = apply_rope(k, cos, sin)
    pad = ((0, 0), (WINDOW, WINDOW), (0, 0), (0, 0))
    kp, vp = jnp.pad(k, pad), jnp.pad(v, pad)
    sink = sinks.astype(jnp.float32).reshape(KV, G)
    scale = d ** -0.5

    def block(i):
        start = i * Q_BLOCK
        qblk = lax.dynamic_slice_in_dim(q, start, Q_BLOCK, axis=1)
        kblk = lax.dynamic_slice_in_dim(kp, start, L, axis=1)
        vblk = lax.dynamic_slice_in_dim(vp, start, L, axis=1)
        s = jnp.einsum('bqkgd,blkd->bkgql', qblk, kblk).astype(jnp.float32) * scale
        qpos = start + jnp.arange(Q_BLOCK)
        kpos = start - WINDOW + jnp.arange(L)
        valid = ((jnp.abs(qpos[:, None] - kpos[None, :]) <= WINDOW)
                 & (kpos[None, :] >= 0) & (kpos[None, :] < S))
        s = jnp.where(valid, s, -jnp.inf)
        sink_col = jnp.broadcast_to(sink[None, :, :, None, None], s.shape[:-1] + (1,))
        p = jax.nn.softmax(jnp.concatenate([s, sink_col], axis=-1), axis=-1)[..., :-1]
        return jnp.einsum('bkgql,blkd->bqkgd', p.astype(v.dtype), vblk)

    o = lax.map(block, jnp.arange(S // Q_BLOCK))
    o = o.swapaxes(0, 1).reshape(B, S, H * d)
    return o @ w_o.astype(h.dtype)


def expert_choice_ffn(h, w_router, w_gate, w_up, w_down):
    B, N, D = h.shape
    cap = EC_CAPACITY_FACTOR * N // N_EXPERTS
    aff = jax.nn.softmax((h @ w_router.astype(h.dtype)).astype(jnp.float32), axis=-1)
    gates, idx = lax.top_k(aff.swapaxes(1, 2), cap)

    def expert(args):
        idx_e, gate_e, wg, wu, wd = args
        xe = jax.vmap(lambda hb, ib: hb[ib])(h, idx_e)
        hid = jax.nn.silu(xe @ wg.astype(h.dtype)) * (xe @ wu.astype(h.dtype))
        return ((hid @ wd.astype(h.dtype)) * gate_e[..., None]).astype(h.dtype)

    ye = lax.map(expert, (idx.swapaxes(0, 1), gates.swapaxes(0, 1), w_gate, w_up, w_down))
    return jax.vmap(lambda ib, cb: jnp.zeros((N, D), h.dtype).at[ib.reshape(-1)].add(cb.reshape(-1, D)),
                    in_axes=(0, 1))(idx, ye)


def setup_inputs(seed: int = 0) -> dict:
    key = jax.random.key(seed)
    ks = jax.random.split(key, 24)
    D, d, E, F = D_MODEL, HEAD_DIM, N_EXPERTS, D_FF_EXPERT
    gqa_in = (GQA_HEADS + 2 * GQA_KV_HEADS) * d

    def normal(k, shape, scale):
        return jax.random.normal(k, shape, jnp.float32) * scale

    def gain(k, shape):
        return 1.0 + 0.02 * jax.random.normal(k, shape, jnp.float32)

    return {
        "x": normal(ks[0], (BATCH, SEQ, D), 1.0),
        "attn_norm_g": gain(ks[1], (DEPTH, D)),
        "ffn_norm_g": gain(ks[2], (DEPTH, D)),
        "final_norm_g": gain(ks[3], (D,)),
        "a_w_in": normal(ks[4], (N_LAYERS_A, D, 3 * D), D ** -0.5),
        "a_w_o": normal(ks[5], (N_LAYERS_A, D, D), D ** -0.5),
        "a_lambda_q1": normal(ks[6], (N_LAYERS_A, d), 0.1),
        "a_lambda_k1": normal(ks[7], (N_LAYERS_A, d), 0.1),
        "a_lambda_q2": normal(ks[8], (N_LAYERS_A, d), 0.1),
        "a_lambda_k2": normal(ks[9], (N_LAYERS_A, d), 0.1),
        "a_subln_g": gain(ks[10], (N_LAYERS_A, 2 * d)),
        "b_w_in": normal(ks[11], (N_LAYERS_B, D, gqa_in), D ** -0.5),
        "b_w_o": normal(ks[12], (N_LAYERS_B, GQA_HEADS * d, D), (GQA_HEADS * d) ** -0.5),
        "b_q_norm_g": gain(ks[13], (N_LAYERS_B, d)),
        "b_k_norm_g": gain(ks[14], (N_LAYERS_B, d)),
        "c_w_in": normal(ks[15], (N_LAYERS_C, D, gqa_in), D ** -0.5),
        "c_w_o": normal(ks[16], (N_LAYERS_C, GQA_HEADS * d, D), (GQA_HEADS * d) ** -0.5),
        "c_sinks": normal(ks[17], (N_LAYERS_C, GQA_HEADS), 0.5),
        "moe_w_router": normal(ks[18], (DEPTH, D, E), D ** -0.5),
        "moe_w_gate": normal(ks[19], (DEPTH, E, D, F), D ** -0.5),
        "moe_w_up": normal(ks[20], (DEPTH, E, D, F), D ** -0.5),
        "moe_w_down": normal(ks[21], (DEPTH, E, F, D), F ** -0.5),
    }


def reference(x, attn_norm_g, ffn_norm_g, final_norm_g,
              a_w_in, a_w_o, a_lambda_q1, a_lambda_k1, a_lambda_q2, a_lambda_k2, a_subln_g,
              b_w_in, b_w_o, b_q_norm_g, b_k_norm_g,
              c_w_in, c_w_o, c_sinks,
              moe_w_router, moe_w_gate, moe_w_up, moe_w_down):
    S = x.shape[1]
    pos = jnp.arange(S)
    cos, sin = rope_tables(pos, HEAD_DIM)
    rows = S // GRID_W
    row_idx = jnp.repeat(jnp.arange(rows), GRID_W)
    col_idx = jnp.tile(jnp.arange(GRID_W), rows)
    row_cos, row_sin = rope_tables(row_idx, HEAD_DIM // 2)
    col_cos, col_sin = rope_tables(col_idx, HEAD_DIM // 2)

    for i in range(DEPTH):
        m, j = i % N_MIXERS, i // N_MIXERS
        h = rms_norm(x, attn_norm_g[i])
        if m == 0:
            lambda_init = 0.8 - 0.6 * math.exp(-0.3 * i)
            mix = diff_attention(h, a_w_in[j], a_w_o[j], a_lambda_q1[j], a_lambda_k1[j],
                                 a_lambda_q2[j], a_lambda_k2[j], a_subln_g[j], lambda_init, cos, sin)
        elif m == 1:
            mix = axial_gqa(h, b_w_in[j], b_w_o[j], b_q_norm_g[j], b_k_norm_g[j],
                            row_cos, row_sin, col_cos, col_sin)
        else:
            mix = window_gqa_sink(h, c_w_in[j], c_w_o[j], c_sinks[j], cos, sin)
        x = x + mix
        x = x + expert_choice_ffn(rms_norm(x, ffn_norm_g[i]), moe_w_router[i],
                                  moe_w_gate[i], moe_w_up[i], moe_w_down[i])
    return rms_norm(x, final_norm_g)
```

```cpp
#include <hip/hip_runtime.h>
#include <cstdio>
#include <cstdint>
__device__ __forceinline__ int fresh_tid() { int t = threadIdx.x; asm volatile("" : "+v"(t)); return t; }
namespace pg8 {
#define PG8_LAS __attribute__((address_space(3)))
typedef unsigned short bf16_t;
typedef short bf16x8 __attribute__((ext_vector_type(8)));
typedef float f32x4 __attribute__((ext_vector_type(4)));
typedef unsigned u32x4 __attribute__((ext_vector_type(4)));
constexpr int BM = 256, BK = 64, HALF = 128, HTB = HALF * BK * 2  , STAGE_BYTES = 8 * HTB, NXCD = 8, WGM = 8;

__host__ __device__ __forceinline__ int lds_byte(int r, int c) { const int st = (r >> 4) * 2 + (c >> 5), rr = r & 15, cc = c & 31, ob = rr * 64 + cc * 2; return st * 1024 + (ob ^ (((ob >> 9) & 1) << 5)); }
__host__ __device__ __forceinline__ void stage_rc(int b, int& R, int& C) { const int st = b / 1024, sb = b % 1024, swz = sb ^ (((sb >> 9) & 1) << 5); R = (st >> 1) * 16 + swz / 64; C = (st & 1) * 32 + (swz % 64) / 2; }
__host__ __device__ __forceinline__ int perm32(int rho) { const int n = rho >> 4, i = rho & 15; return 8 * (i >> 2) + 4 * n + (i & 3); }

struct Unit { int pm, pn; };
struct Gemm { const bf16_t* A; const bf16_t* Bt; int M, N, K; };

struct StaticOrder {
    int nM, nN, nwg, G, c;
    __host__ __device__ void init(int M, int N, int G_, int c_) { nM = M / BM; nN = N / BM; nwg = nM * nN; G = G_; c = c_; }
    __host__ __device__ bool next(int i, Unit& u) const {
        const long L = (long)i * G + c; if (L >= nwg) return false;
        int wgid = (int)L; { const int q = nwg / NXCD, r = nwg % NXCD, xcd = wgid % NXCD, off = wgid / NXCD; wgid = (xcd < r ? xcd * (q + 1) : r * (q + 1) + (xcd - r) * q) + off; }
        const int nig = WGM * nN, gid = wgid / nig, fm = gid * WGM, gsz = (nM - fm) < WGM ? (nM - fm) : WGM;
        u.pm = fm + ((wgid % nig) % gsz); u.pn = (wgid % nig) / gsz; return true;
    }
    __device__ __forceinline__ void a_ready(const Unit&) const {}
    __device__ __forceinline__ void done(const Unit&) const {}
};


template <int NNL> struct GroupedOrder {
    int G, c, nunits;
    __device__ void init(int G_, int c_) { G = G_; c = c_; nunits = 16 * 32 * NNL; }
    __device__ bool next(int i, Unit& u) const {
        const int L = i * G + c; if (L >= nunits) return false;
        if (G == 256) {
            const int x = c & 7, j = c >> 3;
            if (NNL == 16) { const int e = i >> 1, hh = i & 1; u.pm = e * 32 + 4 * x + (j & 3); u.pn = e * 16 + 8 * hh + (j >> 2); }
            else { const int e = 2 * i + (x >> 2); u.pm = e * 32 + 8 * (x & 3) + (j & 7); u.pn = e * NNL + (j >> 3); }
        } else { const int pmg = L / NNL; u.pm = pmg; u.pn = (pmg >> 5) * NNL + (L % NNL); }
        return true;
    }
    __device__ __forceinline__ void a_ready(const Unit&) const {}
    __device__ __forceinline__ void done(const Unit&) const {}
};

__device__ __forceinline__ unsigned cvt_pk_bf16(float lo, float hi) { unsigned r; asm volatile("v_cvt_pk_bf16_f32 %0, %1, %2" : "=v"(r) : "v"(lo), "v"(hi)); return r; }

struct EpiQKV {
    static constexpr bool PERM = true, AFTER_DRAIN = false;
    bf16_t* O; int ldc; const float* tcos; const float* tsin; int nrope, nq; const float* qg; const float* kg; float qscale;
    __device__ __forceinline__ void operator()(const f32x4 (&acc)[2][2][4][2], const Unit& u, int wr, int wc, int fr, int fq) const {
        const int row0 = u.pm * BM + wr * 64 + fr, col0 = u.pn * BM + wc * 64 + 8 * fq;
        const bool rope = u.pn < nrope; const float sc = (u.pn < nq) ? qscale : 1.0f;
        const float* gp = (u.pn < nq) ? qg : kg;
        f32x4 gv[2][2];
        if (rope && gp) {
#pragma unroll
            for (int bj = 0; bj < 2; ++bj)
#pragma unroll
                for (int n = 0; n < 2; ++n) gv[bj][n] = *(const f32x4*)(gp + 32 * bj + 8 * fq + 4 * n);
        }
#pragma unroll
        for (int ai = 0; ai < 2; ++ai)
#pragma unroll
            for (int m = 0; m < 4; ++m) {
                const int row = row0 + ai * HALF + m * 16;
                f32x4 v[2][2];
#pragma unroll
                for (int bj = 0; bj < 2; ++bj)
#pragma unroll
                    for (int n = 0; n < 2; ++n) v[bj][n] = acc[ai][bj][m][n];
                if (rope) {
                    if (gp) {
                        float ss = 0.f;
#pragma unroll
                        for (int bj = 0; bj < 2; ++bj)
#pragma unroll
                            for (int n = 0; n < 2; ++n) ss += (v[bj][n][0] * v[bj][n][0] + v[bj][n][1] * v[bj][n][1]) + (v[bj][n][2] * v[bj][n][2] + v[bj][n][3] * v[bj][n][3]);
                        ss += __shfl_xor(ss, 16); ss += __shfl_xor(ss, 32);
                        const float rstd = __builtin_amdgcn_rsqf(ss * (1.0f / 64.0f) + 1e-6f);
#pragma unroll
                        for (int bj = 0; bj < 2; ++bj)
#pragma unroll
                            for (int n = 0; n < 2; ++n) v[bj][n] = v[bj][n] * rstd * gv[bj][n];
                    }
                    const int s = row & 2047;
#pragma unroll
                    for (int n = 0; n < 2; ++n) {
                        const f32x4 c = *(const f32x4*)(tcos + s * 32 + 8 * fq + 4 * n), sn = *(const f32x4*)(tsin + s * 32 + 8 * fq + 4 * n);
                        const f32x4 x1 = v[0][n], x2 = v[1][n];
                        v[0][n] = x1 * c - x2 * sn; v[1][n] = x2 * c + x1 * sn;
                    }
                }
                bf16_t* rowp = O + (size_t)row * ldc + col0;
#pragma unroll
                for (int bj = 0; bj < 2; ++bj) { const f32x4 v0 = v[bj][0] * sc, v1 = v[bj][1] * sc;
                    u32x4 w; w.x = cvt_pk_bf16(v0[0], v0[1]); w.y = cvt_pk_bf16(v0[2], v0[3]); w.z = cvt_pk_bf16(v1[0], v1[1]); w.w = cvt_pk_bf16(v1[2], v1[3]);
                    *(u32x4*)(rowp + bj * 32) = w; }
            }
    }
};
struct EpiResF32 {
    static constexpr bool PERM = false, AFTER_DRAIN = false;
    const float* base; float* C; int ldc;
    __device__ __forceinline__ void operator()(const f32x4 (&acc)[2][2][4][2], const Unit& u, int wr, int wc, int fr, int fq) const {
        const int row0 = u.pm * BM + wr * 64 + fr, col0 = u.pn * BM + wc * 32 + 4 * fq;
#pragma unroll
        for (int ai = 0; ai < 2; ++ai)
#pragma unroll
            for (int m = 0; m < 4; ++m) { const size_t off = (size_t)(row0 + ai * HALF + m * 16) * ldc + col0;
                f32x4 bs[2][2];
#pragma unroll
                for (int bj = 0; bj < 2; ++bj)
#pragma unroll
                    for (int n = 0; n < 2; ++n) bs[bj][n] = *(const f32x4*)(base + off + bj * HALF + n * 16);
#pragma unroll
                for (int bj = 0; bj < 2; ++bj)
#pragma unroll
                    for (int n = 0; n < 2; ++n) *(f32x4*)(C + off + bj * HALF + n * 16) = acc[ai][bj][m][n] + bs[bj][n];
                asm volatile("" ::: "memory"); }
    }
};
struct EpiSwiGLU {
    static constexpr bool PERM = true, AFTER_DRAIN = false;
    bf16_t* O; int ldc;
    __device__ __forceinline__ void operator()(const f32x4 (&acc)[2][2][4][2], const Unit& u, int wr, int wc, int fr, int fq) const {
        const int row0 = u.pm * BM + wr * 64 + fr, col0 = (u.pn & 15) * HALF + wc * 32 + 8 * fq;
#pragma unroll
        for (int ai = 0; ai < 2; ++ai)
#pragma unroll
            for (int m = 0; m < 4; ++m) { bf16_t* rowp = O + (size_t)(row0 + ai * HALF + m * 16) * ldc + col0;
                f32x4 h[2];
#pragma unroll
                for (int n = 0; n < 2; ++n) { const f32x4 g = acc[ai][0][m][n], up = acc[ai][1][m][n];
#pragma unroll
                    for (int j = 0; j < 4; ++j) { const float e = __builtin_amdgcn_exp2f(g[j] * -1.4426950408889634f); h[n][j] = g[j] * __builtin_amdgcn_rcpf(1.0f + e) * up[j]; } }
                u32x4 w; w.x = cvt_pk_bf16(h[0][0], h[0][1]); w.y = cvt_pk_bf16(h[0][2], h[0][3]); w.z = cvt_pk_bf16(h[1][0], h[1][1]); w.w = cvt_pk_bf16(h[1][2], h[1][3]);
                *(u32x4*)rowp = w; }
    }
};
struct EpiDown {
    static constexpr bool PERM = true, AFTER_DRAIN = false;
    bf16_t* O; int ldc; const float* gate;
    __device__ __forceinline__ void operator()(const f32x4 (&acc)[2][2][4][2], const Unit& u, int wr, int wc, int fr, int fq) const {
        const int row0 = u.pm * BM + wr * 64 + fr, col0 = (u.pn & 3) * BM + wc * 32 + 8 * fq;
#pragma unroll
        for (int ai = 0; ai < 2; ++ai)
#pragma unroll
            for (int m = 0; m < 4; ++m) { const int row = row0 + ai * HALF + m * 16; const float gt = gate[row]; bf16_t* rowp = O + (size_t)row * ldc + col0;
#pragma unroll
                for (int bj = 0; bj < 2; ++bj) { const f32x4 v0 = acc[ai][bj][m][0] * gt, v1 = acc[ai][bj][m][1] * gt;
                    u32x4 w; w.x = cvt_pk_bf16(v0[0], v0[1]); w.y = cvt_pk_bf16(v0[2], v0[3]); w.z = cvt_pk_bf16(v1[0], v1[1]); w.w = cvt_pk_bf16(v1[2], v1[3]);
                    *(u32x4*)(rowp + bj * HALF) = w; } }
    }
};


template <class Epi, class Sched, bool ALIGN_EPI = false, bool SP2 = false>
__device__ __forceinline__ void gemm_phase(PG8_LAS unsigned char* lds, const Gemm g, const Sched& S, const Epi& E) {
    const int tid = fresh_tid(), wid = __builtin_amdgcn_readfirstlane(tid >> 6), lane = tid & 63, wr = wid >> 2, wc = wid & 3, fr = lane & 15, fq = lane >> 4;
    const int K = g.K, nt = K / BK;
    unsigned voffA[2], voffB[2];
#pragma unroll
    for (int i = 0; i < 2; ++i) { int R, C; stage_rc(tid * 16 + i * 8192, R, C); const int Rb = Epi::PERM ? ((R & ~31) + perm32(R & 31)) : R;
        voffA[i] = (unsigned)(R * K + C) * 2u; voffB[i] = (unsigned)(Rb * K + C) * 2u; }
    const size_t kstep = (size_t)(BK * 2);
    const size_t hstep = (size_t)HALF * K * 2;
    const size_t tstep = 2 * hstep;
    const unsigned ldsw = (unsigned)wid * 1024u;
    const int aoff = lds_byte(wr * 64 + fr, fq * 8), boff = lds_byte(wc * 32 + fr, fq * 8);
#define PG8_SA(b, h) (((b) * 2 + (h)) * HTB)
#define PG8_SB(b, h) ((4 + (b) * 2 + (h)) * HTB)
#define PG8_STAGE(bufoff, gbase, voff) do { _Pragma("unroll") for (int _i = 0; _i < 2; ++_i) \
        __builtin_amdgcn_global_load_lds((const unsigned*)((const char*)(gbase) + (voff)[_i]), (PG8_LAS unsigned*)(lds + (bufoff) + ldsw + _i * 8192), 16, 0, 0); } while (0)
#define PG8_LDA(dst, b, h) do { _Pragma("unroll") for (int m = 0; m < 4; ++m) _Pragma("unroll") for (int k = 0; k < 2; ++k) dst[m][k] = *(const PG8_LAS bf16x8*)(lds + PG8_SA(b, h) + aoff + m * 2048 + k * 1024); } while (0)
#define PG8_LDB(dst, b, h) do { _Pragma("unroll") for (int n = 0; n < 2; ++n) _Pragma("unroll") for (int k = 0; k < 2; ++k) dst[n][k] = *(const PG8_LAS bf16x8*)(lds + PG8_SB(b, h) + boff + n * 2048 + k * 1024); } while (0)
#define PG8_MMA(ai, bj, At, Bt) do { __builtin_amdgcn_s_setprio(1); _Pragma("unroll") for (int m = 0; m < 4; ++m) _Pragma("unroll") for (int n = 0; n < 2; ++n) _Pragma("unroll") for (int k = 0; k < 2; ++k) \
        acc[ai][bj][m][n] = __builtin_amdgcn_mfma_f32_16x16x32_bf16(Bt[n][k], At[m][k], acc[ai][bj][m][n], 0, 0, 0); __builtin_amdgcn_s_setprio(0); } while (0)
#define PG8_WAIT_V(n) asm volatile("s_waitcnt vmcnt(" #n ")" ::: "memory")
#define PG8_WAIT_L(n) asm volatile("s_waitcnt lgkmcnt(" #n ")" ::: "memory")
#define PG8_BAR __builtin_amdgcn_s_barrier()
#define PG8_SCHED __builtin_amdgcn_sched_barrier(0)
    Unit cur, nxt; int ui = 0;
    if (!S.next(0, cur)) return;
    f32x4 acc[2][2][4][2];
#pragma unroll
    for (int a = 0; a < 2; ++a)
#pragma unroll
        for (int b = 0; b < 2; ++b)
#pragma unroll
            for (int m = 0; m < 4; ++m)
#pragma unroll
                for (int n = 0; n < 2; ++n) acc[a][b][m][n] = (f32x4){0.f, 0.f, 0.f, 0.f};
    bf16x8 At[4][2], B0[2][2], B1[2][2];
    const char* cA = (const char*)g.A + (size_t)cur.pm * tstep; const char* cB = (const char*)g.Bt + (size_t)cur.pn * tstep;
    S.a_ready(cur);
    if constexpr (SP2) {
        PG8_STAGE(PG8_SB(0, 0), cB, voffB); PG8_STAGE(PG8_SB(0, 1), cB + hstep, voffB); PG8_STAGE(PG8_SA(0, 0), cA, voffA); PG8_STAGE(PG8_SA(0, 1), cA + hstep, voffA);
        if (wr == 1) PG8_BAR;
        PG8_WAIT_V(2); PG8_BAR;
        PG8_STAGE(PG8_SB(1, 0), cB + kstep, voffB); PG8_STAGE(PG8_SA(1, 0), cA + kstep, voffA); PG8_STAGE(PG8_SB(1, 1), cB + hstep + kstep, voffB);
        PG8_WAIT_V(6); PG8_BAR;
    } else {
        PG8_STAGE(PG8_SB(0, 0), cB, voffB); PG8_STAGE(PG8_SA(0, 0), cA, voffA); PG8_STAGE(PG8_SB(0, 1), cB + hstep, voffB); PG8_STAGE(PG8_SA(0, 1), cA + hstep, voffA);
        if (wr == 1) PG8_BAR;
        PG8_WAIT_V(4); PG8_BAR;
        PG8_STAGE(PG8_SB(1, 0), cB + kstep, voffB); PG8_STAGE(PG8_SA(1, 0), cA + kstep, voffA); PG8_STAGE(PG8_SB(1, 1), cB + hstep + kstep, voffB);
        PG8_WAIT_V(6); PG8_BAR;
    }
    for (;;) {
        const bool has_next = S.next(ui + 1, nxt);
        const char* nA = has_next ? (const char*)g.A + (size_t)nxt.pm * tstep : cA; const char* nB = has_next ? (const char*)g.Bt + (size_t)nxt.pn * tstep : cB;
        for (int t = 0; t < nt; t += 2) {
            const bool last = (t == nt - 2);
            const char* a1 = cA + (size_t)(t + 1) * kstep;
            const char* a2 = last ? nA : cA + (size_t)(t + 2) * kstep; const char* b2 = last ? nB : cB + (size_t)(t + 2) * kstep;
            const char* a3 = a2 + kstep; const char* b3 = b2 + kstep;
            if (last && has_next) S.a_ready(nxt);
            if constexpr (SP2) {
            PG8_LDB(B0, 0, 0); PG8_LDB(B1, 0, 1); PG8_SCHED; PG8_LDA(At, 0, 0); PG8_STAGE(PG8_SA(1, 1), a1 + hstep, voffA);
            PG8_WAIT_V(8); PG8_WAIT_L(0); PG8_BAR; PG8_MMA(0, 0, At, B0); PG8_MMA(0, 1, At, B1); PG8_BAR; PG8_SCHED;
            PG8_LDA(At, 0, 1); PG8_STAGE(PG8_SB(0, 0), b2, voffB); PG8_STAGE(PG8_SB(0, 1), b2 + hstep, voffB); PG8_STAGE(PG8_SA(0, 0), a2, voffA);
            PG8_WAIT_V(8); PG8_WAIT_L(0); PG8_BAR; PG8_MMA(1, 0, At, B0); PG8_MMA(1, 1, At, B1); PG8_BAR; PG8_SCHED;
            PG8_LDB(B0, 1, 0); PG8_LDB(B1, 1, 1); PG8_SCHED; PG8_LDA(At, 1, 0); PG8_STAGE(PG8_SA(0, 1), a2 + hstep, voffA);
            PG8_WAIT_V(8); PG8_WAIT_L(0); PG8_BAR; PG8_MMA(0, 0, At, B0); PG8_MMA(0, 1, At, B1); PG8_BAR; PG8_SCHED;
            PG8_LDA(At, 1, 1); PG8_STAGE(PG8_SB(1, 0), b3, voffB); PG8_STAGE(PG8_SB(1, 1), b3 + hstep, voffB); PG8_STAGE(PG8_SA(1, 0), a3, voffA);
            PG8_WAIT_V(8); PG8_WAIT_L(0); PG8_BAR; PG8_MMA(1, 0, At, B0); PG8_MMA(1, 1, At, B1); PG8_BAR; PG8_SCHED;
            } else {
            PG8_LDB(B0, 0, 0); PG8_SCHED; PG8_LDA(At, 0, 0); PG8_STAGE(PG8_SA(1, 1), a1 + hstep, voffA);
            PG8_WAIT_L(8); PG8_BAR; PG8_WAIT_L(0); PG8_MMA(0, 0, At, B0); PG8_BAR; PG8_SCHED;
            PG8_LDB(B1, 0, 1); PG8_STAGE(PG8_SB(0, 0), b2, voffB);
            PG8_BAR; PG8_WAIT_L(0); PG8_MMA(0, 1, At, B1); PG8_BAR;
            PG8_LDA(At, 0, 1); PG8_STAGE(PG8_SA(0, 0), a2, voffA);
            PG8_BAR; PG8_WAIT_L(0); PG8_MMA(1, 0, At, B0); PG8_BAR; PG8_SCHED;
            PG8_STAGE(PG8_SB(0, 1), b2 + hstep, voffB);
            PG8_WAIT_V(6); PG8_BAR; PG8_MMA(1, 1, At, B1); PG8_BAR;
            PG8_LDB(B0, 1, 0); PG8_SCHED; PG8_LDA(At, 1, 0); PG8_STAGE(PG8_SA(0, 1), a2 + hstep, voffA);
            PG8_WAIT_L(8); PG8_BAR; PG8_WAIT_L(0); PG8_MMA(0, 0, At, B0); PG8_BAR; PG8_SCHED;
            PG8_LDB(B1, 1, 1); PG8_STAGE(PG8_SB(1, 0), b3, voffB);
            PG8_BAR; PG8_WAIT_L(0); PG8_MMA(0, 1, At, B1); PG8_BAR;
            PG8_LDA(At, 1, 1); PG8_STAGE(PG8_SA(1, 0), a3, voffA);
            PG8_BAR; PG8_WAIT_L(0); PG8_MMA(1, 0, At, B0); PG8_BAR; PG8_SCHED;
            PG8_STAGE(PG8_SB(1, 1), b3 + hstep, voffB);
            PG8_WAIT_V(6); PG8_BAR; PG8_MMA(1, 1, At, B1); PG8_BAR;
            }
        }
        if constexpr (ALIGN_EPI) { if (wr == 0) PG8_BAR; }
        if constexpr (!Epi::AFTER_DRAIN) { E(acc, cur, wr, wc, fr, fq); S.done(cur); }
        if (!has_next) break;
#pragma unroll
        for (int a = 0; a < 2; ++a)
#pragma unroll
            for (int b = 0; b < 2; ++b)
#pragma unroll
                for (int m = 0; m < 4; ++m)
#pragma unroll
                    for (int n = 0; n < 2; ++n) acc[a][b][m][n] = (f32x4){0.f, 0.f, 0.f, 0.f};
        cur = nxt; cA = nA; cB = nB; ++ui;
        if constexpr (ALIGN_EPI) { if (wr == 1) PG8_BAR; }
    }
    PG8_WAIT_V(0);
    if constexpr (!ALIGN_EPI) { if (wr == 0) PG8_BAR; }
    PG8_BAR;
    if constexpr (Epi::AFTER_DRAIN) { E.fused(acc, cur, wr, wc, fr, fq, lds, wid, lane); S.done(cur); }
#undef PG8_SA
#undef PG8_SB
#undef PG8_STAGE
#undef PG8_LDA
#undef PG8_LDB
#undef PG8_MMA
#undef PG8_WAIT_V
#undef PG8_WAIT_L
#undef PG8_BAR
#undef PG8_SCHED
}
}


namespace att {
using bf16 = unsigned short;
using bf16x8 = __attribute__((ext_vector_type(8))) short;
using s16x4  = __attribute__((ext_vector_type(4))) short;
using f32x16 = __attribute__((ext_vector_type(16))) float;
using u32x4  = __attribute__((ext_vector_type(4))) unsigned;
constexpr int KVBLK = 64;
constexpr float THR = 8.f;
constexpr int SHM_K = KVBLK * 64 * 2;
#define ATT_KSWZ(row, colB) ((row) * 128 + ((colB) ^ ((((row) >> 1) & 7) << 4)))
#define ATT_SBAR() __builtin_amdgcn_sched_barrier(0)
__device__ __forceinline__ int crow(int r, int hi) { return (r & 3) + 8 * (r >> 2) + 4 * hi; }
__device__ __forceinline__ unsigned cvtpk(float lo, float hi) { unsigned r; asm volatile("v_cvt_pk_bf16_f32 %0, %1, %2" : "=v"(r) : "v"(lo), "v"(hi)); return r; }

__device__ __forceinline__ void partialSM(f32x16& p0, f32x16& p1, float& m_reg, float& mn, float& alpha) {
  float pmax = p0[0];
#pragma unroll
  for (int r = 1; r < 16; ++r) pmax = fmaxf(pmax, p0[r]);
#pragma unroll
  for (int r = 0; r < 16; ++r) pmax = fmaxf(pmax, p1[r]);
  { auto rr = __builtin_amdgcn_permlane32_swap(__float_as_uint(pmax), __float_as_uint(pmax), false, false);
    pmax = fmaxf(__uint_as_float(rr[0]), __uint_as_float(rr[1])); }
  if (__builtin_expect(__all(pmax - m_reg <= THR), 1)) { mn = m_reg; alpha = 1.f; }
  else { mn = fmaxf(m_reg, pmax); alpha = __builtin_amdgcn_exp2f(m_reg - mn); m_reg = mn; }
#pragma unroll
  for (int r = 0; r < 16; ++r) p0[r] = p0[r] - mn;
#pragma unroll
  for (int r = 0; r < 16; ++r) p1[r] = p1[r] - mn;
#pragma unroll
  for (int r = 0; r < 16; ++r) p0[r] = __builtin_amdgcn_exp2f(p0[r]);
}
__device__ __forceinline__ void finishSM(f32x16& p0, f32x16& p1, float alpha, float& l_reg, bf16x8& pa0, bf16x8& pa1, bf16x8& pa2, bf16x8& pa3) {
#pragma unroll
  for (int r = 0; r < 16; ++r) p1[r] = __builtin_amdgcn_exp2f(p1[r]);
  float ps = 0;
#pragma unroll
  for (int r = 0; r < 16; ++r) ps += p0[r];
#pragma unroll
  for (int r = 0; r < 16; ++r) ps += p1[r];
  { auto rr = __builtin_amdgcn_permlane32_swap(__float_as_uint(ps), __float_as_uint(ps), false, false);
    ps = __uint_as_float(rr[0]) + __uint_as_float(rr[1]); }
  l_reg = l_reg * alpha + ps;
#define ATT_PK4(P, BASE, OUT) do { unsigned a0 = cvtpk(P[BASE + 0], P[BASE + 1]), a1 = cvtpk(P[BASE + 2], P[BASE + 3]);   \
    unsigned b0 = cvtpk(P[BASE + 4], P[BASE + 5]), b1 = cvtpk(P[BASE + 6], P[BASE + 7]);                              \
    auto r0 = __builtin_amdgcn_permlane32_swap(a0, b0, false, false); auto r1 = __builtin_amdgcn_permlane32_swap(a1, b1, false, false); \
    u32x4 w = {r0[0], r1[0], r0[1], r1[1]}; OUT = *reinterpret_cast<bf16x8*>(&w); } while (0)
  ATT_PK4(p0, 0, pa0); ATT_PK4(p0, 8, pa1); ATT_PK4(p1, 0, pa2); ATT_PK4(p1, 8, pa3);
#undef ATT_PK4
}
__device__ __forceinline__ void qkt(f32x16& p0, f32x16& p1, const char* Ks, const bf16x8* qr, int r32, int hi) {
  p0 = f32x16{}; p1 = f32x16{};
#pragma unroll
  for (int d0 = 0; d0 < 4; ++d0) { const int cb = (d0 * 16 + hi * 8) * 2;
    bf16x8 b0 = *reinterpret_cast<const bf16x8*>(Ks + ATT_KSWZ(r32, cb));
    bf16x8 b1 = *reinterpret_cast<const bf16x8*>(Ks + ATT_KSWZ(32 + r32, cb));
    p0 = __builtin_amdgcn_mfma_f32_32x32x16_bf16(b0, qr[d0], p0, 0, 0, 0);
    p1 = __builtin_amdgcn_mfma_f32_32x32x16_bf16(b1, qr[d0], p1, 0, 0, 0); }
}
__device__ __forceinline__ void wmask(f32x16& p0, f32x16& p1, int dq  , int hi) {
  const float ninf = -__builtin_inff();
#pragma unroll
  for (int r = 0; r < 16; ++r) { const unsigned d = (unsigned)(dq + crow(r, hi)); p0[r] = d <= 256u ? p0[r] : ninf; const unsigned d1 = d + 32u; p1[r] = d1 <= 256u ? p1[r] : ninf; }
}
template <int NCB> __device__ __forceinline__ int v_st(int k, int c) { const int kk = (k & ~0xC) | ((k & 4) << 1) | ((k & 8) >> 1); return ((kk >> 3) * NCB + (c >> 5)) * 512 + ((kk & 7) * 32 + (c & 31)) * 2; }
__device__ __forceinline__ int v_rd_base(int lane) { return ((lane & 3) << 3) | (((lane >> 2) & 3) << 6) | (((lane >> 4) & 1) << 5) | (((lane >> 5) & 1) << 8); }
template <int OFF> __device__ __forceinline__ s16x4 tr_read(int vb) {
  s16x4 r; asm volatile("ds_read_b64_tr_b16 %0, %1 offset:%2" : "=&v"(r) : "v"(vb), "i"(OFF) : "memory"); return r;
}
template <int NCB, int D0> __device__ __forceinline__ void pv_one(f32x16& od, int vb, bf16x8 pa0, bf16x8 pa1, bf16x8 pa2, bf16x8 pa3) {
#define ATT_VOFF(ks, half) (D0 * 512 + (ks) * (NCB * 1024) + (half) * (NCB * 512))
  const s16x4 l0 = tr_read<ATT_VOFF(0, 0)>(vb), h0 = tr_read<ATT_VOFF(0, 1)>(vb), l1 = tr_read<ATT_VOFF(1, 0)>(vb), h1 = tr_read<ATT_VOFF(1, 1)>(vb);
  const s16x4 l2 = tr_read<ATT_VOFF(2, 0)>(vb), h2 = tr_read<ATT_VOFF(2, 1)>(vb), l3 = tr_read<ATT_VOFF(3, 0)>(vb), h3 = tr_read<ATT_VOFF(3, 1)>(vb);
#undef ATT_VOFF
  asm volatile("s_waitcnt lgkmcnt(0)" ::: "memory"); ATT_SBAR();
#define ATT_PK(L, H) (bf16x8){L[0], L[1], L[2], L[3], H[0], H[1], H[2], H[3]}
  od = __builtin_amdgcn_mfma_f32_32x32x16_bf16(pa0, ATT_PK(l0, h0), od, 0, 0, 0);
  od = __builtin_amdgcn_mfma_f32_32x32x16_bf16(pa1, ATT_PK(l1, h1), od, 0, 0, 0);
  od = __builtin_amdgcn_mfma_f32_32x32x16_bf16(pa2, ATT_PK(l2, h2), od, 0, 0, 0);
  od = __builtin_amdgcn_mfma_f32_32x32x16_bf16(pa3, ATT_PK(l3, h3), od, 0, 0, 0);
#undef ATT_PK
}
template <int NCB> __device__ __forceinline__ void pv_all(f32x16* o, int vb, bf16x8 pa0, bf16x8 pa1, bf16x8 pa2, bf16x8 pa3) {
  pv_one<NCB, 0>(o[0], vb, pa0, pa1, pa2, pa3); pv_one<NCB, 1>(o[1], vb, pa0, pa1, pa2, pa3);
  if constexpr (NCB == 4) { pv_one<NCB, 2>(o[2], vb, pa0, pa1, pa2, pa3); pv_one<NCB, 3>(o[3], vb, pa0, pa1, pa2, pa3); }
}

template <int NCB, bool WINDOW>
__device__ __forceinline__ void attn_core(f32x16 (&o)[NCB], const bf16* __restrict__ Qb, const bf16* __restrict__ Kh, const bf16* __restrict__ Vh, int ld, int ntiles,
                                          int qpos0, int kpos0, float sink_l2, char* lds) {
  constexpr int SHM_V = KVBLK * 32 * NCB * 2;
  const int tid = fresh_tid(), wid = tid >> 6, lane = tid & 63, r32 = lane & 31, hi = lane >> 5;
  char* V_lds = lds; char* K_lds = lds + 2 * SHM_V;
  float* wsf = (float*)(lds + 2 * SHM_V + 2 * SHM_K) + wid * 64; float* li_l = wsf; float* al_l = wsf + 32;
  float m_reg = -1e30f, l_reg = 0;
#pragma unroll
  for (int d = 0; d < NCB; ++d) o[d] = f32x16{};
  bf16x8 qr[4];
  const bf16* Qw = Qb + (long)(wid * 32 + r32) * ld + hi * 8;
#pragma unroll
  for (int d0 = 0; d0 < 4; ++d0) qr[d0] = *reinterpret_cast<const bf16x8*>(Qw + d0 * 16);
  const int dq0 = kpos0 - (qpos0 + wid * 32 + r32) + 128;
  const int ksr = tid >> 3, ksc = (tid & 7) * 8, kst = ATT_KSWZ(ksr, ksc * 2);
  constexpr int VCPR = 4 * NCB;
  const int vsr = tid / VCPR, vsc = (tid % VCPR) * 8, vst0 = v_st<NCB>(vsr, vsc), vst1 = v_st<NCB>(vsr + 32, vsc);
  const int vb0 = (int)(uintptr_t)V_lds + v_rd_base(lane);
  struct { bf16x8 ks, vs0, vs1; } sr_[2];
#define ATT_SLOAD(i, t) do { const long k0_ = (long)(t) * KVBLK; sr_[i].ks = *reinterpret_cast<const bf16x8*>(Kh + (k0_ + ksr) * ld + ksc); \
    sr_[i].vs0 = *reinterpret_cast<const bf16x8*>(Vh + (k0_ + vsr) * ld + vsc); \
    if constexpr (NCB == 4) sr_[i].vs1 = *reinterpret_cast<const bf16x8*>(Vh + (k0_ + vsr + 32) * ld + vsc); } while (0)
#define ATT_SWRITE(b, i) do { *(bf16x8*)(K_lds + (b) * SHM_K + kst) = sr_[i].ks; *(bf16x8*)(V_lds + (b) * SHM_V + vst0) = sr_[i].vs0; \
    if constexpr (NCB == 4) *(bf16x8*)(V_lds + (b) * SHM_V + vst1) = sr_[i].vs1; } while (0)
#define ATT_RESC(a) do { if (__any((a) < 1.f)) { if (hi == 0) al_l[r32] = (a); asm volatile("s_waitcnt lgkmcnt(0)" ::: "memory"); \
    _Pragma("unroll") for (int r = 0; r < 16; ++r) { const float al_ = al_l[crow(r, hi)]; _Pragma("unroll") for (int d = 0; d < NCB; ++d) o[d][r] *= al_; } } } while (0)
#define ATT_MASK(P0, P1, t) do { if constexpr (WINDOW) wmask(P0, P1, dq0 + (t) * KVBLK, hi); } while (0)
  f32x16 pA0, pA1, pB0, pB1; float mnA, mnB, alA, alB; bf16x8 pa0, pa1, pa2, pa3; const int NT = ntiles;
  ATT_SLOAD(0, 0); asm volatile("s_waitcnt vmcnt(0)" ::: "memory"); ATT_SWRITE(0, 0); __syncthreads();
  qkt(pA0, pA1, K_lds, qr, r32, hi); ATT_MASK(pA0, pA1, 0); partialSM(pA0, pA1, m_reg, mnA, alA);
  ATT_SLOAD(1, 1); if (2 < NT) ATT_SLOAD(0, 2);
  ATT_SWRITE(1, 1); __syncthreads();
  for (int j = 1; j + 1 < NT; j += 2) {
    ATT_SBAR(); qkt(pB0, pB1, K_lds + SHM_K, qr, r32, hi); ATT_MASK(pB0, pB1, j);
    finishSM(pA0, pA1, alA, l_reg, pa0, pa1, pa2, pa3); ATT_SBAR();
    ATT_SLOAD(1, j + 2); ATT_SBAR();
    pv_all<NCB>(o, vb0, pa0, pa1, pa2, pa3); partialSM(pB0, pB1, m_reg, mnB, alB);
    __syncthreads(); ATT_SWRITE(0, 0);
    ATT_RESC(alB); __syncthreads();
    ATT_SBAR(); qkt(pA0, pA1, K_lds, qr, r32, hi); ATT_MASK(pA0, pA1, j + 1);
    finishSM(pB0, pB1, alB, l_reg, pa0, pa1, pa2, pa3); ATT_SBAR();
    if (j + 3 < NT) ATT_SLOAD(0, j + 3); ATT_SBAR();
    pv_all<NCB>(o, vb0 + SHM_V, pa0, pa1, pa2, pa3); partialSM(pA0, pA1, m_reg, mnA, alA);
    __syncthreads(); ATT_SWRITE(1, 1);
    ATT_RESC(alA); __syncthreads();
  }
  ATT_SBAR(); qkt(pB0, pB1, K_lds + SHM_K, qr, r32, hi); ATT_MASK(pB0, pB1, NT - 1);
  finishSM(pA0, pA1, alA, l_reg, pa0, pa1, pa2, pa3); ATT_SBAR();
  pv_all<NCB>(o, vb0, pa0, pa1, pa2, pa3); partialSM(pB0, pB1, m_reg, mnB, alB);
  __syncthreads(); ATT_RESC(alB);
  finishSM(pB0, pB1, alB, l_reg, pa0, pa1, pa2, pa3); ATT_SBAR();
  pv_all<NCB>(o, vb0 + SHM_V, pa0, pa1, pa2, pa3);
  l_reg += __builtin_amdgcn_exp2f(sink_l2 - m_reg);
  if (hi == 0) li_l[r32] = l_reg; asm volatile("s_waitcnt lgkmcnt(0)" ::: "memory");
#pragma unroll
  for (int r = 0; r < 16; ++r) { const float rl = __builtin_amdgcn_rcpf(li_l[crow(r, hi)]);
#pragma unroll
    for (int d = 0; d < NCB; ++d) o[d][r] *= rl; }
#undef ATT_SLOAD
#undef ATT_SWRITE
#undef ATT_RESC
#undef ATT_MASK
}
template <int NCB> __device__ __forceinline__ void store_o(const f32x16 (&o)[NCB], bf16* Ob, int ld, int lane) {
  const int r32 = lane & 31, hi = lane >> 5, odd = lane & 1;
#pragma unroll
  for (int d = 0; d < NCB; ++d)
#pragma unroll
    for (int r = 0; r < 16; r += 2) {
      const float send = odd ? o[d][r] : o[d][r + 1];
      const float recv = __shfl_xor(send, 1);
      const unsigned pk = odd ? cvtpk(recv, o[d][r + 1]) : cvtpk(o[d][r], recv);
      const int row = crow(r + odd, hi);
      *(unsigned*)(Ob + (long)row * ld + d * 32 + (r32 & ~1)) = pk;
    }
}
}


constexpr int NWAVES = 8;
constexpr int DM = 1024, NB = 32, SEQ = 2048, NTOK = NB * SEQ, DEPTH = 4, NE = 16, CAP = 256, FF = 2048, NROWS_E = NB * NE * CAP;
constexpr float RMS_EPS = 1e-6f;
constexpr float QSCALE = 0.125f * 1.4426950408889634f;
constexpr size_t MiB = 1u << 20;
constexpr size_t WS_CTL = 0, CTL_ZERO_BYTES = 64 * 1024;
constexpr size_t WS_TAB = 1 * MiB;
constexpr size_t WS_MISC = 2 * MiB;
constexpr size_t WS_AFF = 3 * MiB;
constexpr size_t WS_GATE = 7 * MiB;
constexpr size_t WS_SLOT = 8 * MiB;
constexpr size_t WS_WATT = 10 * MiB, WATT_STRIDE = 8 * MiB, WATT_O = 6 * MiB;
constexpr size_t WS_WMOE = 42 * MiB, WMOE_STRIDE = 192 * MiB, WMOE_D = 128 * MiB;
constexpr size_t WS_H = 810 * MiB;
constexpr size_t WS_BIG = 938 * MiB;
constexpr size_t WS_ATT = WS_BIG + 384 * MiB;
constexpr size_t WS_XE = 1450 * MiB;
constexpr size_t WS_END = 1706 * MiB;
constexpr int CW_BAR = 1024;
constexpr int RING_BYTES = 131072, LDSCTL_OFF = 146432, MISC_OFF = LDSCTL_OFF + 320, LDS_BYTES = 147456;

#define GAS __attribute__((address_space(1)))
#define LAS __attribute__((address_space(3)))
typedef unsigned short bf16;
typedef unsigned v4u __attribute__((ext_vector_type(4)));
typedef unsigned v2u __attribute__((ext_vector_type(2)));
typedef float f32x4 __attribute__((ext_vector_type(4)));
#define LDS_WAIT() asm volatile("s_waitcnt lgkmcnt(0)" ::: "memory")
#define VM_WAIT() asm volatile("s_waitcnt vmcnt(0)" ::: "memory")
__device__ __forceinline__ unsigned pk2(float lo, float hi) { unsigned r; asm volatile("v_cvt_pk_bf16_f32 %0, %1, %2" : "=v"(r) : "v"(lo), "v"(hi)); return r; }
__device__ __forceinline__ float bflo(unsigned w) { return __uint_as_float(w << 16); }
__device__ __forceinline__ float bfhi(unsigned w) { return __uint_as_float(w & 0xffff0000u); }


struct Args {
    const float* x; const float* attn_g; const float* ffn_g; const float* final_g;
    const float* w_in[4]; const float* w_o[4];
    const float* lq1[4]; const float* lk1[4]; const float* lq2[4]; const float* lk2[4]; const float* subln[4];
    const float* qn[4]; const float* kn[4];
    const float* sinks[4];
    const float* w_router; const float* w_gate; const float* w_up; const float* w_down;
    float* out; unsigned char* ws;
    int ph_lo, ph_hi;
};

__device__ __forceinline__ float wave_sum(float v) {
#pragma unroll
    for (int o = 1; o < 64; o <<= 1) v += __shfl_xor(v, o);
    return v;
}
__host__ __device__ __forceinline__ int dmap_axial(int u) { const int t = u >> 5, i = u & 31; return i < 16 ? i + 16 * t : 32 + (i - 16) + 16 * t; }

__device__ __forceinline__ void transpose_item(const float* W, size_t ldw, int srccol, bf16* WT, int K, int p0, int k0, LAS float* scr, int lane) {
    const float* src = W + (size_t)k0 * ldw + srccol;
#pragma unroll 16
    for (int kk = 0; kk < 64; ++kk) scr[kk * 65 + lane] = src[(size_t)kk * ldw];
    LDS_WAIT(); asm volatile("" ::: "memory");
    const int c = lane & 7;
#pragma unroll
    for (int j = 0; j < 8; ++j) { const int n = (lane >> 3) + 8 * j; const LAS float* s = scr + (8 * c) * 65 + n;
        v4u o; o.x = pk2(s[0 * 65], s[1 * 65]); o.y = pk2(s[2 * 65], s[3 * 65]); o.z = pk2(s[4 * 65], s[5 * 65]); o.w = pk2(s[6 * 65], s[7 * 65]);
        *(v4u*)(WT + (size_t)(p0 + n) * K + k0 + 8 * c) = o; }
    LDS_WAIT(); asm volatile("" ::: "memory");
}

__device__ __forceinline__ float row_rstd(const f32x4 (&v)[4]) {
    float s = 0.f;
#pragma unroll
    for (int j = 0; j < 4; ++j) s += (v[j].x * v[j].x + v[j].y * v[j].y) + (v[j].z * v[j].z + v[j].w * v[j].w);
    return __builtin_amdgcn_rsqf(wave_sum(s) * (1.0f / DM) + RMS_EPS);
}
__device__ __forceinline__ void store_row_bf16(bf16* orow, const f32x4 (&v)[4], int lane) {
    v2u* o8 = (v2u*)orow + lane;
#pragma unroll
    for (int j = 0; j < 4; ++j) { v2u w; w.x = pk2(v[j].x, v[j].y); w.y = pk2(v[j].z, v[j].w); o8[64 * j] = w; }
}


#define XB_TMO      128
#define XB_XCNT(j)  (256  + 64 * (j))
#define XB_XSUB(j)  (1280 + 64 * (j))
#define XB_XGEN(j)  (2304 + 64 * (j))
#define XB_TOP      3328
#define XB_TOPGEN   3392
#define XCD_BAR_WORDS 3456
#define XB_SPIN_CAP (1u << 18)

__device__ __forceinline__ unsigned xb_ld(unsigned* p)              { return __hip_atomic_load(p, __ATOMIC_RELAXED, __HIP_MEMORY_SCOPE_AGENT); }
__device__ __forceinline__ unsigned xb_add(unsigned* p, unsigned v) { return __hip_atomic_fetch_add(p, v, __ATOMIC_RELAXED, __HIP_MEMORY_SCOPE_AGENT); }
__device__ __forceinline__ unsigned xb_xcc_id() { return (unsigned)__builtin_amdgcn_s_getreg((3 << 11) | 20) & 0xFu; }
#define XB_SPIN(cond, bar) do { unsigned _sp = 0; while (cond) { __builtin_amdgcn_s_sleep(1); \
    if ((++_sp & 255u) == 0u) { if (xb_ld(&(bar)[XB_TMO])) break; if (_sp > XB_SPIN_CAP) { atomicAdd(&(bar)[XB_TMO], 1u); break; } } } } while (0)

struct XcdBarrier {
    unsigned* bar; unsigned x;
    volatile LAS unsigned* st;
};

__device__ __forceinline__ XcdBarrier xcd_barrier_post(unsigned* bar, volatile LAS unsigned* st) {
    XcdBarrier b; b.bar = bar; b.x = xb_xcc_id(); b.st = st;
    if (threadIdx.x == 0) (void)xb_add(&bar[XB_XCNT(b.x)], 1u);
    return b;
}
__device__ __forceinline__ void xcd_barrier_complete(unsigned* bar, unsigned x, unsigned& nloc, unsigned& nx) {
    const unsigned G = gridDim.x * gridDim.y * gridDim.z;
    unsigned sum, cnt, mine, sp = 0u;
    for (;;) {
        sum = 0u; cnt = 0u; mine = 0u;
#pragma unroll
        for (unsigned j = 0; j < 16; ++j) { const unsigned c = xb_ld(&bar[XB_XCNT(j)]); sum += c; cnt += (c > 0u) ? 1u : 0u; mine = (j == x) ? c : mine; }
        if (sum == G) break;
        __builtin_amdgcn_s_sleep(1);
        if ((++sp & 255u) == 0u) { if (xb_ld(&bar[XB_TMO])) break; if (sp > XB_SPIN_CAP) { atomicAdd(&bar[XB_TMO], 1u); break; } }
    }
    nloc = mine > 0u ? mine : 1u; nx = cnt > 0u ? cnt : 1u;
}

__device__ __forceinline__ void xcd_barrier(const XcdBarrier& b) {
    asm volatile("s_waitcnt vmcnt(0)" ::: "memory");
    __syncthreads();
    if (threadIdx.x == 0) {
        unsigned* bar = b.bar;
        __builtin_amdgcn_s_waitcnt(0);
        unsigned nloc = b.st[0], nx = b.st[1];
        if (nloc == 0u) { xcd_barrier_complete(bar, b.x, nloc, nx); b.st[0] = nloc; b.st[1] = nx; }
        const unsigned old = xb_add(&bar[XB_XSUB(b.x)], 1u);
        const unsigned gen = old / nloc;
        if (old + 1u == (gen + 1u) * nloc) {
            __builtin_amdgcn_fence(__ATOMIC_RELEASE, "agent");
            asm volatile("s_waitcnt vmcnt(0)" ::: "memory");
            const unsigned og = xb_add(&bar[XB_TOP], 1u);
            const unsigned tg = og / nx;
            if (og + 1u == (tg + 1u) * nx) xb_add(&bar[XB_TOPGEN], 1u);
            else XB_SPIN(xb_ld(&bar[XB_TOPGEN]) == tg, bar);
            __builtin_amdgcn_fence(__ATOMIC_ACQUIRE, "agent");
            xb_add(&bar[XB_XGEN(b.x)], 1u);
            asm volatile("s_waitcnt vmcnt(0)" ::: "memory");
        } else {
            XB_SPIN(xb_ld(&bar[XB_XGEN(b.x)]) == gen, bar);
            __builtin_amdgcn_fence(__ATOMIC_ACQUIRE, "agent");
            asm volatile("s_waitcnt vmcnt(0)" ::: "memory");
        }
    }
    __syncthreads();
}


__global__ void __launch_bounds__(NWAVES * 64, 2) mk_fwd(Args args) {
    extern __shared__ __attribute__((aligned(16))) unsigned char lds[];
    LAS unsigned char* ldsl = (LAS unsigned char*)lds;
    const int G = gridDim.x, bx = blockIdx.x;
    const int vcu = (G % 8 == 0) ? (bx % 8) * (G / 8) + bx / 8 : bx;
    const int NGW = G * NWAVES;
#define PHASE_IDS() const int tid = fresh_tid(), lane = tid & 63, wave = __builtin_amdgcn_readfirstlane(tid >> 6), gw = vcu * NWAVES + wave; (void)gw; (void)lane; (void)tid
    unsigned char* ws = args.ws;
    unsigned* ctl = (unsigned*)(ws + WS_CTL);
    float* tab = (float*)(ws + WS_TAB);
    float* gperm = (float*)(ws + WS_MISC);
    float* AFF = (float*)(ws + WS_AFF); float* GATE = (float*)(ws + WS_GATE); short* SLOT = (short*)(ws + WS_SLOT);
    bf16* H = (bf16*)(ws + WS_H); bf16* QKV = (bf16*)(ws + WS_BIG); bf16* ATT = (bf16*)(ws + WS_ATT); bf16* HID = (bf16*)(ws + WS_BIG); bf16* XE = (bf16*)(ws + WS_XE);
    float* XR = args.out;

    for (int u = threadIdx.x; u < (LDS_BYTES - LDSCTL_OFF) / 4; u += NWAVES * 64) ((LAS unsigned*)(ldsl + LDSCTL_OFF))[u] = 0u;
    __syncthreads();
    volatile LAS unsigned* MISC = (volatile LAS unsigned*)(ldsl + MISC_OFF);
    XcdBarrier bar = xcd_barrier_post(ctl + CW_BAR, MISC + 8);
    const int ph_lo = args.ph_lo, ph_hi = args.ph_hi; int ph = 0;
#define PHASE_ON() (ph >= ph_lo && ph < ph_hi)
#define PHASE_END() do { ++ph; if (ph > ph_lo && ph < ph_hi) xcd_barrier(bar); } while (0)

    if (PHASE_ON()) {
            PHASE_IDS();
        for (int i = gw * 64 + lane; i < 2 * SEQ * 32; i += NGW * 64) {
            const int which = i >> 16, s = (i >> 5) & 2047, f = i & 31; float ang;
            if (which == 0) ang = (float)s * exp2f(-(float)f * (13.287712379549449f / 32.0f));
            else ang = (float)(f < 16 ? (s >> 6) : (s & 63)) * exp2f(-(float)(f & 15) * (13.287712379549449f / 16.0f));
            tab[which * 131072 + s * 32 + f] = cosf(ang); tab[which * 131072 + 65536 + s * 32 + f] = sinf(ang);
        }
        if (gw == 0) { gperm[lane] = args.qn[1][dmap_axial(lane)]; gperm[64 + lane] = args.kn[1][dmap_axial(lane)]; }
        LAS float* scr = (LAS float*)(ldsl + wave * 16640);
        {
            constexpr int IT_A = 16 * 48 + 256, IT_B = 16 * 24 + 256, IT_ALL = 2 * IT_A + 2 * IT_B;
            for (int it = gw; it < IT_ALL; it += NGW) {
                int l, r = it;
                if (r < IT_A) l = 0; else { r -= IT_A; if (r < IT_B) l = 1; else { r -= IT_B; if (r < IT_B) l = 2; else { r -= IT_B; l = 3; } } }
                const int m = l % 3, n1 = (m == 0) ? 3072 : 1536, nin = 16 * (n1 / 64);
                bf16* wt = (bf16*)(ws + WS_WATT + (size_t)l * WATT_STRIDE);
                if (r < nin) { const int kb = r / (n1 / 64), pb = r % (n1 / 64), p = pb * 64 + lane;
                    const int pn = p >> 8, bj = (p >> 7) & 1, wc = (p >> 5) & 3, i = p & 31, hd = 4 * pn + wc, u = 32 * bj + i;
                    const int d = (m == 1 && hd < 20) ? dmap_axial(u) : u;
                    transpose_item(args.w_in[l], (size_t)n1, 64 * hd + d, wt, DM, pb * 64, kb * 64, scr, lane);
                } else { r -= nin; const int kb = r / 16, pb = r % 16;
                    transpose_item(args.w_o[l], (size_t)DM, pb * 64 + lane, (bf16*)((unsigned char*)wt + WATT_O), DM, pb * 64, kb * 64, scr, lane); }
            }
        }
        for (int it = gw; it < DEPTH * NE * 1536; it += NGW) {
            const int le = it / 1536, r = it % 1536, l = le >> 4, e = le & 15;
            bf16* wgu = (bf16*)(ws + WS_WMOE + (size_t)l * WMOE_STRIDE) + (size_t)e * 4096 * DM;
            bf16* wd = (bf16*)(ws + WS_WMOE + (size_t)l * WMOE_STRIDE + WMOE_D) + (size_t)e * DM * FF;
            if (r < 1024) { const int kb = r >> 6, pb = r & 63, bjj = (pb >> 1) & 1;
                const float* srcm = (bjj ? args.w_up : args.w_gate) + (size_t)le * DM * FF;
                transpose_item(srcm, (size_t)FF, 128 * (pb >> 2) + 64 * (pb & 1) + lane, wgu, DM, pb * 64, kb * 64, scr, lane);
            } else { const int r2 = r - 1024, kb = r2 >> 4, pb = r2 & 15;
                transpose_item(args.w_down + (size_t)le * FF * DM, (size_t)DM, pb * 64 + lane, wd, FF, pb * 64, kb * 64, scr, lane); }
        }
        {
            f32x4 g[4];
#pragma unroll
            for (int j = 0; j < 4; ++j) g[j] = ((const f32x4*)args.attn_g)[lane + 64 * j];
            for (int m = gw; m < NTOK; m += NGW) {
                const f32x4* xr = (const f32x4*)(args.x + (size_t)m * DM) + lane; f32x4 v[4];
#pragma unroll
                for (int j = 0; j < 4; ++j) v[j] = xr[64 * j];
                const float rstd = row_rstd(v);
#pragma unroll
                for (int j = 0; j < 4; ++j) v[j] = v[j] * rstd * g[j];
                store_row_bf16(H + (size_t)m * DM, v, lane);
            }
        }
    }
    PHASE_END();

    for (int layer = 0; layer < DEPTH; ++layer) {
        const int mix = layer % 3;
        const int n1 = (mix == 0) ? 3072 : 1536;
        const bf16* Win_t = (const bf16*)(ws + WS_WATT + (size_t)layer * WATT_STRIDE);
        const bf16* Wo_t = (const bf16*)(ws + WS_WATT + (size_t)layer * WATT_STRIDE + WATT_O);
        const bf16* Wgu_t = (const bf16*)(ws + WS_WMOE + (size_t)layer * WMOE_STRIDE);
        const bf16* Wd_t = (const bf16*)(ws + WS_WMOE + (size_t)layer * WMOE_STRIDE + WMOE_D);

        if (layer > 0) {
            if (PHASE_ON()) {
            PHASE_IDS();
                f32x4 g[4];
#pragma unroll
                for (int j = 0; j < 4; ++j) g[j] = ((const f32x4*)(args.attn_g + layer * DM))[lane + 64 * j];
                for (int m = gw; m < NTOK; m += NGW) {
                    f32x4* xr = (f32x4*)(XR + (size_t)m * DM) + lane; f32x4 v[4];
#pragma unroll
                    for (int j = 0; j < 4; ++j) v[j] = xr[64 * j];
                    const int sl = (lane < 16) ? (int)SLOT[(size_t)m * 16 + lane] : -1; const int b = m >> 11;
                    for (int e = 0; e < 16; ++e) { const int c = __builtin_amdgcn_readlane(sl, e);
                        if (c >= 0) { const v2u* yr = (const v2u*)(XE + ((size_t)((e * 32 + b) * 256 + c)) * DM) + lane;
#pragma unroll
                            for (int j = 0; j < 4; ++j) { const v2u w = yr[64 * j]; v[j].x += bflo(w.x); v[j].y += bfhi(w.x); v[j].z += bflo(w.y); v[j].w += bfhi(w.y); } } }
#pragma unroll
                    for (int j = 0; j < 4; ++j) xr[64 * j] = v[j];
                    const float rstd = row_rstd(v);
#pragma unroll
                    for (int j = 0; j < 4; ++j) v[j] = v[j] * rstd * g[j];
                    store_row_bf16(H + (size_t)m * DM, v, lane);
                }
            }
            PHASE_END();
        }

        if (PHASE_ON()) {
            PHASE_IDS();
            pg8::Gemm g{H, Win_t, NTOK, n1, DM}; pg8::StaticOrder S; S.init(NTOK, n1, G, bx);
            const float* tc = tab + (mix == 1 ? 131072 : 0);
            pg8::EpiQKV E{QKV, n1, tc, tc + 65536, (mix == 0) ? 8 : 5, 4, (mix == 1) ? gperm : nullptr, (mix == 1) ? gperm + 64 : nullptr, QSCALE};
            pg8::gemm_phase<pg8::EpiQKV, pg8::StaticOrder, true, true>(ldsl, g, S, E);
        }
        PHASE_END();

        if (PHASE_ON()) {
            PHASE_IDS();
            const int xq = bx & 7, jq = bx >> 3;
            if (mix == 0) {
                const int jl = layer / 3;
                const float lambda_init = (layer == 0) ? 0.2f : 0.55605820416f;
                const float s1 = wave_sum(args.lq1[layer][lane] * args.lk1[layer][lane]), s2 = wave_sum(args.lq2[layer][lane] * args.lk2[layer][lane]);
                const float lam = __expf(s1) - __expf(s2) + lambda_init; (void)jl;
                float gs[4];
#pragma unroll
                for (int d = 0; d < 4; ++d) gs[d] = args.subln[layer][32 * d + (lane & 31)] * (1.0f - lambda_init);
                unsigned* stash = (unsigned*)(lds + 65536);
                for (int i = 0;; ++i) {
                    const int v = (G == 256) ? (i * 8 + xq) * 32 + jq : i * G + bx; if (v >= NB * 8 * 8) break;
                    const int bh = v >> 3, qb = v & 7, b = bh >> 3, h = bh & 7;
                    const bf16* base = QKV + (size_t)(b * SEQ) * 3072;
                    att::f32x16 o[4];
#pragma unroll 1
                    for (int c = 0; c < 2; ++c) {
                        __syncthreads();
                        att::attn_core<4, false>(o, base + (size_t)(qb * 256) * 3072 + 64 * (2 * h + c), base + 1024 + 64 * (2 * h + c), base + 2048 + 128 * h, 3072, SEQ / 64, 0, 0,
                                                 -__builtin_inff(), (char*)lds);
                        if (c == 0) {
#pragma unroll
                            for (int d = 0; d < 4; ++d)
#pragma unroll
                                for (int q = 0; q < 8; ++q) stash[(d * 8 + q) * 512 + tid] = att::cvtpk(o[d][2 * q], o[d][2 * q + 1]);
                        }
                    }
                    float ss[16];
#pragma unroll
                    for (int r = 0; r < 16; ++r) ss[r] = 0.f;
#pragma unroll
                    for (int d = 0; d < 4; ++d)
#pragma unroll
                        for (int q = 0; q < 8; ++q) { const unsigned w = stash[(d * 8 + q) * 512 + tid];
                            const float a = bflo(w) - lam * o[d][2 * q], bq = bfhi(w) - lam * o[d][2 * q + 1];
                            o[d][2 * q] = a; o[d][2 * q + 1] = bq; ss[2 * q] += a * a; ss[2 * q + 1] += bq * bq; }
#pragma unroll
                    for (int r = 0; r < 16; ++r) { float s = ss[r]; s += __shfl_xor(s, 1); s += __shfl_xor(s, 2); s += __shfl_xor(s, 4); s += __shfl_xor(s, 8); s += __shfl_xor(s, 16);
                        const float rstd = __builtin_amdgcn_rsqf(s * (1.0f / 128.0f) + RMS_EPS);
#pragma unroll
                        for (int d = 0; d < 4; ++d) o[d][r] *= rstd * gs[d]; }
                    att::store_o<4>(o, ATT + (size_t)(b * SEQ + qb * 256 + wave * 32) * DM + 128 * h, DM, lane);
                }
            } else {
                for (int i = 0;; ++i) {
                    const int v = (G == 256) ? (i * 8 + xq) * 32 + jq : i * G + bx; if (v >= NB * 16 * 8) break;
                    const int grp = v >> 5, w = v & 31, b = grp >> 2, kvh = grp & 3, hq = kvh * 4 + (w >> 3), qb = w & 7;
                    const bf16* base = QKV + (size_t)(b * SEQ) * 1536;
                    att::f32x16 o[2];
                    __syncthreads();
                    if (mix == 1) {
                        att::attn_core<2, false>(o, base + (size_t)(qb * 256) * 1536 + 64 * hq, base + 1024 + 64 * kvh, base + 1280 + 64 * kvh, 1536, SEQ / 64, 0, 0, -__builtin_inff(), (char*)lds);
                    } else {
                        const int klo = (qb * 256 - 128) < 0 ? 0 : qb * 256 - 128, khi = (qb * 256 + 384) > SEQ ? SEQ : qb * 256 + 384;
                        att::attn_core<2, true>(o, base + (size_t)(qb * 256) * 1536 + 64 * hq, base + (size_t)klo * 1536 + 1024 + 64 * kvh, base + (size_t)klo * 1536 + 1280 + 64 * kvh, 1536,
                                                (khi - klo) / 64, qb * 256, klo, args.sinks[layer][hq] * 1.4426950408889634f, (char*)lds);
                    }
                    att::store_o<2>(o, ATT + (size_t)(b * SEQ + qb * 256 + wave * 32) * DM + 64 * hq, DM, lane);
                }
            }
        }
        PHASE_END();

        if (PHASE_ON()) {
            PHASE_IDS();
            pg8::Gemm g{ATT, Wo_t, NTOK, DM, DM}; pg8::StaticOrder S; S.init(NTOK, DM, G, bx);
            pg8::EpiResF32 E{layer == 0 ? args.x : (const float*)XR, XR, DM};
            pg8::gemm_phase<pg8::EpiResF32, pg8::StaticOrder, true, true>(ldsl, g, S, E);
        }
        PHASE_END();

        if (PHASE_ON()) {
            PHASE_IDS();
            LAS float* wr = (LAS float*)ldsl;
            const float* wsrc = args.w_router + (size_t)layer * DM * NE;
            for (int i4 = tid; i4 < DM * NE / 4; i4 += NWAVES * 64) { const f32x4 w = ((const f32x4*)wsrc)[i4]; const int col = i4 >> 2, e0 = (i4 & 3) * 4;
                wr[(e0 + 0) * DM + col] = w.x; wr[(e0 + 1) * DM + col] = w.y; wr[(e0 + 2) * DM + col] = w.z; wr[(e0 + 3) * DM + col] = w.w; }
            __syncthreads();
            f32x4 g[4];
#pragma unroll
            for (int j = 0; j < 4; ++j) g[j] = ((const f32x4*)(args.ffn_g + layer * DM))[lane + 64 * j];
            for (int m = gw; m < NTOK; m += NGW) {
                const f32x4* xr = (const f32x4*)(XR + (size_t)m * DM) + lane; f32x4 v[4];
#pragma unroll
                for (int j = 0; j < 4; ++j) v[j] = xr[64 * j];
                const float rstd = row_rstd(v);
#pragma unroll
                for (int j = 0; j < 4; ++j) v[j] = v[j] * rstd * g[j];
                store_row_bf16(H + (size_t)m * DM, v, lane);
                float lg[16];
#pragma unroll
                for (int e = 0; e < 16; ++e) { float a = 0.f;
#pragma unroll
                    for (int j = 0; j < 4; ++j) { const f32x4 w = *(const LAS f32x4*)(wr + e * DM + 256 * j + 4 * lane); a += (v[j].x * w.x + v[j].y * w.y) + (v[j].z * w.z + v[j].w * w.w); }
                    lg[e] = wave_sum(a); }
                float mx = lg[0];
#pragma unroll
                for (int e = 1; e < 16; ++e) mx = fmaxf(mx, lg[e]);
                float sum = 0.f, mine = 0.f;
#pragma unroll
                for (int e = 0; e < 16; ++e) { const float p = __expf(lg[e] - mx); sum += p; mine = (lane == e) ? p : mine; }
                if (lane < 16) AFF[((size_t)(m >> 11) * 16 + lane) * SEQ + (m & 2047)] = mine / sum;
            }
            __syncthreads();
        }
        PHASE_END();

        if (PHASE_ON()) {
            PHASE_IDS();
            LAS unsigned* red = (LAS unsigned*)ldsl;
            LAS int* idxs = (LAS int*)(ldsl + 1024);
            for (int pair = bx; pair < NB * NE; pair += G) {
                const int b = pair >> 4, e = pair & 15;
                const f32x4 av = ((const f32x4*)(AFF + (size_t)pair * SEQ))[tid];
                const unsigned u0 = __float_as_uint(av.x), u1 = __float_as_uint(av.y), u2 = __float_as_uint(av.z), u3 = __float_as_uint(av.w);
                unsigned prefix = 0u;
                for (int bit = 30; bit >= 0; --bit) {
                    const unsigned cand = prefix | (1u << bit);
                    const unsigned cw = (unsigned)__popcll(__ballot(u0 >= cand)) + (unsigned)__popcll(__ballot(u1 >= cand)) + (unsigned)__popcll(__ballot(u2 >= cand)) + (unsigned)__popcll(__ballot(u3 >= cand));
                    LAS unsigned* rb = red + (bit & 1) * 8;
                    if (lane == 0) rb[wave] = cw;
                    __syncthreads();
                    unsigned tot = 0;
#pragma unroll
                    for (int w = 0; w < 8; ++w) tot += rb[w];
                    if (tot >= (unsigned)CAP) prefix = cand;
                }
                const unsigned T = prefix;
                const unsigned g0 = u0 > T, g1 = u1 > T, g2 = u2 > T, g3 = u3 > T, q0 = u0 == T, q1 = u1 == T, q2 = u2 == T, q3 = u3 == T;
                const unsigned packed = (g0 + g1 + g2 + g3) | ((q0 + q1 + q2 + q3) << 16);
                unsigned incl = packed;
#pragma unroll
                for (int off = 1; off < 64; off <<= 1) { const unsigned t = __shfl_up(incl, off); if (lane >= off) incl += t; }
                LAS unsigned* tot8 = red + 16;
                __syncthreads();
                if (lane == 63) tot8[wave] = incl;
                __syncthreads();
                unsigned woff = 0, all = 0;
#pragma unroll
                for (int w = 0; w < 8; ++w) { const unsigned t = tot8[w]; all += t; woff += (w < wave) ? t : 0u; }
                const unsigned excl = incl - packed + woff;
                int bg = (int)(excl & 0xffffu), be = (int)(excl >> 16); const int ngt = (int)(all & 0xffffu), need = CAP - ngt;
                const size_t rowbase = (size_t)(e * 32 + b) * 256;
                int sl[4]; const unsigned gg[4] = {g0, g1, g2, g3}, qq[4] = {q0, q1, q2, q3}; const float vv[4] = {av.x, av.y, av.z, av.w};
#pragma unroll
                for (int q = 0; q < 4; ++q) { int s = -1;
                    if (gg[q]) s = bg++; else if (qq[q]) { const int r = be++; s = (r < need) ? ngt + r : -1; }
                    sl[q] = s;
                    if (s >= 0) { idxs[s] = 4 * tid + q; GATE[rowbase + s] = vv[q]; }
                    SLOT[((size_t)(b * SEQ + 4 * tid + q)) * 16 + e] = (short)s; }
                __syncthreads();
                for (int r0 = wave; r0 < CAP; r0 += 32) {
                    v4u t[4][2];
#pragma unroll
                    for (int k = 0; k < 4; ++k) { const int tok = idxs[r0 + 8 * k]; const v4u* src = (const v4u*)(H + ((size_t)(b * SEQ + tok)) * DM) + lane; t[k][0] = src[0]; t[k][1] = src[64]; }
#pragma unroll
                    for (int k = 0; k < 4; ++k) { v4u* dst = (v4u*)(XE + (rowbase + r0 + 8 * k) * DM) + lane; dst[0] = t[k][0]; dst[64] = t[k][1]; }
                }
                __syncthreads();
            }
        }
        PHASE_END();

        if (PHASE_ON()) {
            PHASE_IDS();
            pg8::Gemm g{XE, Wgu_t, NROWS_E, NE * 4096, DM}; pg8::GroupedOrder<16> S; S.init(G, bx);
            pg8::EpiSwiGLU E{HID, FF};
            pg8::gemm_phase<pg8::EpiSwiGLU, pg8::GroupedOrder<16>, true, true>(ldsl, g, S, E);
        }
        PHASE_END();

        if (PHASE_ON()) {
            PHASE_IDS();
            pg8::Gemm g{HID, Wd_t, NROWS_E, NE * DM, FF}; pg8::GroupedOrder<4> S; S.init(G, bx);
            pg8::EpiDown E{XE, DM, GATE};
            pg8::gemm_phase<pg8::EpiDown, pg8::GroupedOrder<4>, true, true>(ldsl, g, S, E);
        }
        PHASE_END();
    }

    if (PHASE_ON()) {
            PHASE_IDS();
        f32x4 g[4];
#pragma unroll
        for (int j = 0; j < 4; ++j) g[j] = ((const f32x4*)args.final_g)[lane + 64 * j];
        for (int m = gw; m < NTOK; m += NGW) {
            f32x4* xr = (f32x4*)(XR + (size_t)m * DM) + lane; f32x4 v[4];
#pragma unroll
            for (int j = 0; j < 4; ++j) v[j] = xr[64 * j];
            const int sl = (lane < 16) ? (int)SLOT[(size_t)m * 16 + lane] : -1; const int b = m >> 11;
            for (int e = 0; e < 16; ++e) { const int c = __builtin_amdgcn_readlane(sl, e);
                if (c >= 0) { const v2u* yr = (const v2u*)(XE + ((size_t)((e * 32 + b) * 256 + c)) * DM) + lane;
#pragma unroll
                    for (int j = 0; j < 4; ++j) { const v2u w = yr[64 * j]; v[j].x += bflo(w.x); v[j].y += bfhi(w.x); v[j].z += bflo(w.y); v[j].w += bfhi(w.y); } } }
            const float rstd = row_rstd(v);
#pragma unroll
            for (int j = 0; j < 4; ++j) xr[64 * j] = v[j] * rstd * g[j];
        }
    }
#undef PHASE_ON
#undef PHASE_END
}

extern "C" void kernel_launch(void* const* d_in, const int* in_sizes, int n_in, void* d_out, int out_size, void* d_ws, size_t ws_size, hipStream_t stream) {
    static int grid = 0;
    if (grid == 0) {
        if (n_in != 22 || in_sizes[0] != NTOK * DM || out_size != NTOK * DM || ws_size < WS_END) {
            fprintf(stderr, "kernel_launch: shape/workspace mismatch (n_in %d, in0 %d, out %d, ws %zu < %zu)\n", n_in, n_in > 0 ? in_sizes[0] : -1, out_size, ws_size, (size_t)WS_END); grid = -1; return; }
        int dev = 0, cus = 0;
        if (hipGetDevice(&dev) != hipSuccess || hipDeviceGetAttribute(&cus, hipDeviceAttributeMultiprocessorCount, dev) != hipSuccess) { grid = -1; return; }
        if (hipFuncSetAttribute((const void*)mk_fwd, hipFuncAttributeMaxDynamicSharedMemorySize, LDS_BYTES) != hipSuccess) { fprintf(stderr, "kernel_launch: hipFuncSetAttribute failed\n"); grid = -1; return; }
        int per_cu = 0;
        if (hipOccupancyMaxActiveBlocksPerMultiprocessor(&per_cu, (const void*)mk_fwd, NWAVES * 64, LDS_BYTES) != hipSuccess || per_cu < 1) fprintf(stderr, "kernel_launch: occupancy query says %d\n", per_cu);
        (void)hipGetLastError();
        grid = cus;
    }
    if (grid < 0) return;
    (void)hipMemsetAsync((char*)d_ws + WS_CTL, 0, CTL_ZERO_BYTES, stream);
    Args a{};
    const float* const* in = (const float* const*)d_in;
    a.x = in[0]; a.attn_g = in[1]; a.ffn_g = in[2]; a.final_g = in[3];
    for (int l = 0; l < 4; ++l) {
        const int m = l % 3, j = l / 3;
        a.w_in[l] = m == 0 ? in[4] + (size_t)j * DM * 3072 : (m == 1 ? in[11] + (size_t)j * DM * 1536 : in[15] + (size_t)j * DM * 1536);
        a.w_o[l] = m == 0 ? in[5] + (size_t)j * DM * DM : (m == 1 ? in[12] + (size_t)j * DM * DM : in[16] + (size_t)j * DM * DM);
        a.lq1[l] = in[6] + j * 64; a.lk1[l] = in[7] + j * 64; a.lq2[l] = in[8] + j * 64; a.lk2[l] = in[9] + j * 64; a.subln[l] = in[10] + j * 128;
        a.qn[l] = in[13]; a.kn[l] = in[14]; a.sinks[l] = in[17];
        if (m != 0) { a.lq1[l] = in[6]; a.lk1[l] = in[7]; a.lq2[l] = in[8]; a.lk2[l] = in[9]; a.subln[l] = in[10]; }
    }
    a.w_router = in[18]; a.w_gate = in[19]; a.w_up = in[20]; a.w_down = in[21];
    a.out = (float*)d_out; a.ws = (unsigned char*)d_ws;
    a.ph_lo = 0; a.ph_hi = 1000;
    hipLaunchKernelGGL(mk_fwd, dim3(grid), dim3(NWAVES * 64), LDS_BYTES, stream, a);
    const hipError_t le = hipPeekAtLastError();
    if (le != hipSuccess) fprintf(stderr, "kernel_launch: launch failed: %s\n", hipGetErrorName(le));
}
```

```cpp
#include <hip/hip_runtime.h>
#include <cstdio>
#include <cstdint>
__device__ __forceinline__ int fresh_tid() { int t = threadIdx.x; asm volatile("" : "+v"(t)); return t; }
__device__ __forceinline__ float dpp_xor1(float v) { return __uint_as_float((unsigned)__builtin_amdgcn_update_dpp(0, (int)__float_as_uint(v), 0xB1, 0xF, 0xF, true)); }
__device__ __forceinline__ float dpp_xor2(float v) { return __uint_as_float((unsigned)__builtin_amdgcn_update_dpp(0, (int)__float_as_uint(v), 0x4E, 0xF, 0xF, true)); }
__device__ __forceinline__ float dpp_hmirror(float v) { return __uint_as_float((unsigned)__builtin_amdgcn_update_dpp(0, (int)__float_as_uint(v), 0x141, 0xF, 0xF, true)); }
__device__ __forceinline__ float dpp_mirror(float v) { return __uint_as_float((unsigned)__builtin_amdgcn_update_dpp(0, (int)__float_as_uint(v), 0x140, 0xF, 0xF, true)); }
__device__ __forceinline__ float sum_swap16(float v) { auto r = __builtin_amdgcn_permlane16_swap(__float_as_uint(v), __float_as_uint(v), false, false); return __uint_as_float(r[0]) + __uint_as_float(r[1]); }
__device__ __forceinline__ float sum_swap32(float v) { auto r = __builtin_amdgcn_permlane32_swap(__float_as_uint(v), __float_as_uint(v), false, false); return __uint_as_float(r[0]) + __uint_as_float(r[1]); }
__device__ __forceinline__ float sum16(float v) { v += dpp_xor1(v); v += dpp_xor2(v); v += dpp_hmirror(v); v += dpp_mirror(v); return v; }
__device__ __forceinline__ float sum32(float v) { return sum_swap16(sum16(v)); }
__device__ __forceinline__ float sum64(float v) { return sum_swap32(sum32(v)); }
namespace pg8 {
#define PG8_LAS __attribute__((address_space(3)))
typedef unsigned short bf16_t;
typedef short bf16x8 __attribute__((ext_vector_type(8)));
typedef float f32x4 __attribute__((ext_vector_type(4)));
typedef unsigned u32x4 __attribute__((ext_vector_type(4)));
constexpr int BM = 256, BK = 64, HALF = 128, HTB = HALF * BK * 2  , STAGE_BYTES = 8 * HTB, NXCD = 8, WGM = 8;

__host__ __device__ __forceinline__ int lds_byte(int r, int c) { const int st = (r >> 4) * 2 + (c >> 5), rr = r & 15, cc = c & 31, ob = rr * 64 + cc * 2; return st * 1024 + (ob ^ (((ob >> 9) & 1) << 5)); }
__host__ __device__ __forceinline__ void stage_rc(int b, int& R, int& C) { const int st = b / 1024, sb = b % 1024, swz = sb ^ (((sb >> 9) & 1) << 5); R = (st >> 1) * 16 + swz / 64; C = (st & 1) * 32 + (swz % 64) / 2; }
__host__ __device__ __forceinline__ int perm32(int rho) { const int n = rho >> 4, i = rho & 15; return 8 * (i >> 2) + 4 * n + (i & 3); }

struct Unit { int pm, pn; };
struct Gemm { const bf16_t* A; const bf16_t* Bt; int M, N, K; };

struct StaticOrder {
    int nM, nN, nwg, G, c;
    __host__ __device__ void init(int M, int N, int G_, int c_) { nM = M / BM; nN = N / BM; nwg = nM * nN; G = G_; c = c_; }
    __host__ __device__ bool next(int i, Unit& u) const {
        const long L = (long)i * G + c; if (L >= nwg) return false;
        int wgid = (int)L; { const int q = nwg / NXCD, r = nwg % NXCD, xcd = wgid % NXCD, off = wgid / NXCD; wgid = (xcd < r ? xcd * (q + 1) : r * (q + 1) + (xcd - r) * q) + off; }
        const int nig = WGM * nN, gid = wgid / nig, fm = gid * WGM, gsz = (nM - fm) < WGM ? (nM - fm) : WGM;
        u.pm = fm + ((wgid % nig) % gsz); u.pn = (wgid % nig) / gsz; return true;
    }
    __device__ __forceinline__ void a_ready(const Unit&) const {}
    __device__ __forceinline__ void done(const Unit&) const {}
};


template <int NNL> struct GroupedOrder {
    int G, c, nunits;
    __device__ void init(int G_, int c_) { G = G_; c = c_; nunits = 16 * 32 * NNL; }
    __device__ bool next(int i, Unit& u) const {
        const int L = i * G + c; if (L >= nunits) return false;
        if (G == 256) {
            const int x = c & 7, j = c >> 3;
            if (NNL == 16) { const int e = i >> 1, hh = i & 1; u.pm = e * 32 + 4 * x + (j & 3); u.pn = e * 16 + 8 * hh + (j >> 2); }
            else { const int e = 2 * i + (x >> 2); u.pm = e * 32 + 8 * (x & 3) + (j & 7); u.pn = e * NNL + (j >> 3); }
        } else { const int pmg = L / NNL; u.pm = pmg; u.pn = (pmg >> 5) * NNL + (L % NNL); }
        return true;
    }
    __device__ __forceinline__ void a_ready(const Unit&) const {}
    __device__ __forceinline__ void done(const Unit&) const {}
};

__device__ __forceinline__ unsigned cvt_pk_bf16(float lo, float hi) { unsigned r; asm volatile("v_cvt_pk_bf16_f32 %0, %1, %2" : "=v"(r) : "v"(lo), "v"(hi)); return r; }

struct EpiQKV {
    static constexpr bool PERM = true, AFTER_DRAIN = false;
    bf16_t* O; int ldc; const float* tcos; const float* tsin; int nrope, nq; const float* qg; const float* kg; float qscale;
    __device__ __forceinline__ void operator()(const f32x4 (&acc)[2][2][4][2], const Unit& u, int wr, int wc, int fr, int fq) const {
        const int row0 = u.pm * BM + wr * 64 + fr, col0 = u.pn * BM + wc * 64 + 8 * fq;
        const bool rope = u.pn < nrope; const float sc = (u.pn < nq) ? qscale : 1.0f;
        const float* gp = (u.pn < nq) ? qg : kg;
        f32x4 gv[2][2];
        if (rope && gp) {
#pragma unroll
            for (int bj = 0; bj < 2; ++bj)
#pragma unroll
                for (int n = 0; n < 2; ++n) gv[bj][n] = *(const f32x4*)(gp + 32 * bj + 8 * fq + 4 * n);
        }
#pragma unroll
        for (int ai = 0; ai < 2; ++ai)
#pragma unroll
            for (int m = 0; m < 4; ++m) {
                const int row = row0 + ai * HALF + m * 16;
                f32x4 v[2][2];
#pragma unroll
                for (int bj = 0; bj < 2; ++bj)
#pragma unroll
                    for (int n = 0; n < 2; ++n) v[bj][n] = acc[ai][bj][m][n];
                if (rope) {
                    if (gp) {
                        float ss = 0.f;
#pragma unroll
                        for (int bj = 0; bj < 2; ++bj)
#pragma unroll
                            for (int n = 0; n < 2; ++n) ss += (v[bj][n][0] * v[bj][n][0] + v[bj][n][1] * v[bj][n][1]) + (v[bj][n][2] * v[bj][n][2] + v[bj][n][3] * v[bj][n][3]);
                        ss = sum_swap32(sum_swap16(ss));
                        const float rstd = __builtin_amdgcn_rsqf(ss * (1.0f / 64.0f) + 1e-6f);
#pragma unroll
                        for (int bj = 0; bj < 2; ++bj)
#pragma unroll
                            for (int n = 0; n < 2; ++n) v[bj][n] = v[bj][n] * rstd * gv[bj][n];
                    }
                    const int s = row & 2047;
#pragma unroll
                    for (int n = 0; n < 2; ++n) {
                        const f32x4 c = *(const f32x4*)(tcos + s * 32 + 8 * fq + 4 * n), sn = *(const f32x4*)(tsin + s * 32 + 8 * fq + 4 * n);
                        const f32x4 x1 = v[0][n], x2 = v[1][n];
                        v[0][n] = x1 * c - x2 * sn; v[1][n] = x2 * c + x1 * sn;
                    }
                }
                bf16_t* rowp = O + (size_t)row * ldc + col0;
#pragma unroll
                for (int bj = 0; bj < 2; ++bj) { const f32x4 v0 = v[bj][0] * sc, v1 = v[bj][1] * sc;
                    u32x4 w; w.x = cvt_pk_bf16(v0[0], v0[1]); w.y = cvt_pk_bf16(v0[2], v0[3]); w.z = cvt_pk_bf16(v1[0], v1[1]); w.w = cvt_pk_bf16(v1[2], v1[3]);
                    *(u32x4*)(rowp + bj * 32) = w; }
            }
    }
};
struct EpiResF32 {
    static constexpr bool PERM = false, AFTER_DRAIN = false;
    const float* base; float* C; int ldc;
    __device__ __forceinline__ void operator()(const f32x4 (&acc)[2][2][4][2], const Unit& u, int wr, int wc, int fr, int fq) const {
        const int row0 = u.pm * BM + wr * 64 + fr, col0 = u.pn * BM + wc * 32 + 4 * fq;
#pragma unroll
        for (int ai = 0; ai < 2; ++ai)
#pragma unroll
            for (int m = 0; m < 4; ++m) { const size_t off = (size_t)(row0 + ai * HALF + m * 16) * ldc + col0;
                f32x4 bs[2][2];
#pragma unroll
                for (int bj = 0; bj < 2; ++bj)
#pragma unroll
                    for (int n = 0; n < 2; ++n) bs[bj][n] = *(const f32x4*)(base + off + bj * HALF + n * 16);
#pragma unroll
                for (int bj = 0; bj < 2; ++bj)
#pragma unroll
                    for (int n = 0; n < 2; ++n) *(f32x4*)(C + off + bj * HALF + n * 16) = acc[ai][bj][m][n] + bs[bj][n];
                asm volatile("" ::: "memory"); }
    }
};
struct EpiSwiGLU {
    static constexpr bool PERM = true, AFTER_DRAIN = false;
    bf16_t* O; int ldc;
    __device__ __forceinline__ void operator()(const f32x4 (&acc)[2][2][4][2], const Unit& u, int wr, int wc, int fr, int fq) const {
        const int row0 = u.pm * BM + wr * 64 + fr, col0 = (u.pn & 15) * HALF + wc * 32 + 8 * fq;
#pragma unroll
        for (int ai = 0; ai < 2; ++ai)
#pragma unroll
            for (int m = 0; m < 4; ++m) { bf16_t* rowp = O + (size_t)(row0 + ai * HALF + m * 16) * ldc + col0;
                f32x4 h[2];
#pragma unroll
                for (int n = 0; n < 2; ++n) { const f32x4 g = acc[ai][0][m][n], up = acc[ai][1][m][n];
#pragma unroll
                    for (int j = 0; j < 4; ++j) { const float e = __builtin_amdgcn_exp2f(g[j] * -1.4426950408889634f); h[n][j] = g[j] * __builtin_amdgcn_rcpf(1.0f + e) * up[j]; } }
                u32x4 w; w.x = cvt_pk_bf16(h[0][0], h[0][1]); w.y = cvt_pk_bf16(h[0][2], h[0][3]); w.z = cvt_pk_bf16(h[1][0], h[1][1]); w.w = cvt_pk_bf16(h[1][2], h[1][3]);
                *(u32x4*)rowp = w; }
    }
};
__device__ __forceinline__ unsigned cvt4_fp8(float a, float b, float c, float d) { int r = __builtin_amdgcn_cvt_pk_fp8_f32(a, b, 0, false); r = __builtin_amdgcn_cvt_pk_fp8_f32(c, d, r, true); return (unsigned)r; }
constexpr float W8_SCALE = 32.0f, W8_INV = 1.0f / 32.0f;
struct EpiSwiGLU8 {
    static constexpr bool PERM = true, AFTER_DRAIN = false;
    unsigned char* O; int ldc;
    __device__ __forceinline__ void operator()(const f32x4 (&acc)[2][2][4][2], const Unit& u, int wr, int wc, int fr, int fq) const {
        const int row0 = u.pm * BM + wr * 64 + fr, col0 = (u.pn & 15) * HALF + wc * 32 + 8 * fq;
#pragma unroll
        for (int ai = 0; ai < 2; ++ai)
#pragma unroll
            for (int m = 0; m < 4; ++m) { unsigned char* rowp = O + (size_t)(row0 + ai * HALF + m * 16) * ldc + col0;
                f32x4 h[2];
#pragma unroll
                for (int n = 0; n < 2; ++n) { const f32x4 g = acc[ai][0][m][n] * W8_INV, up = acc[ai][1][m][n] * W8_INV;
#pragma unroll
                    for (int j = 0; j < 4; ++j) { const float e = __builtin_amdgcn_exp2f(g[j] * -1.4426950408889634f); h[n][j] = g[j] * __builtin_amdgcn_rcpf(1.0f + e) * up[j]; } }
                typedef unsigned u32x2 __attribute__((ext_vector_type(2)));
                u32x2 w; w.x = cvt4_fp8(h[0][0], h[0][1], h[0][2], h[0][3]); w.y = cvt4_fp8(h[1][0], h[1][1], h[1][2], h[1][3]);
                *(u32x2*)rowp = w; }
    }
};
struct EpiDown {
    static constexpr bool PERM = true, AFTER_DRAIN = false;
    bf16_t* O; int ldc; const float* gate; float osc;
    __device__ __forceinline__ void operator()(const f32x4 (&acc)[2][2][4][2], const Unit& u, int wr, int wc, int fr, int fq) const {
        const int row0 = u.pm * BM + wr * 64 + fr, col0 = (u.pn & 3) * BM + wc * 32 + 8 * fq;
#pragma unroll
        for (int ai = 0; ai < 2; ++ai)
#pragma unroll
            for (int m = 0; m < 4; ++m) { const int row = row0 + ai * HALF + m * 16; const float gt = gate[row] * osc; bf16_t* rowp = O + (size_t)row * ldc + col0;
#pragma unroll
                for (int bj = 0; bj < 2; ++bj) { const f32x4 v0 = acc[ai][bj][m][0] * gt, v1 = acc[ai][bj][m][1] * gt;
                    u32x4 w; w.x = cvt_pk_bf16(v0[0], v0[1]); w.y = cvt_pk_bf16(v0[2], v0[3]); w.z = cvt_pk_bf16(v1[0], v1[1]); w.w = cvt_pk_bf16(v1[2], v1[3]);
                    *(u32x4*)(rowp + bj * HALF) = w; } }
    }
};


__device__ __forceinline__ void glds16s(const char* gbase, unsigned voff, unsigned lds_dst) {
    unsigned keep; const unsigned dst = __builtin_amdgcn_readfirstlane(lds_dst);
    asm volatile("s_mov_b32 %0, m0\n\ts_mov_b32 m0, %3\n\ts_nop 0\n\tglobal_load_lds_dwordx4 %1, %2\n\ts_mov_b32 m0, %0" : "=&s"(keep) : "v"(voff), "s"(gbase), "s"(dst) : "memory");
}
typedef int i32x4 __attribute__((ext_vector_type(4)));
typedef int i32x8 __attribute__((ext_vector_type(8)));
template <class Epi, class Sched, bool ALIGN_EPI = false, bool SP2 = false, bool F8 = false>
__device__ __forceinline__ void gemm_phase(PG8_LAS unsigned char* lds, const Gemm g, const Sched& S, const Epi& E) {
    const int tid = fresh_tid(), wid = __builtin_amdgcn_readfirstlane(tid >> 6), lane = tid & 63, wr = wid >> 2, wc = wid & 3, fr = lane & 15, fq = lane >> 4;
    const int K = F8 ? g.K / 2 : g.K, nt = K / BK;
    unsigned voffA[2], voffB[2];
#pragma unroll
    for (int i = 0; i < 2; ++i) { int R, C; stage_rc(tid * 16 + i * 8192, R, C); const int Rb = Epi::PERM ? ((R & ~31) + perm32(R & 31)) : R;
        voffA[i] = (unsigned)(R * K + C) * 2u; voffB[i] = (unsigned)(Rb * K + C) * 2u; }
    const size_t kstep = (size_t)(BK * 2);
    const size_t hstep = (size_t)HALF * K * 2;
    const size_t tstep = 2 * hstep;
    const unsigned ldsw = (unsigned)wid * 1024u;
    const int aoff = lds_byte(wr * 64 + fr, fq * 8), boff = lds_byte(wc * 32 + fr, fq * 8);
#define PG8_SA(b, h) (((b) * 2 + (h)) * HTB)
#define PG8_SB(b, h) ((4 + (b) * 2 + (h)) * HTB)
    int sc8 = 0x7f7f7f7f; asm volatile("" : "+v"(sc8));
    const unsigned ldsb = (unsigned)(uintptr_t)lds;
#define PG8_STAGE(bufoff, gbase, voff) do { _Pragma("unroll") for (int _i = 0; _i < 2; ++_i) \
        glds16s((const char*)(gbase), (voff)[_i], ldsb + (unsigned)(bufoff) + ldsw + (unsigned)(_i * 8192)); } while (0)
#define PG8_LDA(dst, b, h) do { _Pragma("unroll") for (int m = 0; m < 4; ++m) _Pragma("unroll") for (int k = 0; k < 2; ++k) dst[m][k] = *(const PG8_LAS bf16x8*)(lds + PG8_SA(b, h) + aoff + m * 2048 + k * 1024); } while (0)
#define PG8_LDB(dst, b, h) do { _Pragma("unroll") for (int n = 0; n < 2; ++n) _Pragma("unroll") for (int k = 0; k < 2; ++k) dst[n][k] = *(const PG8_LAS bf16x8*)(lds + PG8_SB(b, h) + boff + n * 2048 + k * 1024); } while (0)
#define PG8_CAT(x) __builtin_shufflevector(__builtin_bit_cast(i32x4, (x)[0]), __builtin_bit_cast(i32x4, (x)[1]), 0, 1, 2, 3, 4, 5, 6, 7)
#define PG8_MMA(ai, bj, At, Bt) do { __builtin_amdgcn_s_setprio(1); _Pragma("unroll") for (int m = 0; m < 4; ++m) _Pragma("unroll") for (int n = 0; n < 2; ++n) { \
        if constexpr (F8) acc[ai][bj][m][n] = __builtin_amdgcn_mfma_scale_f32_16x16x128_f8f6f4(PG8_CAT(Bt[n]), PG8_CAT(At[m]), acc[ai][bj][m][n], 0, 0, 0, sc8, 0, sc8); \
        else { _Pragma("unroll") for (int k = 0; k < 2; ++k) acc[ai][bj][m][n] = __builtin_amdgcn_mfma_f32_16x16x32_bf16(Bt[n][k], At[m][k], acc[ai][bj][m][n], 0, 0, 0); } } __builtin_amdgcn_s_setprio(0); } while (0)
#define PG8_WAIT_V(n) asm volatile("s_waitcnt vmcnt(" #n ")" ::: "memory")
#define PG8_WAIT_L(n) asm volatile("s_waitcnt lgkmcnt(" #n ")" ::: "memory")
#define PG8_BAR __builtin_amdgcn_s_barrier()
#define PG8_SCHED __builtin_amdgcn_sched_barrier(0)
    Unit cur, nxt; int ui = 0;
    if (!S.next(0, cur)) return;
    f32x4 acc[2][2][4][2];
#pragma unroll
    for (int a = 0; a < 2; ++a)
#pragma unroll
        for (int b = 0; b < 2; ++b)
#pragma unroll
            for (int m = 0; m < 4; ++m)
#pragma unroll
                for (int n = 0; n < 2; ++n) acc[a][b][m][n] = (f32x4){0.f, 0.f, 0.f, 0.f};
    bf16x8 At[4][2], B0[2][2], B1[2][2];
    const char* cA = (const char*)g.A + (size_t)cur.pm * tstep; const char* cB = (const char*)g.Bt + (size_t)cur.pn * tstep;
    S.a_ready(cur);
    if constexpr (SP2) {
        PG8_STAGE(PG8_SB(0, 0), cB, voffB); PG8_STAGE(PG8_SB(0, 1), cB + hstep, voffB); PG8_STAGE(PG8_SA(0, 0), cA, voffA); PG8_STAGE(PG8_SA(0, 1), cA + hstep, voffA);
        if (wr == 1) PG8_BAR;
        PG8_WAIT_V(2); PG8_BAR;
        PG8_STAGE(PG8_SB(1, 0), cB + kstep, voffB); PG8_STAGE(PG8_SA(1, 0), cA + kstep, voffA); PG8_STAGE(PG8_SB(1, 1), cB + hstep + kstep, voffB);
        PG8_WAIT_V(6); PG8_BAR;
    } else {
        PG8_STAGE(PG8_SB(0, 0), cB, voffB); PG8_STAGE(PG8_SA(0, 0), cA, voffA); PG8_STAGE(PG8_SB(0, 1), cB + hstep, voffB); PG8_STAGE(PG8_SA(0, 1), cA + hstep, voffA);
        if (wr == 1) PG8_BAR;
        PG8_WAIT_V(4); PG8_BAR;
        PG8_STAGE(PG8_SB(1, 0), cB + kstep, voffB); PG8_STAGE(PG8_SA(1, 0), cA + kstep, voffA); PG8_STAGE(PG8_SB(1, 1), cB + hstep + kstep, voffB);
        PG8_WAIT_V(6); PG8_BAR;
    }
    for (;;) {
        const bool has_next = S.next(ui + 1, nxt);
        const char* nA = has_next ? (const char*)g.A + (size_t)nxt.pm * tstep : cA; const char* nB = has_next ? (const char*)g.Bt + (size_t)nxt.pn * tstep : cB;
#pragma unroll 1
        for (int t = 0; t < nt; t += 2) {
            const bool last = (t == nt - 2);
            const char* a1 = cA + (size_t)(t + 1) * kstep;
            const char* a2 = last ? nA : cA + (size_t)(t + 2) * kstep; const char* b2 = last ? nB : cB + (size_t)(t + 2) * kstep;
            const char* a3 = a2 + kstep; const char* b3 = b2 + kstep;
            if (last && has_next) S.a_ready(nxt);
            if constexpr (SP2) {
            PG8_LDB(B0, 0, 0); PG8_LDB(B1, 0, 1); PG8_SCHED; PG8_LDA(At, 0, 0); PG8_STAGE(PG8_SA(1, 1), a1 + hstep, voffA);
            PG8_WAIT_V(8); PG8_WAIT_L(0); PG8_BAR; PG8_MMA(0, 0, At, B0); PG8_MMA(0, 1, At, B1); PG8_BAR; PG8_SCHED;
            PG8_LDA(At, 0, 1); PG8_STAGE(PG8_SB(0, 0), b2, voffB); PG8_STAGE(PG8_SB(0, 1), b2 + hstep, voffB); PG8_STAGE(PG8_SA(0, 0), a2, voffA);
            PG8_WAIT_V(8); PG8_WAIT_L(0); PG8_BAR; PG8_MMA(1, 0, At, B0); PG8_MMA(1, 1, At, B1); PG8_BAR; PG8_SCHED;
            PG8_LDB(B0, 1, 0); PG8_LDB(B1, 1, 1); PG8_SCHED; PG8_LDA(At, 1, 0); PG8_STAGE(PG8_SA(0, 1), a2 + hstep, voffA);
            PG8_WAIT_V(8); PG8_WAIT_L(0); PG8_BAR; PG8_MMA(0, 0, At, B0); PG8_MMA(0, 1, At, B1); PG8_BAR; PG8_SCHED;
            PG8_LDA(At, 1, 1); PG8_STAGE(PG8_SB(1, 0), b3, voffB); PG8_STAGE(PG8_SB(1, 1), b3 + hstep, voffB); PG8_STAGE(PG8_SA(1, 0), a3, voffA);
            PG8_WAIT_V(8); PG8_WAIT_L(0); PG8_BAR; PG8_MMA(1, 0, At, B0); PG8_MMA(1, 1, At, B1); PG8_BAR; PG8_SCHED;
            } else {
            PG8_LDB(B0, 0, 0); PG8_SCHED; PG8_LDA(At, 0, 0); PG8_STAGE(PG8_SA(1, 1), a1 + hstep, voffA);
            PG8_WAIT_L(8); PG8_BAR; PG8_WAIT_L(0); PG8_MMA(0, 0, At, B0); PG8_BAR; PG8_SCHED;
            PG8_LDB(B1, 0, 1); PG8_STAGE(PG8_SB(0, 0), b2, voffB);
            PG8_BAR; PG8_WAIT_L(0); PG8_MMA(0, 1, At, B1); PG8_BAR;
            PG8_LDA(At, 0, 1); PG8_STAGE(PG8_SA(0, 0), a2, voffA);
            PG8_BAR; PG8_WAIT_L(0); PG8_MMA(1, 0, At, B0); PG8_BAR; PG8_SCHED;
            PG8_STAGE(PG8_SB(0, 1), b2 + hstep, voffB);
            PG8_WAIT_V(6); PG8_BAR; PG8_MMA(1, 1, At, B1); PG8_BAR;
            PG8_LDB(B0, 1, 0); PG8_SCHED; PG8_LDA(At, 1, 0); PG8_STAGE(PG8_SA(0, 1), a2 + hstep, voffA);
            PG8_WAIT_L(8); PG8_BAR; PG8_WAIT_L(0); PG8_MMA(0, 0, At, B0); PG8_BAR; PG8_SCHED;
            PG8_LDB(B1, 1, 1); PG8_STAGE(PG8_SB(1, 0), b3, voffB);
            PG8_BAR; PG8_WAIT_L(0); PG8_MMA(0, 1, At, B1); PG8_BAR;
            PG8_LDA(At, 1, 1); PG8_STAGE(PG8_SA(1, 0), a3, voffA);
            PG8_BAR; PG8_WAIT_L(0); PG8_MMA(1, 0, At, B0); PG8_BAR; PG8_SCHED;
            PG8_STAGE(PG8_SB(1, 1), b3 + hstep, voffB);
            PG8_WAIT_V(6); PG8_BAR; PG8_MMA(1, 1, At, B1); PG8_BAR;
            }
        }
        if constexpr (ALIGN_EPI) { if (wr == 0) PG8_BAR; }
        if constexpr (!Epi::AFTER_DRAIN) { const int l_ = fresh_tid() & 63; E(acc, cur, wr, wc, l_ & 15, l_ >> 4); S.done(cur); }
        if (!has_next) break;
#pragma unroll
        for (int a = 0; a < 2; ++a)
#pragma unroll
            for (int b = 0; b < 2; ++b)
#pragma unroll
                for (int m = 0; m < 4; ++m)
#pragma unroll
                    for (int n = 0; n < 2; ++n) acc[a][b][m][n] = (f32x4){0.f, 0.f, 0.f, 0.f};
        cur = nxt; cA = nA; cB = nB; ++ui;
        if constexpr (ALIGN_EPI) { if (wr == 1) PG8_BAR; }
    }
    PG8_WAIT_V(0);
    if constexpr (!ALIGN_EPI) { if (wr == 0) PG8_BAR; }
    PG8_BAR;
    if constexpr (Epi::AFTER_DRAIN) { E.fused(acc, cur, wr, wc, fr, fq, lds, wid, lane); S.done(cur); }
#undef PG8_SA
#undef PG8_SB
#undef PG8_STAGE
#undef PG8_LDA
#undef PG8_LDB
#undef PG8_MMA
#undef PG8_CAT
#undef PG8_WAIT_V
#undef PG8_WAIT_L
#undef PG8_BAR
#undef PG8_SCHED
}
}


namespace att {
using bf16 = unsigned short;
using bf16x8 = __attribute__((ext_vector_type(8))) short;
using s16x4  = __attribute__((ext_vector_type(4))) short;
using f32x16 = __attribute__((ext_vector_type(16))) float;
using u32x4  = __attribute__((ext_vector_type(4))) unsigned;
constexpr int KVBLK = 64;
constexpr float THR = 8.f;
constexpr int SHM_K = KVBLK * 64 * 2;
#define ATT_KSWZ(row, colB) ((row) * 128 + ((colB) ^ ((((row) >> 1) & 7) << 4)))
#define ATT_SBAR() __builtin_amdgcn_sched_barrier(0)
__device__ __forceinline__ int crow(int r, int hi) { return (r & 3) + 8 * (r >> 2) + 4 * hi; }
__device__ __forceinline__ unsigned cvtpk(float lo, float hi) { unsigned r; asm volatile("v_cvt_pk_bf16_f32 %0, %1, %2" : "=v"(r) : "v"(lo), "v"(hi)); return r; }

__device__ __forceinline__ void partialSM(f32x16& p0, f32x16& p1, float& m_reg, float& mn, float& alpha) {
  float pmax = p0[0];
#pragma unroll
  for (int r = 1; r < 16; ++r) pmax = fmaxf(pmax, p0[r]);
#pragma unroll
  for (int r = 0; r < 16; ++r) pmax = fmaxf(pmax, p1[r]);
  { auto rr = __builtin_amdgcn_permlane32_swap(__float_as_uint(pmax), __float_as_uint(pmax), false, false);
    pmax = fmaxf(__uint_as_float(rr[0]), __uint_as_float(rr[1])); }
  if (__builtin_expect(__all(pmax - m_reg <= THR), 1)) { mn = m_reg; alpha = 1.f; }
  else { mn = fmaxf(m_reg, pmax); alpha = __builtin_amdgcn_exp2f(m_reg - mn); m_reg = mn; }
#pragma unroll
  for (int r = 0; r < 16; ++r) p0[r] = p0[r] - mn;
#pragma unroll
  for (int r = 0; r < 16; ++r) p1[r] = p1[r] - mn;
#pragma unroll
  for (int r = 0; r < 16; ++r) p0[r] = __builtin_amdgcn_exp2f(p0[r]);
}
__device__ __forceinline__ void finishSM(f32x16& p0, f32x16& p1, float alpha, float& l_reg, bf16x8& pa0, bf16x8& pa1, bf16x8& pa2, bf16x8& pa3) {
#pragma unroll
  for (int r = 0; r < 16; ++r) p1[r] = __builtin_amdgcn_exp2f(p1[r]);
  float ps = 0;
#pragma unroll
  for (int r = 0; r < 16; ++r) ps += p0[r];
#pragma unroll
  for (int r = 0; r < 16; ++r) ps += p1[r];
  { auto rr = __builtin_amdgcn_permlane32_swap(__float_as_uint(ps), __float_as_uint(ps), false, false);
    ps = __uint_as_float(rr[0]) + __uint_as_float(rr[1]); }
  l_reg = l_reg * alpha + ps;
#define ATT_PK4(P, BASE, OUT) do { unsigned a0 = cvtpk(P[BASE + 0], P[BASE + 1]), a1 = cvtpk(P[BASE + 2], P[BASE + 3]);   \
    unsigned b0 = cvtpk(P[BASE + 4], P[BASE + 5]), b1 = cvtpk(P[BASE + 6], P[BASE + 7]);                              \
    auto r0 = __builtin_amdgcn_permlane32_swap(a0, b0, false, false); auto r1 = __builtin_amdgcn_permlane32_swap(a1, b1, false, false); \
    u32x4 w = {r0[0], r1[0], r0[1], r1[1]}; OUT = *reinterpret_cast<bf16x8*>(&w); } while (0)
  ATT_PK4(p0, 0, pa0); ATT_PK4(p0, 8, pa1); ATT_PK4(p1, 0, pa2); ATT_PK4(p1, 8, pa3);
#undef ATT_PK4
}
__device__ __forceinline__ void qkt(f32x16& p0, f32x16& p1, const char* Ks, const bf16x8* qr, int r32, int hi) {
  p0 = f32x16{}; p1 = f32x16{};
#pragma unroll
  for (int d0 = 0; d0 < 4; ++d0) { const int cb = (d0 * 16 + hi * 8) * 2;
    bf16x8 b0 = *reinterpret_cast<const bf16x8*>(Ks + ATT_KSWZ(r32, cb));
    bf16x8 b1 = *reinterpret_cast<const bf16x8*>(Ks + ATT_KSWZ(32 + r32, cb));
    p0 = __builtin_amdgcn_mfma_f32_32x32x16_bf16(b0, qr[d0], p0, 0, 0, 0);
    p1 = __builtin_amdgcn_mfma_f32_32x32x16_bf16(b1, qr[d0], p1, 0, 0, 0); }
}
__device__ __forceinline__ void wmask(f32x16& p0, f32x16& p1, int dq  , int hi) {
  const float ninf = -__builtin_inff();
#pragma unroll
  for (int r = 0; r < 16; ++r) { const unsigned d = (unsigned)(dq + crow(r, hi)); p0[r] = d <= 256u ? p0[r] : ninf; const unsigned d1 = d + 32u; p1[r] = d1 <= 256u ? p1[r] : ninf; }
}
template <int NCB> __device__ __forceinline__ int v_st(int k, int c) { const int kk = (k & ~0xC) | ((k & 4) << 1) | ((k & 8) >> 1); return ((kk >> 3) * NCB + (c >> 5)) * 512 + ((kk & 7) * 32 + (c & 31)) * 2; }
__device__ __forceinline__ int v_rd_base(int lane) { return ((lane & 3) << 3) | (((lane >> 2) & 3) << 6) | (((lane >> 4) & 1) << 5) | (((lane >> 5) & 1) << 8); }
template <int OFF> __device__ __forceinline__ s16x4 tr_read(int vb) {
  s16x4 r; asm volatile("ds_read_b64_tr_b16 %0, %1 offset:%2" : "=&v"(r) : "v"(vb), "i"(OFF) : "memory"); return r;
}
template <int NCB, int D0> __device__ __forceinline__ void pv_one(f32x16& od, int vb, bf16x8 pa0, bf16x8 pa1, bf16x8 pa2, bf16x8 pa3) {
#define ATT_VOFF(ks, half) (D0 * 512 + (ks) * (NCB * 1024) + (half) * (NCB * 512))
  const s16x4 l0 = tr_read<ATT_VOFF(0, 0)>(vb), h0 = tr_read<ATT_VOFF(0, 1)>(vb), l1 = tr_read<ATT_VOFF(1, 0)>(vb), h1 = tr_read<ATT_VOFF(1, 1)>(vb);
  const s16x4 l2 = tr_read<ATT_VOFF(2, 0)>(vb), h2 = tr_read<ATT_VOFF(2, 1)>(vb), l3 = tr_read<ATT_VOFF(3, 0)>(vb), h3 = tr_read<ATT_VOFF(3, 1)>(vb);
#undef ATT_VOFF
  asm volatile("s_waitcnt lgkmcnt(0)" ::: "memory"); ATT_SBAR();
#define ATT_PK(L, H) (bf16x8){L[0], L[1], L[2], L[3], H[0], H[1], H[2], H[3]}
  od = __builtin_amdgcn_mfma_f32_32x32x16_bf16(pa0, ATT_PK(l0, h0), od, 0, 0, 0);
  od = __builtin_amdgcn_mfma_f32_32x32x16_bf16(pa1, ATT_PK(l1, h1), od, 0, 0, 0);
  od = __builtin_amdgcn_mfma_f32_32x32x16_bf16(pa2, ATT_PK(l2, h2), od, 0, 0, 0);
  od = __builtin_amdgcn_mfma_f32_32x32x16_bf16(pa3, ATT_PK(l3, h3), od, 0, 0, 0);
#undef ATT_PK
}
template <int NCB> __device__ __forceinline__ void pv_all(f32x16* o, int vb, bf16x8 pa0, bf16x8 pa1, bf16x8 pa2, bf16x8 pa3) {
  pv_one<NCB, 0>(o[0], vb, pa0, pa1, pa2, pa3); pv_one<NCB, 1>(o[1], vb, pa0, pa1, pa2, pa3);
  if constexpr (NCB == 4) { pv_one<NCB, 2>(o[2], vb, pa0, pa1, pa2, pa3); pv_one<NCB, 3>(o[3], vb, pa0, pa1, pa2, pa3); }
}

template <int NCB, bool WINDOW>
__device__ __forceinline__ void attn_core(f32x16 (&o)[NCB], const bf16* __restrict__ Qb, const bf16* __restrict__ Kh, const bf16* __restrict__ Vh, int ld, int ntiles,
                                          int qpos0, int kpos0, float sink_l2, char* lds) {
  constexpr int SHM_V = KVBLK * 32 * NCB * 2;
  const int tid = fresh_tid(), wid = tid >> 6, lane = tid & 63, r32 = lane & 31, hi = lane >> 5;
  char* V_lds = lds; char* K_lds = lds + 2 * SHM_V;
  float* wsf = (float*)(lds + 2 * SHM_V + 2 * SHM_K) + wid * 64; float* li_l = wsf; float* al_l = wsf + 32;
  float m_reg = -1e30f, l_reg = 0; asm volatile("" : "+v"(m_reg));
#pragma unroll
  for (int d = 0; d < NCB; ++d) o[d] = f32x16{};
  bf16x8 qr[4];
  const bf16* Qw = Qb + (long)(wid * 32 + r32) * ld + hi * 8;
#pragma unroll
  for (int d0 = 0; d0 < 4; ++d0) qr[d0] = *reinterpret_cast<const bf16x8*>(Qw + d0 * 16);
  const int dq0 = kpos0 - (qpos0 + wid * 32 + r32) + 128;
  const int ksr = tid >> 3, ksc = (tid & 7) * 8, kst = ATT_KSWZ(ksr, ksc * 2);
  constexpr int VCPR = 4 * NCB;
  const int vsr = tid / VCPR, vsc = (tid % VCPR) * 8, vst0 = v_st<NCB>(vsr, vsc), vst1 = v_st<NCB>(vsr + 32, vsc);
  const int vb0 = (int)(uintptr_t)V_lds + v_rd_base(lane);
  struct { bf16x8 ks, vs0, vs1; } sr_[2];
#define ATT_SLOAD(i, t) do { const long k0_ = (long)(t) * KVBLK; sr_[i].ks = *reinterpret_cast<const bf16x8*>(Kh + (k0_ + ksr) * ld + ksc); \
    sr_[i].vs0 = *reinterpret_cast<const bf16x8*>(Vh + (k0_ + vsr) * ld + vsc); \
    if constexpr (NCB == 4) sr_[i].vs1 = *reinterpret_cast<const bf16x8*>(Vh + (k0_ + vsr + 32) * ld + vsc); } while (0)
#define ATT_SWRITE(b, i) do { *(bf16x8*)(K_lds + (b) * SHM_K + kst) = sr_[i].ks; *(bf16x8*)(V_lds + (b) * SHM_V + vst0) = sr_[i].vs0; \
    if constexpr (NCB == 4) *(bf16x8*)(V_lds + (b) * SHM_V + vst1) = sr_[i].vs1; } while (0)
#define ATT_RESC(a) do { if (__any((a) < 1.f)) { if (hi == 0) al_l[r32] = (a); asm volatile("s_waitcnt lgkmcnt(0)" ::: "memory"); \
    _Pragma("unroll") for (int r = 0; r < 16; ++r) { const float al_ = al_l[crow(r, hi)]; _Pragma("unroll") for (int d = 0; d < NCB; ++d) o[d][r] *= al_; } } } while (0)
#define ATT_MASK(P0, P1, t) do { if constexpr (WINDOW) wmask(P0, P1, dq0 + (t) * KVBLK, hi); } while (0)
  f32x16 pA0, pA1, pB0, pB1; float mnA, mnB, alA, alB; bf16x8 pa0, pa1, pa2, pa3; const int NT = ntiles;
  ATT_SLOAD(0, 0); asm volatile("s_waitcnt vmcnt(0)" ::: "memory"); ATT_SWRITE(0, 0); __syncthreads();
  qkt(pA0, pA1, K_lds, qr, r32, hi); ATT_MASK(pA0, pA1, 0); partialSM(pA0, pA1, m_reg, mnA, alA);
  ATT_SLOAD(1, 1); if (2 < NT) ATT_SLOAD(0, 2);
  ATT_SWRITE(1, 1); __syncthreads();
  for (int j = 1; j + 1 < NT; j += 2) {
    ATT_SBAR(); qkt(pB0, pB1, K_lds + SHM_K, qr, r32, hi); ATT_MASK(pB0, pB1, j);
    finishSM(pA0, pA1, alA, l_reg, pa0, pa1, pa2, pa3); ATT_SBAR();
    ATT_SLOAD(1, j + 2); ATT_SBAR();
    pv_all<NCB>(o, vb0, pa0, pa1, pa2, pa3); partialSM(pB0, pB1, m_reg, mnB, alB);
    __syncthreads(); ATT_SWRITE(0, 0);
    ATT_RESC(alB); __syncthreads();
    ATT_SBAR(); qkt(pA0, pA1, K_lds, qr, r32, hi); ATT_MASK(pA0, pA1, j + 1);
    finishSM(pB0, pB1, alB, l_reg, pa0, pa1, pa2, pa3); ATT_SBAR();
    if (j + 3 < NT) ATT_SLOAD(0, j + 3); ATT_SBAR();
    pv_all<NCB>(o, vb0 + SHM_V, pa0, pa1, pa2, pa3); partialSM(pA0, pA1, m_reg, mnA, alA);
    __syncthreads(); ATT_SWRITE(1, 1);
    ATT_RESC(alA); __syncthreads();
  }
  ATT_SBAR(); qkt(pB0, pB1, K_lds + SHM_K, qr, r32, hi); ATT_MASK(pB0, pB1, NT - 1);
  finishSM(pA0, pA1, alA, l_reg, pa0, pa1, pa2, pa3); ATT_SBAR();
  pv_all<NCB>(o, vb0, pa0, pa1, pa2, pa3); partialSM(pB0, pB1, m_reg, mnB, alB);
  __syncthreads(); ATT_RESC(alB);
  finishSM(pB0, pB1, alB, l_reg, pa0, pa1, pa2, pa3); ATT_SBAR();
  pv_all<NCB>(o, vb0 + SHM_V, pa0, pa1, pa2, pa3);
  l_reg += __builtin_amdgcn_exp2f(sink_l2 - m_reg);
  if (hi == 0) li_l[r32] = l_reg; asm volatile("s_waitcnt lgkmcnt(0)" ::: "memory");
#pragma unroll
  for (int r = 0; r < 16; ++r) { const float rl = __builtin_amdgcn_rcpf(li_l[crow(r, hi)]);
#pragma unroll
    for (int d = 0; d < NCB; ++d) o[d][r] *= rl; }
#undef ATT_SLOAD
#undef ATT_SWRITE
#undef ATT_RESC
#undef ATT_MASK
}
template <int NCB> __device__ __forceinline__ void store_o(const f32x16 (&o)[NCB], bf16* Ob, int ld, int lane) {
  const int r32 = lane & 31, hi = lane >> 5, odd = lane & 1;
#pragma unroll
  for (int d = 0; d < NCB; ++d)
#pragma unroll
    for (int r = 0; r < 16; r += 2) {
      const float send = odd ? o[d][r] : o[d][r + 1];
      const float recv = dpp_xor1(send);
      const unsigned pk = cvtpk(odd ? recv : o[d][r], odd ? o[d][r + 1] : recv);
      const int row = crow(r + odd, hi);
      *(unsigned*)(Ob + (long)row * ld + d * 32 + (r32 & ~1)) = pk;
    }
}
}


constexpr int NWAVES = 8;
constexpr int DM = 1024, NB = 32, SEQ = 2048, NTOK = NB * SEQ, DEPTH = 4, NE = 16, CAP = 256, FF = 2048, NROWS_E = NB * NE * CAP;
constexpr float RMS_EPS = 1e-6f;
constexpr float QSCALE = 0.125f * 1.4426950408889634f;
constexpr size_t MiB = 1u << 20;
constexpr size_t WS_CTL = 0, CTL_ZERO_BYTES = 64 * 1024;
constexpr size_t WS_TAB = 1 * MiB;
constexpr size_t WS_MISC = 2 * MiB;
constexpr size_t WS_AFF = 3 * MiB;
constexpr size_t WS_GATE = 7 * MiB;
constexpr size_t WS_SLOT = 8 * MiB;
constexpr size_t WS_WATT = 10 * MiB, WATT_STRIDE = 8 * MiB, WATT_O = 6 * MiB;
constexpr size_t WS_WMOE = 42 * MiB, WMOE_STRIDE = 96 * MiB, WMOE_D = 64 * MiB;
constexpr size_t WS_H = 426 * MiB;
constexpr size_t WS_H8 = 554 * MiB;
constexpr size_t WS_BIG = 618 * MiB;
constexpr size_t WS_ATT = WS_BIG + 384 * MiB;
constexpr size_t WS_XE = 1130 * MiB;
constexpr size_t WS_END = 1386 * MiB;
constexpr int CW_BAR = 1024;
constexpr int RING_BYTES = 131072, LDSCTL_OFF = 146432, MISC_OFF = LDSCTL_OFF + 320, LDS_BYTES = 147456;

#define GAS __attribute__((address_space(1)))
#define LAS __attribute__((address_space(3)))
typedef unsigned short bf16;
typedef unsigned v4u __attribute__((ext_vector_type(4)));
typedef unsigned v2u __attribute__((ext_vector_type(2)));
typedef float f32x4 __attribute__((ext_vector_type(4)));
#define LDS_WAIT() asm volatile("s_waitcnt lgkmcnt(0)" ::: "memory")
#define VM_WAIT() asm volatile("s_waitcnt vmcnt(0)" ::: "memory")
__device__ __forceinline__ unsigned pk2(float lo, float hi) { unsigned r; asm volatile("v_cvt_pk_bf16_f32 %0, %1, %2" : "=v"(r) : "v"(lo), "v"(hi)); return r; }
__device__ __forceinline__ float bflo(unsigned w) { return __uint_as_float(w << 16); }
__device__ __forceinline__ float bfhi(unsigned w) { return __uint_as_float(w & 0xffff0000u); }


struct Args {
    const float* x; const float* attn_g; const float* ffn_g; const float* final_g;
    const float* w_in[4]; const float* w_o[4];
    const float* lq1[4]; const float* lk1[4]; const float* lq2[4]; const float* lk2[4]; const float* subln[4];
    const float* qn[4]; const float* kn[4];
    const float* sinks[4];
    const float* w_router; const float* w_gate; const float* w_up; const float* w_down;
    float* out; unsigned char* ws;
    int ph_lo, ph_hi;
};

__device__ __forceinline__ float wave_sum(float v) { return sum64(v); }
__host__ __device__ __forceinline__ int dmap_axial(int u) { const int t = u >> 5, i = u & 31; return i < 16 ? i + 16 * t : 32 + (i - 16) + 16 * t; }

__device__ __forceinline__ void transpose_item(const float* W, size_t ldw, int srccol, bf16* WT, int K, int p0, int k0, LAS float* scr, int lane) {
    const float* src = W + (size_t)k0 * ldw + srccol;
#pragma unroll 16
    for (int kk = 0; kk < 64; ++kk) scr[kk * 65 + lane] = src[(size_t)kk * ldw];
    LDS_WAIT(); asm volatile("" ::: "memory");
    const int c = lane & 7;
#pragma unroll
    for (int j = 0; j < 8; ++j) { const int n = (lane >> 3) + 8 * j; const LAS float* s = scr + (8 * c) * 65 + n;
        v4u o; o.x = pk2(s[0 * 65], s[1 * 65]); o.y = pk2(s[2 * 65], s[3 * 65]); o.z = pk2(s[4 * 65], s[5 * 65]); o.w = pk2(s[6 * 65], s[7 * 65]);
        *(v4u*)(WT + (size_t)(p0 + n) * K + k0 + 8 * c) = o; }
    LDS_WAIT(); asm volatile("" ::: "memory");
}

__device__ __forceinline__ void transpose_item_f8(const float* W, size_t ldw, int srccol, unsigned char* WT, int KB, int p0, int k0, LAS float* scr, int lane, float scale) {
    const float* src = W + (size_t)k0 * ldw + srccol;
#pragma unroll 16
    for (int kk = 0; kk < 64; ++kk) scr[kk * 65 + lane] = src[(size_t)kk * ldw];
    LDS_WAIT(); asm volatile("" ::: "memory");
    const int c = lane & 3;
#pragma unroll
    for (int j = 0; j < 4; ++j) { const int n = (lane >> 2) + 16 * j; const LAS float* t = scr + (16 * c) * 65 + n;
        v4u o;
        o.x = pg8::cvt4_fp8(t[0 * 65] * scale, t[1 * 65] * scale, t[2 * 65] * scale, t[3 * 65] * scale);
        o.y = pg8::cvt4_fp8(t[4 * 65] * scale, t[5 * 65] * scale, t[6 * 65] * scale, t[7 * 65] * scale);
        o.z = pg8::cvt4_fp8(t[8 * 65] * scale, t[9 * 65] * scale, t[10 * 65] * scale, t[11 * 65] * scale);
        o.w = pg8::cvt4_fp8(t[12 * 65] * scale, t[13 * 65] * scale, t[14 * 65] * scale, t[15 * 65] * scale);
        *(v4u*)(WT + (size_t)(p0 + n) * KB + k0 + 16 * c) = o; }
    LDS_WAIT(); asm volatile("" ::: "memory");
}

__device__ __forceinline__ float row_rstd(const f32x4 (&v)[4]) {
    float s = 0.f;
#pragma unroll
    for (int j = 0; j < 4; ++j) s += (v[j].x * v[j].x + v[j].y * v[j].y) + (v[j].z * v[j].z + v[j].w * v[j].w);
    return __builtin_amdgcn_rsqf(wave_sum(s) * (1.0f / DM) + RMS_EPS);
}
__device__ __forceinline__ void store_row_bf16(bf16* orow, const f32x4 (&v)[4], int lane) {
    v2u* o8 = (v2u*)orow + lane;
#pragma unroll
    for (int j = 0; j < 4; ++j) { v2u w; w.x = pk2(v[j].x, v[j].y); w.y = pk2(v[j].z, v[j].w); o8[64 * j] = w; }
}


__device__ __forceinline__ void add_expert_rows(f32x4 (&v)[4], int sl, int b, const bf16* YE, int lane) {
    unsigned mask = (unsigned)__ballot(sl >= 0) & 0xffffu;
    while (mask) {
        v2u w[4][4]; bool ok[4];
#pragma unroll
        for (int k = 0; k < 4; ++k) {
            ok[k] = mask != 0u;
            if (ok[k]) { const int e = __builtin_ctz(mask); mask &= mask - 1u; const int c = __builtin_amdgcn_readlane(sl, e);
                const v2u* yr = (const v2u*)(YE + ((size_t)((e * 32 + b) * 256 + c)) * DM) + lane;
#pragma unroll
                for (int j = 0; j < 4; ++j) w[k][j] = yr[64 * j]; }
        }
#pragma unroll
        for (int k = 0; k < 4; ++k)
            if (ok[k]) {
#pragma unroll
                for (int j = 0; j < 4; ++j) { v[j].x += bflo(w[k][j].x); v[j].y += bfhi(w[k][j].x); v[j].z += bflo(w[k][j].y); v[j].w += bfhi(w[k][j].y); } }
    }
}


#define XB_TMO      128
#define XB_XCNT(j)  (256  + 64 * (j))
#define XB_XSUB(j)  (1280 + 64 * (j))
#define XB_XGEN(j)  (2304 + 64 * (j))
#define XB_TOP      3328
#define XB_TOPGEN   3392
#define XCD_BAR_WORDS 3456
#define XB_SPIN_CAP (1u << 18)

__device__ __forceinline__ unsigned xb_ld(unsigned* p)              { return __hip_atomic_load(p, __ATOMIC_RELAXED, __HIP_MEMORY_SCOPE_AGENT); }
__device__ __forceinline__ unsigned xb_add(unsigned* p, unsigned v) { return __hip_atomic_fetch_add(p, v, __ATOMIC_RELAXED, __HIP_MEMORY_SCOPE_AGENT); }
__device__ __forceinline__ unsigned xb_xcc_id() { return (unsigned)__builtin_amdgcn_s_getreg((3 << 11) | 20) & 0xFu; }
#define XB_SPIN(cond, bar) do { unsigned _sp = 0; while (cond) { __builtin_amdgcn_s_sleep(1); \
    if ((++_sp & 255u) == 0u) { if (xb_ld(&(bar)[XB_TMO])) break; if (_sp > XB_SPIN_CAP) { atomicAdd(&(bar)[XB_TMO], 1u); break; } } } } while (0)

struct XcdBarrier {
    unsigned* bar; unsigned x;
    volatile LAS unsigned* st;
};

__device__ __forceinline__ XcdBarrier xcd_barrier_post(unsigned* bar, volatile LAS unsigned* st) {
    XcdBarrier b; b.bar = bar; b.x = xb_xcc_id(); b.st = st;
    if (threadIdx.x == 0) (void)xb_add(&bar[XB_XCNT(b.x)], 1u);
    return b;
}
__device__ __forceinline__ void xcd_barrier_complete(unsigned* bar, unsigned x, unsigned& nloc, unsigned& nx) {
    const unsigned G = gridDim.x * gridDim.y * gridDim.z;
    unsigned sum, cnt, mine, sp = 0u;
    for (;;) {
        sum = 0u; cnt = 0u; mine = 0u;
#pragma unroll
        for (unsigned j = 0; j < 16; ++j) { const unsigned c = xb_ld(&bar[XB_XCNT(j)]); sum += c; cnt += (c > 0u) ? 1u : 0u; mine = (j == x) ? c : mine; }
        if (sum == G) break;
        __builtin_amdgcn_s_sleep(1);
        if ((++sp & 255u) == 0u) { if (xb_ld(&bar[XB_TMO])) break; if (sp > XB_SPIN_CAP) { atomicAdd(&bar[XB_TMO], 1u); break; } }
    }
    nloc = mine > 0u ? mine : 1u; nx = cnt > 0u ? cnt : 1u;
}

__device__ __forceinline__ void xcd_barrier(const XcdBarrier& b) {
    asm volatile("s_waitcnt vmcnt(0)" ::: "memory");
    __syncthreads();
    if (threadIdx.x == 0) {
        unsigned* bar = b.bar; asm volatile("" : "+s"(bar));
        __builtin_amdgcn_s_waitcnt(0);
        unsigned nloc = b.st[0], nx = b.st[1];
        if (nloc == 0u) { xcd_barrier_complete(bar, b.x, nloc, nx); b.st[0] = nloc; b.st[1] = nx; }
        const unsigned old = xb_add(&bar[XB_XSUB(b.x)], 1u);
        const unsigned gen = old / nloc;
        if (old + 1u == (gen + 1u) * nloc) {
            __builtin_amdgcn_fence(__ATOMIC_RELEASE, "agent");
            asm volatile("s_waitcnt vmcnt(0)" ::: "memory");
            const unsigned og = xb_add(&bar[XB_TOP], 1u);
            const unsigned tg = og / nx;
            if (og + 1u == (tg + 1u) * nx) xb_add(&bar[XB_TOPGEN], 1u);
            else XB_SPIN(xb_ld(&bar[XB_TOPGEN]) == tg, bar);
            __builtin_amdgcn_fence(__ATOMIC_ACQUIRE, "agent");
            xb_add(&bar[XB_XGEN(b.x)], 1u);
            asm volatile("s_waitcnt vmcnt(0)" ::: "memory");
        } else {
            XB_SPIN(xb_ld(&bar[XB_XGEN(b.x)]) == gen, bar);
            __builtin_amdgcn_fence(__ATOMIC_ACQUIRE, "agent");
            asm volatile("s_waitcnt vmcnt(0)" ::: "memory");
        }
    }
    __syncthreads();
}


__global__ void __launch_bounds__(NWAVES * 64, 2) mk_fwd(Args args) {
    extern __shared__ __attribute__((aligned(16))) unsigned char lds[];
    LAS unsigned char* ldsl = (LAS unsigned char*)lds;
    const int G = gridDim.x, bx = blockIdx.x;
    const int vcu = (G % 8 == 0) ? (bx % 8) * (G / 8) + bx / 8 : bx;
    const int NGW = G * NWAVES;
#define PHASE_IDS() const int tid = fresh_tid(), lane = tid & 63, wave = __builtin_amdgcn_readfirstlane(tid >> 6), gw = vcu * NWAVES + wave; (void)gw; (void)lane; (void)tid; unsigned char* ws = args.ws; asm volatile("" : "+s"(ws)); float* XR = args.out; asm volatile("" : "+s"(XR)); (void)XR
    unsigned* ctl = (unsigned*)(args.ws + WS_CTL);
#define tab ((float*)(ws + WS_TAB))
#define gperm ((float*)(ws + WS_MISC))
#define AFF ((float*)(ws + WS_AFF))
#define GATE ((float*)(ws + WS_GATE))
#define SLOT ((short*)(ws + WS_SLOT))
#define H ((bf16*)(ws + WS_H))
#define QKV ((bf16*)(ws + WS_BIG))
#define ATT ((bf16*)(ws + WS_ATT))
#define HID8 (ws + WS_BIG)
#define XE ((bf16*)(ws + WS_XE))
#define XE8 (ws + WS_XE)
#define H8 (ws + WS_H8)
    for (int u = threadIdx.x; u < (LDS_BYTES - LDSCTL_OFF) / 4; u += NWAVES * 64) ((LAS unsigned*)(ldsl + LDSCTL_OFF))[u] = 0u;
    __syncthreads();
    volatile LAS unsigned* MISC = (volatile LAS unsigned*)(ldsl + MISC_OFF);
    XcdBarrier bar = xcd_barrier_post(ctl + CW_BAR, MISC + 8);
    const int ph_lo = args.ph_lo, ph_hi = args.ph_hi; int ph = 0;
#define PHASE_ON() (ph >= ph_lo && ph < ph_hi)
#ifndef EN_P0
#define EN_P0 1
#endif
#ifndef EN_N1
#define EN_N1 1
#endif
#ifndef EN_G1
#define EN_G1 1
#endif
#ifndef EN_AT
#define EN_AT 1
#endif
#ifndef EN_ATA
#define EN_ATA 1
#endif
#ifndef EN_ATB
#define EN_ATB 1
#endif
#ifndef EN_G2
#define EN_G2 1
#endif
#ifndef EN_N2
#define EN_N2 1
#endif
#ifndef EN_TK
#define EN_TK 1
#endif
#ifndef EN_G3
#define EN_G3 1
#endif
#ifndef EN_G4
#define EN_G4 1
#endif
#ifndef EN_FIN
#define EN_FIN 1
#endif
#define PHASE_END() do { ++ph; if (ph > ph_lo && ph < ph_hi) xcd_barrier(bar); } while (0)

    if (EN_P0 && PHASE_ON()) {
            PHASE_IDS();
        for (int i = gw * 64 + lane; i < 2 * SEQ * 32; i += NGW * 64) {
            const int which = i >> 16, s = (i >> 5) & 2047, f = i & 31; float ang;
            if (which == 0) ang = (float)s * exp2f(-(float)f * (13.287712379549449f / 32.0f));
            else ang = (float)(f < 16 ? (s >> 6) : (s & 63)) * exp2f(-(float)(f & 15) * (13.287712379549449f / 16.0f));
            tab[which * 131072 + s * 32 + f] = cosf(ang); tab[which * 131072 + 65536 + s * 32 + f] = sinf(ang);
        }
        if (gw == 0) { gperm[lane] = args.qn[1][dmap_axial(lane)]; gperm[64 + lane] = args.kn[1][dmap_axial(lane)]; }
        LAS float* scr = (LAS float*)(ldsl + wave * 16640);
        {
            constexpr int IT_A = 16 * 48 + 256, IT_B = 16 * 24 + 256, IT_ALL = 2 * IT_A + 2 * IT_B;
            for (int it = gw; it < IT_ALL; it += NGW) {
                int l, r = it;
                if (r < IT_A) l = 0; else { r -= IT_A; if (r < IT_B) l = 1; else { r -= IT_B; if (r < IT_B) l = 2; else { r -= IT_B; l = 3; } } }
                const int m = l % 3, n1 = (m == 0) ? 3072 : 1536, nin = 16 * (n1 / 64);
                bf16* wt = (bf16*)(ws + WS_WATT + (size_t)l * WATT_STRIDE);
                if (r < nin) { const int kb = r / (n1 / 64), pb = r % (n1 / 64), p = pb * 64 + lane;
                    const int pn = p >> 8, bj = (p >> 7) & 1, wc = (p >> 5) & 3, i = p & 31, hd = 4 * pn + wc, u = 32 * bj + i;
                    const int d = (m == 1 && hd < 20) ? dmap_axial(u) : u;
                    transpose_item(args.w_in[l], (size_t)n1, 64 * hd + d, wt, DM, pb * 64, kb * 64, scr, lane);
                } else { r -= nin; const int kb = r / 16, pb = r % 16;
                    transpose_item(args.w_o[l], (size_t)DM, pb * 64 + lane, (bf16*)((unsigned char*)wt + WATT_O), DM, pb * 64, kb * 64, scr, lane); }
            }
        }
        for (int it = gw; it < DEPTH * NE * 1536; it += NGW) {
            const int le = it / 1536, r = it % 1536, l = le >> 4, e = le & 15;
            unsigned char* wgu = ws + WS_WMOE + (size_t)l * WMOE_STRIDE + (size_t)e * 4096 * DM;
            unsigned char* wd = ws + WS_WMOE + (size_t)l * WMOE_STRIDE + WMOE_D + (size_t)e * DM * FF;
            if (r < 1024) { const int kb = r >> 6, pb = r & 63, bjj = (pb >> 1) & 1;
                const float* srcm = (bjj ? args.w_up : args.w_gate) + (size_t)le * DM * FF;
                transpose_item_f8(srcm, (size_t)FF, 128 * (pb >> 2) + 64 * (pb & 1) + lane, wgu, DM, pb * 64, kb * 64, scr, lane, pg8::W8_SCALE);
            } else { const int r2 = r - 1024, kb = r2 >> 4, pb = r2 & 15;
                transpose_item_f8(args.w_down + (size_t)le * FF * DM, (size_t)DM, pb * 64 + lane, wd, FF, pb * 64, kb * 64, scr, lane, pg8::W8_SCALE); }
        }
        {
            f32x4 g[4];
#pragma unroll
            for (int j = 0; j < 4; ++j) g[j] = ((const f32x4*)args.attn_g)[lane + 64 * j];
            for (int m = gw; m < NTOK; m += NGW) {
                const f32x4* xr = (const f32x4*)(args.x + (size_t)m * DM) + lane; f32x4 v[4];
#pragma unroll
                for (int j = 0; j < 4; ++j) v[j] = xr[64 * j];
                const float rstd = row_rstd(v);
#pragma unroll
                for (int j = 0; j < 4; ++j) v[j] = v[j] * rstd * g[j];
                store_row_bf16(H + (size_t)m * DM, v, lane);
            }
        }
    }
    PHASE_END();

    for (int layer = 0; layer < DEPTH; ++layer) {
        const int mix = layer % 3;
        const int n1 = (mix == 0) ? 3072 : 1536;
#define Win_t ((const bf16*)(ws + WS_WATT + (size_t)layer * WATT_STRIDE))
#define Wo_t ((const bf16*)(ws + WS_WATT + (size_t)layer * WATT_STRIDE + WATT_O))
#define Wgu8 (ws + WS_WMOE + (size_t)layer * WMOE_STRIDE)
#define Wd8 (ws + WS_WMOE + (size_t)layer * WMOE_STRIDE + WMOE_D)

        if (layer > 0) {
            if (EN_N1 && PHASE_ON()) {
            PHASE_IDS();
                f32x4 g[4];
#pragma unroll
                for (int j = 0; j < 4; ++j) g[j] = ((const f32x4*)(args.attn_g + layer * DM))[lane + 64 * j];
                for (int m = gw; m < NTOK; m += 2 * NGW) {
                    const int m2 = (m + NGW < NTOK) ? m + NGW : m;
                    f32x4* xa = (f32x4*)(XR + (size_t)m * DM) + lane; f32x4* xb = (f32x4*)(XR + (size_t)m2 * DM) + lane; f32x4 va[4], vb[4];
#pragma unroll
                    for (int j = 0; j < 4; ++j) { va[j] = xa[64 * j]; vb[j] = xb[64 * j]; }
                    const int sla = (lane < 16) ? (int)SLOT[(size_t)m * 16 + lane] : -1, slb = (lane < 16) ? (int)SLOT[(size_t)m2 * 16 + lane] : -1;
                    add_expert_rows(va, sla, m >> 11, XE, lane);
                    add_expert_rows(vb, slb, m2 >> 11, XE, lane);
#pragma unroll
                    for (int j = 0; j < 4; ++j) xa[64 * j] = va[j];
                    const float ra = row_rstd(va);
#pragma unroll
                    for (int j = 0; j < 4; ++j) va[j] = va[j] * ra * g[j];
                    store_row_bf16(H + (size_t)m * DM, va, lane);
                    if (m2 != m) {
#pragma unroll
                        for (int j = 0; j < 4; ++j) xb[64 * j] = vb[j];
                        const float rb = row_rstd(vb);
#pragma unroll
                        for (int j = 0; j < 4; ++j) vb[j] = vb[j] * rb * g[j];
                        store_row_bf16(H + (size_t)m2 * DM, vb, lane);
                    }
                }
            }
            PHASE_END();
        }

        if (EN_G1 && PHASE_ON()) {
            PHASE_IDS();
            pg8::Gemm g{H, Win_t, NTOK, n1, DM}; pg8::StaticOrder S; S.init(NTOK, n1, G, bx);
            const float* tc = tab + (mix == 1 ? 131072 : 0);
            pg8::EpiQKV E{QKV, n1, tc, tc + 65536, (mix == 0) ? 8 : 5, 4, (mix == 1) ? gperm : nullptr, (mix == 1) ? gperm + 64 : nullptr, QSCALE};
            pg8::gemm_phase<pg8::EpiQKV, pg8::StaticOrder, true, true>(ldsl, g, S, E);
        }
        PHASE_END();

        if (EN_AT && PHASE_ON()) {
            PHASE_IDS();
            const int xq = bx & 7, jq = bx >> 3;
            if (EN_ATA && mix == 0) {
                const int jl = layer / 3;
                const float lambda_init = (layer == 0) ? 0.2f : 0.55605820416f;
                const float s1 = wave_sum(args.lq1[layer][lane] * args.lk1[layer][lane]), s2 = wave_sum(args.lq2[layer][lane] * args.lk2[layer][lane]);
                const float lam = __uint_as_float(__builtin_amdgcn_readfirstlane(__float_as_uint(__expf(s1) - __expf(s2) + lambda_init))); (void)jl;
                const float* subg = args.subln[layer];
                LAS unsigned* stash = (LAS unsigned*)(ldsl + 65536) + tid;
                for (int i = 0;; ++i) {
                    const int v = (G == 256) ? (i * 8 + xq) * 32 + jq : i * G + bx; if (v >= NB * 8 * 8) break;
                    const int bh = v >> 3, qb = v & 7, b = bh >> 3, h = bh & 7;
                    const bf16* base = QKV + (size_t)(b * SEQ) * 3072;
                    att::f32x16 o[4];
#pragma unroll 1
                    for (int c = 0; c < 2; ++c) {
                        __syncthreads();
                        att::attn_core<4, false>(o, base + (size_t)(qb * 256) * 3072 + 64 * (2 * h + c), base + 1024 + 64 * (2 * h + c), base + 2048 + 128 * h, 3072, SEQ / 64, 0, 0,
                                                 -__builtin_inff(), (char*)lds);
                        if (c == 0) {
#pragma unroll
                            for (int d = 0; d < 4; ++d)
#pragma unroll
                                for (int q = 0; q < 8; ++q) stash[(d * 8 + q) * 512] = att::cvtpk(o[d][2 * q], o[d][2 * q + 1]);
                        }
                    }
                    float ss[16], gs[4];
#pragma unroll
                    for (int d = 0; d < 4; ++d) gs[d] = subg[32 * d + (lane & 31)] * (1.0f - lambda_init);
#pragma unroll
                    for (int r = 0; r < 16; ++r) ss[r] = 0.f;
#pragma unroll
                    for (int d = 0; d < 4; ++d)
#pragma unroll
                        for (int q = 0; q < 8; ++q) { const unsigned w = stash[(d * 8 + q) * 512];
                            const float a = bflo(w) - lam * o[d][2 * q], bq = bfhi(w) - lam * o[d][2 * q + 1];
                            o[d][2 * q] = a; o[d][2 * q + 1] = bq; ss[2 * q] += a * a; ss[2 * q + 1] += bq * bq; }
#pragma unroll
                    for (int r = 0; r < 16; ++r) { const float s = sum32(ss[r]);
                        const float rstd = __builtin_amdgcn_rsqf(s * (1.0f / 128.0f) + RMS_EPS);
#pragma unroll
                        for (int d = 0; d < 4; ++d) o[d][r] *= rstd * gs[d]; }
                    att::store_o<4>(o, ATT + (size_t)(b * SEQ + qb * 256 + wave * 32) * DM + 128 * h, DM, lane);
                }
            } else if (EN_ATB) {
                for (int i = 0;; ++i) {
                    const int v = (G == 256) ? (i * 8 + xq) * 32 + jq : i * G + bx; if (v >= NB * 16 * 8) break;
                    const int grp = v >> 5, w = v & 31, b = grp >> 2, kvh = grp & 3, hq = kvh * 4 + (w >> 3), qb = w & 7;
                    const bf16* base = QKV + (size_t)(b * SEQ) * 1536;
                    att::f32x16 o[2];
                    __syncthreads();
                    if (mix == 1) {
                        att::attn_core<2, false>(o, base + (size_t)(qb * 256) * 1536 + 64 * hq, base + 1024 + 64 * kvh, base + 1280 + 64 * kvh, 1536, SEQ / 64, 0, 0, -__builtin_inff(), (char*)lds);
                    } else {
                        const int klo = (qb * 256 - 128) < 0 ? 0 : qb * 256 - 128, khi = (qb * 256 + 384) > SEQ ? SEQ : qb * 256 + 384;
                        att::attn_core<2, true>(o, base + (size_t)(qb * 256) * 1536 + 64 * hq, base + (size_t)klo * 1536 + 1024 + 64 * kvh, base + (size_t)klo * 1536 + 1280 + 64 * kvh, 1536,
                                                (khi - klo) / 64, qb * 256, klo, args.sinks[layer][hq] * 1.4426950408889634f, (char*)lds);
                    }
                    att::store_o<2>(o, ATT + (size_t)(b * SEQ + qb * 256 + wave * 32) * DM + 64 * hq, DM, lane);
                }
            }
        }
        PHASE_END();

        if (EN_G2 && PHASE_ON()) {
            PHASE_IDS();
            pg8::Gemm g{ATT, Wo_t, NTOK, DM, DM}; pg8::StaticOrder S; S.init(NTOK, DM, G, bx);
            pg8::EpiResF32 E{layer == 0 ? args.x : (const float*)XR, XR, DM};
            pg8::gemm_phase<pg8::EpiResF32, pg8::StaticOrder, true, true>(ldsl, g, S, E);
        }
        PHASE_END();

        if (EN_N2 && PHASE_ON()) {
            PHASE_IDS();
            LAS float* wr = (LAS float*)ldsl;
            const float* wsrc = args.w_router + (size_t)layer * DM * NE;
            for (int i4 = tid; i4 < DM * NE / 4; i4 += NWAVES * 64) { const f32x4 w = ((const f32x4*)wsrc)[i4]; const int col = i4 >> 2, e0 = (i4 & 3) * 4;
                wr[(e0 + 0) * DM + col] = w.x; wr[(e0 + 1) * DM + col] = w.y; wr[(e0 + 2) * DM + col] = w.z; wr[(e0 + 3) * DM + col] = w.w; }
            __syncthreads();
            f32x4 g[4];
#pragma unroll
            for (int j = 0; j < 4; ++j) g[j] = ((const f32x4*)(args.ffn_g + layer * DM))[lane + 64 * j];
            for (int m = gw; m < NTOK; m += NGW) {
                const f32x4* xr = (const f32x4*)(XR + (size_t)m * DM) + lane; f32x4 v[4];
#pragma unroll
                for (int j = 0; j < 4; ++j) v[j] = xr[64 * j];
                const float rstd = row_rstd(v);
#pragma unroll
                for (int j = 0; j < 4; ++j) v[j] = v[j] * rstd * g[j];
                { unsigned* o4 = (unsigned*)(H8 + (size_t)m * DM) + lane;
#pragma unroll
                    for (int j = 0; j < 4; ++j) o4[64 * j] = pg8::cvt4_fp8(v[j].x, v[j].y, v[j].z, v[j].w); }
                float lg[16];
#pragma unroll
                for (int e = 0; e < 16; ++e) { float a = 0.f;
#pragma unroll
                    for (int j = 0; j < 4; ++j) { const f32x4 w = *(const LAS f32x4*)(wr + e * DM + 256 * j + 4 * lane); a += (v[j].x * w.x + v[j].y * w.y) + (v[j].z * w.z + v[j].w * w.w); }
                    lg[e] = wave_sum(a); if ((e & 3) == 3) __builtin_amdgcn_sched_barrier(0); }
                float mx = lg[0];
#pragma unroll
                for (int e = 1; e < 16; ++e) mx = fmaxf(mx, lg[e]);
                float sum = 0.f, mine = 0.f;
#pragma unroll
                for (int e = 0; e < 16; ++e) { const float p = __expf(lg[e] - mx); sum += p; mine = (lane == e) ? p : mine; }
                if (lane < 16) AFF[((size_t)(m >> 11) * 16 + lane) * SEQ + (m & 2047)] = mine / sum;
            }
            __syncthreads();
        }
        PHASE_END();

        if (EN_TK && PHASE_ON()) {
            PHASE_IDS();
            LAS unsigned* red = (LAS unsigned*)ldsl;
            LAS int* idxs = (LAS int*)(ldsl + 1024);
            for (int pair = bx; pair < NB * NE; pair += G) {
                const int b = pair >> 4, e = pair & 15;
                const f32x4 av = ((const f32x4*)(AFF + (size_t)pair * SEQ))[tid];
                const unsigned u0 = __float_as_uint(av.x), u1 = __float_as_uint(av.y), u2 = __float_as_uint(av.z), u3 = __float_as_uint(av.w);
                unsigned prefix = 0u;
                for (int bit = 30; bit >= 0; --bit) {
                    const unsigned cand = prefix | (1u << bit);
                    const unsigned cw = (unsigned)__popcll(__ballot(u0 >= cand)) + (unsigned)__popcll(__ballot(u1 >= cand)) + (unsigned)__popcll(__ballot(u2 >= cand)) + (unsigned)__popcll(__ballot(u3 >= cand));
                    LAS unsigned* rb = red + (bit & 1) * 8;
                    if (lane == 0) rb[wave] = cw;
                    __syncthreads();
                    unsigned tot = 0;
#pragma unroll
                    for (int w = 0; w < 8; ++w) tot += rb[w];
                    if (tot >= (unsigned)CAP) prefix = cand;
                }
                const unsigned T = prefix;
                const unsigned g0 = u0 > T, g1 = u1 > T, g2 = u2 > T, g3 = u3 > T, q0 = u0 == T, q1 = u1 == T, q2 = u2 == T, q3 = u3 == T;
                const unsigned long long bg0 = __ballot(g0), bg1 = __ballot(g1), bg2 = __ballot(g2), bg3 = __ballot(g3), bq0 = __ballot(q0), bq1 = __ballot(q1), bq2 = __ballot(q2), bq3 = __ballot(q3);
#define MBC(m) __builtin_amdgcn_mbcnt_hi((unsigned)((m) >> 32), __builtin_amdgcn_mbcnt_lo((unsigned)(m), 0u))
                const unsigned pre = (MBC(bg0) + MBC(bg1) + MBC(bg2) + MBC(bg3)) | ((MBC(bq0) + MBC(bq1) + MBC(bq2) + MBC(bq3)) << 16);
#undef MBC
                const unsigned wtot = (unsigned)(__popcll(bg0) + __popcll(bg1) + __popcll(bg2) + __popcll(bg3)) | ((unsigned)(__popcll(bq0) + __popcll(bq1) + __popcll(bq2) + __popcll(bq3)) << 16);
                LAS unsigned* tot8 = red + 16;
                __syncthreads();
                if (lane == 0) tot8[wave] = wtot;
                __syncthreads();
                unsigned woff = 0, all = 0;
#pragma unroll
                for (int w = 0; w < 8; ++w) { const unsigned t = tot8[w]; all += t; woff += (w < wave) ? t : 0u; }
                const unsigned excl = pre + woff;
                int bg = (int)(excl & 0xffffu), be = (int)(excl >> 16); const int ngt = (int)(all & 0xffffu), need = CAP - ngt;
                const size_t rowbase = (size_t)(e * 32 + b) * 256;
                int sl[4]; const unsigned gg[4] = {g0, g1, g2, g3}, qq[4] = {q0, q1, q2, q3}; const float vv[4] = {av.x, av.y, av.z, av.w};
#pragma unroll
                for (int q = 0; q < 4; ++q) { int s = -1;
                    if (gg[q]) s = bg++; else if (qq[q]) { const int r = be++; s = (r < need) ? ngt + r : -1; }
                    sl[q] = s;
                    if (s >= 0) { idxs[s] = 4 * tid + q; GATE[rowbase + s] = vv[q]; }
                    SLOT[((size_t)(b * SEQ + 4 * tid + q)) * 16 + e] = (short)s; }
                __syncthreads();
                for (int r0 = wave; r0 < CAP; r0 += 64) {
                    v4u t[8];
#pragma unroll
                    for (int k = 0; k < 8; ++k) { const int tok = idxs[r0 + 8 * k]; t[k] = ((const v4u*)(H8 + ((size_t)(b * SEQ + tok)) * DM))[lane]; }
#pragma unroll
                    for (int k = 0; k < 8; ++k) ((v4u*)(XE8 + (rowbase + r0 + 8 * k) * DM))[lane] = t[k];
                }
                __syncthreads();
            }
        }
        PHASE_END();

        if (EN_G3 && PHASE_ON()) {
            PHASE_IDS();
            pg8::Gemm g{(const pg8::bf16_t*)XE8, (const pg8::bf16_t*)Wgu8, NROWS_E, NE * 4096, DM}; pg8::GroupedOrder<16> S; S.init(G, bx);
            pg8::EpiSwiGLU8 E{HID8, FF};
            pg8::gemm_phase<pg8::EpiSwiGLU8, pg8::GroupedOrder<16>, true, true, true>(ldsl, g, S, E);
        }
        PHASE_END();

        if (EN_G4 && PHASE_ON()) {
            PHASE_IDS();
            pg8::Gemm g{(const pg8::bf16_t*)HID8, (const pg8::bf16_t*)Wd8, NROWS_E, NE * DM, FF}; pg8::GroupedOrder<4> S; S.init(G, bx);
            pg8::EpiDown E{XE, DM, GATE, pg8::W8_INV};
            pg8::gemm_phase<pg8::EpiDown, pg8::GroupedOrder<4>, true, true, true>(ldsl, g, S, E);
        }
        PHASE_END();
    }

    if (EN_FIN && PHASE_ON()) {
            PHASE_IDS();
        f32x4 g[4];
#pragma unroll
        for (int j = 0; j < 4; ++j) g[j] = ((const f32x4*)args.final_g)[lane + 64 * j];
        for (int m = gw; m < NTOK; m += 2 * NGW) {
            const int m2 = (m + NGW < NTOK) ? m + NGW : m;
            f32x4* xa = (f32x4*)(XR + (size_t)m * DM) + lane; f32x4* xb = (f32x4*)(XR + (size_t)m2 * DM) + lane; f32x4 va[4], vb[4];
#pragma unroll
            for (int j = 0; j < 4; ++j) { va[j] = xa[64 * j]; vb[j] = xb[64 * j]; }
            const int sla = (lane < 16) ? (int)SLOT[(size_t)m * 16 + lane] : -1, slb = (lane < 16) ? (int)SLOT[(size_t)m2 * 16 + lane] : -1;
            add_expert_rows(va, sla, m >> 11, XE, lane);
            add_expert_rows(vb, slb, m2 >> 11, XE, lane);
            const float ra = row_rstd(va);
#pragma unroll
            for (int j = 0; j < 4; ++j) xa[64 * j] = va[j] * ra * g[j];
            if (m2 != m) {
                const float rb = row_rstd(vb);
#pragma unroll
                for (int j = 0; j < 4; ++j) xb[64 * j] = vb[j] * rb * g[j];
            }
        }
    }
#undef PHASE_ON
#undef PHASE_END
}

extern "C" void kernel_launch(void* const* d_in, const int* in_sizes, int n_in, void* d_out, int out_size, void* d_ws, size_t ws_size, hipStream_t stream) {
    static int grid = 0;
    if (grid == 0) {
        if (n_in != 22 || in_sizes[0] != NTOK * DM || out_size != NTOK * DM || ws_size < WS_END) {
            fprintf(stderr, "kernel_launch: shape/workspace mismatch (n_in %d, in0 %d, out %d, ws %zu < %zu)\n", n_in, n_in > 0 ? in_sizes[0] : -1, out_size, ws_size, (size_t)WS_END); grid = -1; return; }
        int dev = 0, cus = 0;
        if (hipGetDevice(&dev) != hipSuccess || hipDeviceGetAttribute(&cus, hipDeviceAttributeMultiprocessorCount, dev) != hipSuccess) { grid = -1; return; }
        if (hipFuncSetAttribute((const void*)mk_fwd, hipFuncAttributeMaxDynamicSharedMemorySize, LDS_BYTES) != hipSuccess) { fprintf(stderr, "kernel_launch: hipFuncSetAttribute failed\n"); grid = -1; return; }
        int per_cu = 0;
        if (hipOccupancyMaxActiveBlocksPerMultiprocessor(&per_cu, (const void*)mk_fwd, NWAVES * 64, LDS_BYTES) != hipSuccess || per_cu < 1) fprintf(stderr, "kernel_launch: occupancy query says %d\n", per_cu);
        (void)hipGetLastError();
        grid = cus;
    }
    if (grid < 0) return;
    (void)hipMemsetAsync((char*)d_ws + WS_CTL, 0, CTL_ZERO_BYTES, stream);
    Args a{};
    const float* const* in = (const float* const*)d_in;
    a.x = in[0]; a.attn_g = in[1]; a.ffn_g = in[2]; a.final_g = in[3];
    for (int l = 0; l < 4; ++l) {
        const int m = l % 3, j = l / 3;
        a.w_in[l] = m == 0 ? in[4] + (size_t)j * DM * 3072 : (m == 1 ? in[11] + (size_t)j * DM * 1536 : in[15] + (size_t)j * DM * 1536);
        a.w_o[l] = m == 0 ? in[5] + (size_t)j * DM * DM : (m == 1 ? in[12] + (size_t)j * DM * DM : in[16] + (size_t)j * DM * DM);
        a.lq1[l] = in[6] + j * 64; a.lk1[l] = in[7] + j * 64; a.lq2[l] = in[8] + j * 64; a.lk2[l] = in[9] + j * 64; a.subln[l] = in[10] + j * 128;
        a.qn[l] = in[13]; a.kn[l] = in[14]; a.sinks[l] = in[17];
        if (m != 0) { a.lq1[l] = in[6]; a.lk1[l] = in[7]; a.lq2[l] = in[8]; a.lk2[l] = in[9]; a.subln[l] = in[10]; }
    }
    a.w_router = in[18]; a.w_gate = in[19]; a.w_up = in[20]; a.w_down = in[21];
    a.out = (float*)d_out; a.ws = (unsigned char*)d_ws;
    a.ph_lo = 0; a.ph_hi = 1000;
    hipLaunchKernelGGL(mk_fwd, dim3(grid), dim3(NWAVES * 64), LDS_BYTES, stream, a);
    const hipError_t le = hipPeekAtLastError();
    if (le != hipSuccess) fprintf(stderr, "kernel_launch: launch failed: %s\n", hipGetErrorName(le));
}
```

```cpp
#include <hip/hip_runtime.h>
#include <cstdio>
#include <cstdint>
__device__ __forceinline__ int fresh_tid() { int t = threadIdx.x; asm volatile("" : "+v"(t)); return t; }
__device__ __forceinline__ float dpp_xor1(float v) { return __uint_as_float((unsigned)__builtin_amdgcn_update_dpp(0, (int)__float_as_uint(v), 0xB1, 0xF, 0xF, true)); }
__device__ __forceinline__ float dpp_xor2(float v) { return __uint_as_float((unsigned)__builtin_amdgcn_update_dpp(0, (int)__float_as_uint(v), 0x4E, 0xF, 0xF, true)); }
__device__ __forceinline__ float dpp_hmirror(float v) { return __uint_as_float((unsigned)__builtin_amdgcn_update_dpp(0, (int)__float_as_uint(v), 0x141, 0xF, 0xF, true)); }
__device__ __forceinline__ float dpp_mirror(float v) { return __uint_as_float((unsigned)__builtin_amdgcn_update_dpp(0, (int)__float_as_uint(v), 0x140, 0xF, 0xF, true)); }
__device__ __forceinline__ float dpp_ror4(float v) { return __uint_as_float((unsigned)__builtin_amdgcn_update_dpp(0, (int)__float_as_uint(v), 0x124, 0xF, 0xF, true)); }
__device__ __forceinline__ float dpp_ror8(float v) { return __uint_as_float((unsigned)__builtin_amdgcn_update_dpp(0, (int)__float_as_uint(v), 0x128, 0xF, 0xF, true)); }
__device__ __forceinline__ float sum_swap16(float v) { auto r = __builtin_amdgcn_permlane16_swap(__float_as_uint(v), __float_as_uint(v), false, false); return __uint_as_float(r[0]) + __uint_as_float(r[1]); }
__device__ __forceinline__ float sum_swap32(float v) { auto r = __builtin_amdgcn_permlane32_swap(__float_as_uint(v), __float_as_uint(v), false, false); return __uint_as_float(r[0]) + __uint_as_float(r[1]); }
__device__ __forceinline__ float sum16(float v) { v += dpp_xor1(v); v += dpp_xor2(v); v += dpp_hmirror(v); v += dpp_mirror(v); return v; }
__device__ __forceinline__ float sum32(float v) { return sum_swap16(sum16(v)); }
__device__ __forceinline__ float sum64(float v) { return sum_swap32(sum32(v)); }
namespace pg8 {
#define PG8_LAS __attribute__((address_space(3)))
typedef unsigned short bf16_t;
typedef short bf16x8 __attribute__((ext_vector_type(8)));
typedef float f32x4 __attribute__((ext_vector_type(4)));
typedef unsigned u32x4 __attribute__((ext_vector_type(4)));
constexpr int BM = 256, BK = 64, HALF = 128, HTB = HALF * BK * 2  , STAGE_BYTES = 8 * HTB, NXCD = 8, WGM = 8;

__host__ __device__ __forceinline__ int lds_byte(int r, int c) { const int st = (r >> 4) * 2 + (c >> 5), rr = r & 15, cc = c & 31, ob = rr * 64 + cc * 2; return st * 1024 + (ob ^ (((ob >> 9) & 1) << 5)); }
__host__ __device__ __forceinline__ void stage_rc(int b, int& R, int& C) { const int st = b / 1024, sb = b % 1024, swz = sb ^ (((sb >> 9) & 1) << 5); R = (st >> 1) * 16 + swz / 64; C = (st & 1) * 32 + (swz % 64) / 2; }
__host__ __device__ __forceinline__ int perm32(int rho) { const int n = rho >> 4, i = rho & 15; return 8 * (i >> 2) + 4 * n + (i & 3); }

struct Unit { int pm, pn; };
struct Gemm { const bf16_t* A; const bf16_t* Bt; int M, N, K; };

struct StaticOrder {
    int nM, nN, nwg, G, c;
    __host__ __device__ void init(int M, int N, int G_, int c_) { nM = M / BM; nN = N / BM; nwg = nM * nN; G = G_; c = c_; }
    __host__ __device__ bool next(int i, Unit& u) const {
        const long L = (long)i * G + c; if (L >= nwg) return false;
        int wgid = (int)L; { const int q = nwg / NXCD, r = nwg % NXCD, xcd = wgid % NXCD, off = wgid / NXCD; wgid = (xcd < r ? xcd * (q + 1) : r * (q + 1) + (xcd - r) * q) + off; }
        const int nig = WGM * nN, gid = wgid / nig, fm = gid * WGM, gsz = (nM - fm) < WGM ? (nM - fm) : WGM;
        u.pm = fm + ((wgid % nig) % gsz); u.pn = (wgid % nig) / gsz; return true;
    }
    __device__ __forceinline__ void a_ready(const Unit&) const {}
    __device__ __forceinline__ void done(const Unit&) const {}
};


template <int NNL> struct GroupedOrder {
    int G, c, nunits;
    __device__ void init(int G_, int c_) { G = G_; c = c_; nunits = 16 * 32 * NNL; }
    __device__ bool next(int i, Unit& u) const {
        const int L = i * G + c; if (L >= nunits) return false;
        if (G == 256) {
            const int x = c & 7, j = c >> 3;
            if (NNL == 16) { const int e = i >> 1, hh = i & 1; u.pm = e * 32 + 4 * x + (j & 3); u.pn = e * 16 + 8 * hh + (j >> 2); }
            else { const int e = 2 * i + (x >> 2); u.pm = e * 32 + 8 * (x & 3) + (j & 7); u.pn = e * NNL + (j >> 3); }
        } else { const int pmg = L / NNL; u.pm = pmg; u.pn = (pmg >> 5) * NNL + (L % NNL); }
        return true;
    }
    __device__ __forceinline__ void a_ready(const Unit&) const {}
    __device__ __forceinline__ void done(const Unit&) const {}
};

__device__ __forceinline__ unsigned cvt_pk_bf16(float lo, float hi) { unsigned r; asm volatile("v_cvt_pk_bf16_f32 %0, %1, %2" : "=v"(r) : "v"(lo), "v"(hi)); return r; }

struct EpiQKV {
    static constexpr bool PERM = true, AFTER_DRAIN = false;
    bf16_t* O; int ldc; const float* tcos; const float* tsin; int nrope, nq; const PG8_LAS float* qg; const PG8_LAS float* kg; float qscale;
    __device__ __forceinline__ void operator()(const f32x4 (&acc)[2][2][4][2], const Unit& u, int wr, int wc, int fr, int fq) const {
        const int row0 = u.pm * BM + wr * 64 + fr, col0 = u.pn * BM + wc * 64 + 8 * fq;
        const bool rope = u.pn < nrope; const float sc = (u.pn < nq) ? qscale : 1.0f;
        const PG8_LAS float* gp = (u.pn < nq) ? qg : kg;
        f32x4 gv[2][2];
        if (rope && gp) {
#pragma unroll
            for (int bj = 0; bj < 2; ++bj)
#pragma unroll
                for (int n = 0; n < 2; ++n) gv[bj][n] = *(const PG8_LAS f32x4*)(gp + 32 * bj + 8 * fq + 4 * n);
        }
#pragma unroll
        for (int ai = 0; ai < 2; ++ai)
#pragma unroll
            for (int m = 0; m < 4; ++m) {
                const int row = row0 + ai * HALF + m * 16;
                f32x4 v[2][2];
#pragma unroll
                for (int bj = 0; bj < 2; ++bj)
#pragma unroll
                    for (int n = 0; n < 2; ++n) v[bj][n] = acc[ai][bj][m][n];
                if (rope) {
                    if (gp) {
                        float ss = 0.f;
#pragma unroll
                        for (int bj = 0; bj < 2; ++bj)
#pragma unroll
                            for (int n = 0; n < 2; ++n) ss += (v[bj][n][0] * v[bj][n][0] + v[bj][n][1] * v[bj][n][1]) + (v[bj][n][2] * v[bj][n][2] + v[bj][n][3] * v[bj][n][3]);
                        ss = sum_swap32(sum_swap16(ss));
                        const float rstd = __builtin_amdgcn_rsqf(ss * (1.0f / 64.0f) + 1e-6f);
#pragma unroll
                        for (int bj = 0; bj < 2; ++bj)
#pragma unroll
                            for (int n = 0; n < 2; ++n) v[bj][n] = v[bj][n] * rstd * gv[bj][n];
                    }
                    const int s = row & 2047;
#pragma unroll
                    for (int n = 0; n < 2; ++n) {
                        const f32x4 c = *(const f32x4*)(tcos + s * 32 + 8 * fq + 4 * n), sn = *(const f32x4*)(tsin + s * 32 + 8 * fq + 4 * n);
                        const f32x4 x1 = v[0][n], x2 = v[1][n];
                        v[0][n] = x1 * c - x2 * sn; v[1][n] = x2 * c + x1 * sn;
                    }
                }
                bf16_t* rowp = O + (size_t)row * ldc + col0;
#pragma unroll
                for (int bj = 0; bj < 2; ++bj) { const f32x4 v0 = v[bj][0] * sc, v1 = v[bj][1] * sc;
                    u32x4 w; w.x = cvt_pk_bf16(v0[0], v0[1]); w.y = cvt_pk_bf16(v0[2], v0[3]); w.z = cvt_pk_bf16(v1[0], v1[1]); w.w = cvt_pk_bf16(v1[2], v1[3]);
                    *(u32x4*)(rowp + bj * 32) = w; }
            }
    }
};
struct EpiResF32 {
    static constexpr bool PERM = false, AFTER_DRAIN = false;
    const float* base; float* C; int ldc;
    __device__ __forceinline__ void operator()(const f32x4 (&acc)[2][2][4][2], const Unit& u, int wr, int wc, int fr, int fq) const {
        const int row0 = u.pm * BM + wr * 64 + fr, col0 = u.pn * BM + wc * 32 + 4 * fq;
#pragma unroll
        for (int ai = 0; ai < 2; ++ai)
#pragma unroll
            for (int m = 0; m < 4; ++m) { const size_t off = (size_t)(row0 + ai * HALF + m * 16) * ldc + col0;
                f32x4 bs[2][2];
#pragma unroll
                for (int bj = 0; bj < 2; ++bj)
#pragma unroll
                    for (int n = 0; n < 2; ++n) bs[bj][n] = *(const f32x4*)(base + off + bj * HALF + n * 16);
#pragma unroll
                for (int bj = 0; bj < 2; ++bj)
#pragma unroll
                    for (int n = 0; n < 2; ++n) *(f32x4*)(C + off + bj * HALF + n * 16) = acc[ai][bj][m][n] + bs[bj][n];
                asm volatile("" ::: "memory"); }
    }
};
struct EpiSwiGLU {
    static constexpr bool PERM = true, AFTER_DRAIN = false;
    bf16_t* O; int ldc;
    __device__ __forceinline__ void operator()(const f32x4 (&acc)[2][2][4][2], const Unit& u, int wr, int wc, int fr, int fq) const {
        const int row0 = u.pm * BM + wr * 64 + fr, col0 = (u.pn & 15) * HALF + wc * 32 + 8 * fq;
#pragma unroll
        for (int ai = 0; ai < 2; ++ai)
#pragma unroll
            for (int m = 0; m < 4; ++m) { bf16_t* rowp = O + (size_t)(row0 + ai * HALF + m * 16) * ldc + col0;
                f32x4 h[2];
#pragma unroll
                for (int n = 0; n < 2; ++n) { const f32x4 g = acc[ai][0][m][n], up = acc[ai][1][m][n];
#pragma unroll
                    for (int j = 0; j < 4; ++j) { const float e = __builtin_amdgcn_exp2f(g[j] * -1.4426950408889634f); h[n][j] = g[j] * __builtin_amdgcn_rcpf(1.0f + e) * up[j]; } }
                u32x4 w; w.x = cvt_pk_bf16(h[0][0], h[0][1]); w.y = cvt_pk_bf16(h[0][2], h[0][3]); w.z = cvt_pk_bf16(h[1][0], h[1][1]); w.w = cvt_pk_bf16(h[1][2], h[1][3]);
                *(u32x4*)rowp = w; }
    }
};
__device__ __forceinline__ unsigned cvt4_fp8(float a, float b, float c, float d) { int r = __builtin_amdgcn_cvt_pk_fp8_f32(a, b, 0, false); r = __builtin_amdgcn_cvt_pk_fp8_f32(c, d, r, true); return (unsigned)r; }
constexpr float W8_SCALE = 32.0f, W8_INV = 1.0f / 32.0f;
struct EpiSwiGLU8 {
    static constexpr bool PERM = true, AFTER_DRAIN = false;
    unsigned char* O; int ldc;
    __device__ __forceinline__ void operator()(const f32x4 (&acc)[2][2][4][2], const Unit& u, int wr, int wc, int fr, int fq) const {
        const int row0 = u.pm * BM + wr * 64 + fr, col0 = (u.pn & 15) * HALF + wc * 32 + 8 * fq;
#pragma unroll
        for (int ai = 0; ai < 2; ++ai)
#pragma unroll
            for (int m = 0; m < 4; ++m) { unsigned char* rowp = O + (size_t)(row0 + ai * HALF + m * 16) * ldc + col0;
                f32x4 h[2];
#pragma unroll
                for (int n = 0; n < 2; ++n) { const f32x4 g = acc[ai][0][m][n], up = acc[ai][1][m][n];
#pragma unroll
                    for (int j = 0; j < 4; ++j) { const float e = __builtin_amdgcn_exp2f(g[j] * -1.4426950408889634f); h[n][j] = g[j] * __builtin_amdgcn_rcpf(1.0f + e) * up[j]; } }
                typedef unsigned u32x2 __attribute__((ext_vector_type(2)));
                u32x2 w; w.x = cvt4_fp8(h[0][0], h[0][1], h[0][2], h[0][3]); w.y = cvt4_fp8(h[1][0], h[1][1], h[1][2], h[1][3]);
                *(u32x2*)rowp = w; }
    }
};
struct EpiDown {
    static constexpr bool PERM = true, AFTER_DRAIN = false;
    bf16_t* O; int ldc; const float* gate; float osc;
    __device__ __forceinline__ void operator()(const f32x4 (&acc)[2][2][4][2], const Unit& u, int wr, int wc, int fr, int fq) const {
        const int row0 = u.pm * BM + wr * 64 + fr, col0 = (u.pn & 3) * BM + wc * 32 + 8 * fq;
#pragma unroll
        for (int ai = 0; ai < 2; ++ai)
#pragma unroll
            for (int m = 0; m < 4; ++m) { const int row = row0 + ai * HALF + m * 16; const float gt = gate[row] * osc; bf16_t* rowp = O + (size_t)row * ldc + col0;
#pragma unroll
                for (int bj = 0; bj < 2; ++bj) { const f32x4 v0 = acc[ai][bj][m][0] * gt, v1 = acc[ai][bj][m][1] * gt;
                    u32x4 w; w.x = cvt_pk_bf16(v0[0], v0[1]); w.y = cvt_pk_bf16(v0[2], v0[3]); w.z = cvt_pk_bf16(v1[0], v1[1]); w.w = cvt_pk_bf16(v1[2], v1[3]);
                    *(u32x4*)(rowp + bj * HALF) = w; } }
    }
};


__device__ __forceinline__ void glds16s(const char* gbase, unsigned voff, unsigned lds_dst) {
    unsigned keep; const unsigned dst = __builtin_amdgcn_readfirstlane(lds_dst);
    asm volatile("s_mov_b32 %0, m0\n\ts_mov_b32 m0, %3\n\ts_nop 0\n\tglobal_load_lds_dwordx4 %1, %2\n\ts_mov_b32 m0, %0" : "=&s"(keep) : "v"(voff), "s"(gbase), "s"(dst) : "memory");
}
typedef int i32x4 __attribute__((ext_vector_type(4)));
typedef int i32x8 __attribute__((ext_vector_type(8)));
template <class Epi, class Sched, bool ALIGN_EPI = false, bool SP2 = false, bool F8 = false>
__device__ __forceinline__ void gemm_phase(PG8_LAS unsigned char* lds, const Gemm g, const Sched& S, const Epi& E) {
    const int tid = fresh_tid(), wid = __builtin_amdgcn_readfirstlane(tid >> 6), lane = tid & 63, wr = wid >> 2, wc = wid & 3, fr = lane & 15, fq = lane >> 4;
    const int K = F8 ? g.K / 2 : g.K, nt = K / BK;
    unsigned voffA[2], voffB[2];
#pragma unroll
    for (int i = 0; i < 2; ++i) { int R, C; stage_rc(tid * 16 + i * 8192, R, C); const int Rb = Epi::PERM ? ((R & ~31) + perm32(R & 31)) : R;
        voffA[i] = (unsigned)(R * K + C) * 2u; voffB[i] = (unsigned)(Rb * K + C) * 2u; }
    const size_t kstep = (size_t)(BK * 2);
    const size_t hstep = (size_t)HALF * K * 2;
    const size_t tstep = 2 * hstep;
    const unsigned ldsw = (unsigned)wid * 1024u;
    const int aoff = lds_byte(wr * 64 + fr, fq * 8), boff = lds_byte(wc * 32 + fr, fq * 8);
#define PG8_SA(b, h) (((b) * 2 + (h)) * HTB)
#define PG8_SB(b, h) ((4 + (b) * 2 + (h)) * HTB)
    int sc8 = 0x7f7f7a7a; asm volatile("" : "+v"(sc8));
    const unsigned ldsb = (unsigned)(uintptr_t)lds;
#define PG8_STAGE(bufoff, gbase, voff) do { _Pragma("unroll") for (int _i = 0; _i < 2; ++_i) \
        glds16s((const char*)(gbase), (voff)[_i], ldsb + (unsigned)(bufoff) + ldsw + (unsigned)(_i * 8192)); } while (0)
#define PG8_LDA(dst, b, h) do { _Pragma("unroll") for (int m = 0; m < 4; ++m) _Pragma("unroll") for (int k = 0; k < 2; ++k) dst[m][k] = *(const PG8_LAS bf16x8*)(lds + PG8_SA(b, h) + aoff + m * 2048 + k * 1024); } while (0)
#define PG8_LDB(dst, b, h) do { _Pragma("unroll") for (int n = 0; n < 2; ++n) _Pragma("unroll") for (int k = 0; k < 2; ++k) dst[n][k] = *(const PG8_LAS bf16x8*)(lds + PG8_SB(b, h) + boff + n * 2048 + k * 1024); } while (0)
#define PG8_CAT(x) __builtin_shufflevector(__builtin_bit_cast(i32x4, (x)[0]), __builtin_bit_cast(i32x4, (x)[1]), 0, 1, 2, 3, 4, 5, 6, 7)
#define PG8_MMA(ai, bj, At, Bt) do { __builtin_amdgcn_s_setprio(1); _Pragma("unroll") for (int m = 0; m < 4; ++m) _Pragma("unroll") for (int n = 0; n < 2; ++n) { \
        if constexpr (F8) acc[ai][bj][m][n] = __builtin_amdgcn_mfma_scale_f32_16x16x128_f8f6f4(PG8_CAT(Bt[n]), PG8_CAT(At[m]), acc[ai][bj][m][n], 0, 0, 0, sc8, 2, sc8); \
        else { _Pragma("unroll") for (int k = 0; k < 2; ++k) acc[ai][bj][m][n] = __builtin_amdgcn_mfma_f32_16x16x32_bf16(Bt[n][k], At[m][k], acc[ai][bj][m][n], 0, 0, 0); } } __builtin_amdgcn_s_setprio(0); } while (0)
#define PG8_WAIT_V(n) asm volatile("s_waitcnt vmcnt(" #n ")" ::: "memory")
#define PG8_WAIT_L(n) asm volatile("s_waitcnt lgkmcnt(" #n ")" ::: "memory")
#define PG8_BAR __builtin_amdgcn_s_barrier()
#define PG8_SCHED __builtin_amdgcn_sched_barrier(0)
    Unit cur, nxt; int ui = 0;
    if (!S.next(0, cur)) return;
    f32x4 acc[2][2][4][2];
#pragma unroll
    for (int a = 0; a < 2; ++a)
#pragma unroll
        for (int b = 0; b < 2; ++b)
#pragma unroll
            for (int m = 0; m < 4; ++m)
#pragma unroll
                for (int n = 0; n < 2; ++n) acc[a][b][m][n] = (f32x4){0.f, 0.f, 0.f, 0.f};
    bf16x8 At[4][2], B0[2][2], B1[2][2];
    const char* cA = (const char*)g.A + (size_t)cur.pm * tstep; const char* cB = (const char*)g.Bt + (size_t)cur.pn * tstep;
    S.a_ready(cur);
    if constexpr (SP2) {
        PG8_STAGE(PG8_SB(0, 0), cB, voffB); PG8_STAGE(PG8_SB(0, 1), cB + hstep, voffB); PG8_STAGE(PG8_SA(0, 0), cA, voffA); PG8_STAGE(PG8_SA(0, 1), cA + hstep, voffA);
        if (wr == 1) PG8_BAR;
        PG8_WAIT_V(2); PG8_BAR;
        PG8_STAGE(PG8_SB(1, 0), cB + kstep, voffB); PG8_STAGE(PG8_SA(1, 0), cA + kstep, voffA); PG8_STAGE(PG8_SB(1, 1), cB + hstep + kstep, voffB);
        PG8_WAIT_V(6); PG8_BAR;
    } else {
        PG8_STAGE(PG8_SB(0, 0), cB, voffB); PG8_STAGE(PG8_SA(0, 0), cA, voffA); PG8_STAGE(PG8_SB(0, 1), cB + hstep, voffB); PG8_STAGE(PG8_SA(0, 1), cA + hstep, voffA);
        if (wr == 1) PG8_BAR;
        PG8_WAIT_V(4); PG8_BAR;
        PG8_STAGE(PG8_SB(1, 0), cB + kstep, voffB); PG8_STAGE(PG8_SA(1, 0), cA + kstep, voffA); PG8_STAGE(PG8_SB(1, 1), cB + hstep + kstep, voffB);
        PG8_WAIT_V(6); PG8_BAR;
    }
    for (;;) {
        const bool has_next = S.next(ui + 1, nxt);
        const char* nA = has_next ? (const char*)g.A + (size_t)nxt.pm * tstep : cA; const char* nB = has_next ? (const char*)g.Bt + (size_t)nxt.pn * tstep : cB;
#pragma unroll 1
        for (int t = 0; t < nt; t += 2) {
            const bool last = (t == nt - 2);
            const char* a1 = cA + (size_t)(t + 1) * kstep;
            const char* a2 = last ? nA : cA + (size_t)(t + 2) * kstep; const char* b2 = last ? nB : cB + (size_t)(t + 2) * kstep;
            const char* a3 = a2 + kstep; const char* b3 = b2 + kstep;
            if (last && has_next) S.a_ready(nxt);
            if constexpr (SP2) {
            PG8_LDB(B0, 0, 0); PG8_LDB(B1, 0, 1); PG8_SCHED; PG8_LDA(At, 0, 0); PG8_STAGE(PG8_SA(1, 1), a1 + hstep, voffA);
            PG8_WAIT_V(8); PG8_WAIT_L(0); PG8_BAR; PG8_MMA(0, 0, At, B0); PG8_MMA(0, 1, At, B1); PG8_BAR; PG8_SCHED;
            PG8_LDA(At, 0, 1); PG8_STAGE(PG8_SB(0, 0), b2, voffB); PG8_STAGE(PG8_SB(0, 1), b2 + hstep, voffB); PG8_STAGE(PG8_SA(0, 0), a2, voffA);
            PG8_WAIT_V(8); PG8_WAIT_L(0); PG8_BAR; PG8_MMA(1, 0, At, B0); PG8_MMA(1, 1, At, B1); PG8_BAR; PG8_SCHED;
            PG8_LDB(B0, 1, 0); PG8_LDB(B1, 1, 1); PG8_SCHED; PG8_LDA(At, 1, 0); PG8_STAGE(PG8_SA(0, 1), a2 + hstep, voffA);
            PG8_WAIT_V(8); PG8_WAIT_L(0); PG8_BAR; PG8_MMA(0, 0, At, B0); PG8_MMA(0, 1, At, B1); PG8_BAR; PG8_SCHED;
            PG8_LDA(At, 1, 1); PG8_STAGE(PG8_SB(1, 0), b3, voffB); PG8_STAGE(PG8_SB(1, 1), b3 + hstep, voffB); PG8_STAGE(PG8_SA(1, 0), a3, voffA);
            PG8_WAIT_V(8); PG8_WAIT_L(0); PG8_BAR; PG8_MMA(1, 0, At, B0); PG8_MMA(1, 1, At, B1); PG8_BAR; PG8_SCHED;
            } else {
            PG8_LDB(B0, 0, 0); PG8_SCHED; PG8_LDA(At, 0, 0); PG8_STAGE(PG8_SA(1, 1), a1 + hstep, voffA);
            PG8_WAIT_L(8); PG8_BAR; PG8_WAIT_L(0); PG8_MMA(0, 0, At, B0); PG8_BAR; PG8_SCHED;
            PG8_LDB(B1, 0, 1); PG8_STAGE(PG8_SB(0, 0), b2, voffB);
            PG8_BAR; PG8_WAIT_L(0); PG8_MMA(0, 1, At, B1); PG8_BAR;
            PG8_LDA(At, 0, 1); PG8_STAGE(PG8_SA(0, 0), a2, voffA);
            PG8_BAR; PG8_WAIT_L(0); PG8_MMA(1, 0, At, B0); PG8_BAR; PG8_SCHED;
            PG8_STAGE(PG8_SB(0, 1), b2 + hstep, voffB);
            PG8_WAIT_V(6); PG8_BAR; PG8_MMA(1, 1, At, B1); PG8_BAR;
            PG8_LDB(B0, 1, 0); PG8_SCHED; PG8_LDA(At, 1, 0); PG8_STAGE(PG8_SA(0, 1), a2 + hstep, voffA);
            PG8_WAIT_L(8); PG8_BAR; PG8_WAIT_L(0); PG8_MMA(0, 0, At, B0); PG8_BAR; PG8_SCHED;
            PG8_LDB(B1, 1, 1); PG8_STAGE(PG8_SB(1, 0), b3, voffB);
            PG8_BAR; PG8_WAIT_L(0); PG8_MMA(0, 1, At, B1); PG8_BAR;
            PG8_LDA(At, 1, 1); PG8_STAGE(PG8_SA(1, 0), a3, voffA);
            PG8_BAR; PG8_WAIT_L(0); PG8_MMA(1, 0, At, B0); PG8_BAR; PG8_SCHED;
            PG8_STAGE(PG8_SB(1, 1), b3 + hstep, voffB);
            PG8_WAIT_V(6); PG8_BAR; PG8_MMA(1, 1, At, B1); PG8_BAR;
            }
        }
        if constexpr (ALIGN_EPI) { if (wr == 0) PG8_BAR; }
        if constexpr (!Epi::AFTER_DRAIN) { const int l_ = fresh_tid() & 63; E(acc, cur, wr, wc, l_ & 15, l_ >> 4); S.done(cur); }
        if (!has_next) break;
#pragma unroll
        for (int a = 0; a < 2; ++a)
#pragma unroll
            for (int b = 0; b < 2; ++b)
#pragma unroll
                for (int m = 0; m < 4; ++m)
#pragma unroll
                    for (int n = 0; n < 2; ++n) acc[a][b][m][n] = (f32x4){0.f, 0.f, 0.f, 0.f};
        cur = nxt; cA = nA; cB = nB; ++ui;
        if constexpr (ALIGN_EPI) { if (wr == 1) PG8_BAR; }
    }
    PG8_WAIT_V(0);
    if constexpr (!ALIGN_EPI) { if (wr == 0) PG8_BAR; }
    PG8_BAR;
    if constexpr (Epi::AFTER_DRAIN) { E.fused(acc, cur, wr, wc, fr, fq, lds, wid, lane); S.done(cur); }
#undef PG8_SA
#undef PG8_SB
#undef PG8_STAGE
#undef PG8_LDA
#undef PG8_LDB
#undef PG8_MMA
#undef PG8_CAT
#undef PG8_WAIT_V
#undef PG8_WAIT_L
#undef PG8_BAR
#undef PG8_SCHED
}
}


namespace att {
using bf16 = unsigned short;
using bf16x8 = __attribute__((ext_vector_type(8))) short;
using s16x4  = __attribute__((ext_vector_type(4))) short;
using f32x16 = __attribute__((ext_vector_type(16))) float;
using u32x4  = __attribute__((ext_vector_type(4))) unsigned;
constexpr int KVBLK = 64;
constexpr float THR = 8.f;
constexpr int SHM_K = KVBLK * 64 * 2;
#define ATT_KSWZ(row, colB) ((row) * 128 + ((colB) ^ ((((row) >> 1) & 7) << 4)))
#define ATT_SBAR() __builtin_amdgcn_sched_barrier(0)
__device__ __forceinline__ int crow(int r, int hi) { return (r & 3) + 8 * (r >> 2) + 4 * hi; }
__device__ __forceinline__ unsigned cvtpk(float lo, float hi) { unsigned r; asm volatile("v_cvt_pk_bf16_f32 %0, %1, %2" : "=v"(r) : "v"(lo), "v"(hi)); return r; }

__device__ __forceinline__ void partialSM(f32x16& p0, f32x16& p1, float& m_reg, float& mn, float& alpha) {
  float pmax = p0[0];
#pragma unroll
  for (int r = 1; r < 16; ++r) pmax = fmaxf(pmax, p0[r]);
#pragma unroll
  for (int r = 0; r < 16; ++r) pmax = fmaxf(pmax, p1[r]);
  { auto rr = __builtin_amdgcn_permlane32_swap(__float_as_uint(pmax), __float_as_uint(pmax), false, false);
    pmax = fmaxf(__uint_as_float(rr[0]), __uint_as_float(rr[1])); }
  if (__builtin_expect(__all(pmax - m_reg <= THR), 1)) { mn = m_reg; alpha = 1.f; }
  else { mn = fmaxf(m_reg, pmax); alpha = __builtin_amdgcn_exp2f(m_reg - mn); m_reg = mn; }
#pragma unroll
  for (int r = 0; r < 16; ++r) p0[r] = p0[r] - mn;
#pragma unroll
  for (int r = 0; r < 16; ++r) p1[r] = p1[r] - mn;
#pragma unroll
  for (int r = 0; r < 16; ++r) p0[r] = __builtin_amdgcn_exp2f(p0[r]);
}
__device__ __forceinline__ void finishSM(f32x16& p0, f32x16& p1, float alpha, float& l_reg, bf16x8& pa0, bf16x8& pa1, bf16x8& pa2, bf16x8& pa3) {
#pragma unroll
  for (int r = 0; r < 16; ++r) p1[r] = __builtin_amdgcn_exp2f(p1[r]);
  float ps = 0;
#pragma unroll
  for (int r = 0; r < 16; ++r) ps += p0[r];
#pragma unroll
  for (int r = 0; r < 16; ++r) ps += p1[r];
  { auto rr = __builtin_amdgcn_permlane32_swap(__float_as_uint(ps), __float_as_uint(ps), false, false);
    ps = __uint_as_float(rr[0]) + __uint_as_float(rr[1]); }
  l_reg = l_reg * alpha + ps;
#define ATT_PK4(P, BASE, OUT) do { unsigned a0 = cvtpk(P[BASE + 0], P[BASE + 1]), a1 = cvtpk(P[BASE + 2], P[BASE + 3]);   \
    unsigned b0 = cvtpk(P[BASE + 4], P[BASE + 5]), b1 = cvtpk(P[BASE + 6], P[BASE + 7]);                              \
    auto r0 = __builtin_amdgcn_permlane32_swap(a0, b0, false, false); auto r1 = __builtin_amdgcn_permlane32_swap(a1, b1, false, false); \
    u32x4 w = {r0[0], r1[0], r0[1], r1[1]}; OUT = *reinterpret_cast<bf16x8*>(&w); } while (0)
  ATT_PK4(p0, 0, pa0); ATT_PK4(p0, 8, pa1); ATT_PK4(p1, 0, pa2); ATT_PK4(p1, 8, pa3);
#undef ATT_PK4
}
__device__ __forceinline__ void qkt(f32x16& p0, f32x16& p1, const char* Ks, const bf16x8* qr, int r32, int hi) {
  p0 = f32x16{}; p1 = f32x16{};
#pragma unroll
  for (int d0 = 0; d0 < 4; ++d0) { const int cb = (d0 * 16 + hi * 8) * 2;
    bf16x8 b0 = *reinterpret_cast<const bf16x8*>(Ks + ATT_KSWZ(r32, cb));
    bf16x8 b1 = *reinterpret_cast<const bf16x8*>(Ks + ATT_KSWZ(32 + r32, cb));
    p0 = __builtin_amdgcn_mfma_f32_32x32x16_bf16(b0, qr[d0], p0, 0, 0, 0);
    p1 = __builtin_amdgcn_mfma_f32_32x32x16_bf16(b1, qr[d0], p1, 0, 0, 0); }
}
__device__ __forceinline__ void wmask(f32x16& p0, f32x16& p1, int dq  , int hi) {
  const float ninf = -__builtin_inff();
#pragma unroll
  for (int r = 0; r < 16; ++r) { const unsigned d = (unsigned)(dq + crow(r, hi)); p0[r] = d <= 256u ? p0[r] : ninf; const unsigned d1 = d + 32u; p1[r] = d1 <= 256u ? p1[r] : ninf; }
}
template <int NCB> __device__ __forceinline__ int v_st(int k, int c) { const int kk = (k & ~0xC) | ((k & 4) << 1) | ((k & 8) >> 1); return ((kk >> 3) * NCB + (c >> 5)) * 512 + ((kk & 7) * 32 + (c & 31)) * 2; }
__device__ __forceinline__ int v_rd_base(int lane) { return ((lane & 3) << 3) | (((lane >> 2) & 3) << 6) | (((lane >> 4) & 1) << 5) | (((lane >> 5) & 1) << 8); }
template <int OFF> __device__ __forceinline__ s16x4 tr_read(int vb) {
  s16x4 r; asm volatile("ds_read_b64_tr_b16 %0, %1 offset:%2" : "=&v"(r) : "v"(vb), "i"(OFF) : "memory"); return r;
}
template <int NCB, int D0> __device__ __forceinline__ void pv_one(f32x16& od, int vb, bf16x8 pa0, bf16x8 pa1, bf16x8 pa2, bf16x8 pa3) {
#define ATT_VOFF(ks, half) (D0 * 512 + (ks) * (NCB * 1024) + (half) * (NCB * 512))
  const s16x4 l0 = tr_read<ATT_VOFF(0, 0)>(vb), h0 = tr_read<ATT_VOFF(0, 1)>(vb), l1 = tr_read<ATT_VOFF(1, 0)>(vb), h1 = tr_read<ATT_VOFF(1, 1)>(vb);
  const s16x4 l2 = tr_read<ATT_VOFF(2, 0)>(vb), h2 = tr_read<ATT_VOFF(2, 1)>(vb), l3 = tr_read<ATT_VOFF(3, 0)>(vb), h3 = tr_read<ATT_VOFF(3, 1)>(vb);
#undef ATT_VOFF
  asm volatile("s_waitcnt lgkmcnt(0)" ::: "memory"); ATT_SBAR();
#define ATT_PK(L, H) (bf16x8){L[0], L[1], L[2], L[3], H[0], H[1], H[2], H[3]}
  od = __builtin_amdgcn_mfma_f32_32x32x16_bf16(pa0, ATT_PK(l0, h0), od, 0, 0, 0);
  od = __builtin_amdgcn_mfma_f32_32x32x16_bf16(pa1, ATT_PK(l1, h1), od, 0, 0, 0);
  od = __builtin_amdgcn_mfma_f32_32x32x16_bf16(pa2, ATT_PK(l2, h2), od, 0, 0, 0);
  od = __builtin_amdgcn_mfma_f32_32x32x16_bf16(pa3, ATT_PK(l3, h3), od, 0, 0, 0);
#undef ATT_PK
}
template <int NCB> __device__ __forceinline__ void pv_all(f32x16* o, int vb, bf16x8 pa0, bf16x8 pa1, bf16x8 pa2, bf16x8 pa3) {
  pv_one<NCB, 0>(o[0], vb, pa0, pa1, pa2, pa3); pv_one<NCB, 1>(o[1], vb, pa0, pa1, pa2, pa3);
  if constexpr (NCB == 4) { pv_one<NCB, 2>(o[2], vb, pa0, pa1, pa2, pa3); pv_one<NCB, 3>(o[3], vb, pa0, pa1, pa2, pa3); }
}

template <int NCB, bool WINDOW>
__device__ __forceinline__ void attn_core(f32x16 (&o)[NCB], const bf16* __restrict__ Qb, const bf16* __restrict__ Kh, const bf16* __restrict__ Vh, int ld, int ntiles,
                                          int qpos0, int kpos0, float sink_l2, char* lds) {
  constexpr int SHM_V = KVBLK * 32 * NCB * 2;
  const int tid = fresh_tid(), wid = tid >> 6, lane = tid & 63, r32 = lane & 31, hi = lane >> 5;
  char* V_lds = lds; char* K_lds = lds + 2 * SHM_V;
  float* wsf = (float*)(lds + 2 * SHM_V + 2 * SHM_K) + wid * 64; float* li_l = wsf; float* al_l = wsf + 32;
  float m_reg = -1e30f, l_reg = 0; asm volatile("" : "+v"(m_reg));
#pragma unroll
  for (int d = 0; d < NCB; ++d) o[d] = f32x16{};
  bf16x8 qr[4];
  const bf16* Qw = Qb + (long)(wid * 32 + r32) * ld + hi * 8;
#pragma unroll
  for (int d0 = 0; d0 < 4; ++d0) qr[d0] = *reinterpret_cast<const bf16x8*>(Qw + d0 * 16);
  const int dq0 = kpos0 - (qpos0 + wid * 32 + r32) + 128;
  const int ksr = tid >> 3, ksc = (tid & 7) * 8, kst = ATT_KSWZ(ksr, ksc * 2);
  constexpr int VCPR = 4 * NCB;
  const int vsr = tid / VCPR, vsc = (tid % VCPR) * 8, vst0 = v_st<NCB>(vsr, vsc), vst1 = v_st<NCB>(vsr + 32, vsc);
  const int vb0 = (int)(uintptr_t)V_lds + v_rd_base(lane);
  struct { bf16x8 ks, vs0, vs1; } sr_[2];
#define ATT_SLOAD(i, t) do { const long k0_ = (long)(t) * KVBLK; sr_[i].ks = *reinterpret_cast<const bf16x8*>(Kh + (k0_ + ksr) * ld + ksc); \
    sr_[i].vs0 = *reinterpret_cast<const bf16x8*>(Vh + (k0_ + vsr) * ld + vsc); \
    if constexpr (NCB == 4) sr_[i].vs1 = *reinterpret_cast<const bf16x8*>(Vh + (k0_ + vsr + 32) * ld + vsc); } while (0)
#define ATT_SWRITE(b, i) do { *(bf16x8*)(K_lds + (b) * SHM_K + kst) = sr_[i].ks; *(bf16x8*)(V_lds + (b) * SHM_V + vst0) = sr_[i].vs0; \
    if constexpr (NCB == 4) *(bf16x8*)(V_lds + (b) * SHM_V + vst1) = sr_[i].vs1; } while (0)
#define ATT_RESC(a) do { if (__any((a) < 1.f)) { if (hi == 0) al_l[r32] = (a); asm volatile("s_waitcnt lgkmcnt(0)" ::: "memory"); \
    _Pragma("unroll") for (int r = 0; r < 16; ++r) { const float al_ = al_l[crow(r, hi)]; _Pragma("unroll") for (int d = 0; d < NCB; ++d) o[d][r] *= al_; } } } while (0)
#define ATT_MASK(P0, P1, t) do { if constexpr (WINDOW) wmask(P0, P1, dq0 + (t) * KVBLK, hi); } while (0)
  f32x16 pA0, pA1, pB0, pB1; float mnA, mnB, alA, alB; bf16x8 pa0, pa1, pa2, pa3; const int NT = ntiles;
  ATT_SLOAD(0, 0); asm volatile("s_waitcnt vmcnt(0)" ::: "memory"); ATT_SWRITE(0, 0); __syncthreads();
  qkt(pA0, pA1, K_lds, qr, r32, hi); ATT_MASK(pA0, pA1, 0); partialSM(pA0, pA1, m_reg, mnA, alA);
  ATT_SLOAD(1, 1); if (2 < NT) ATT_SLOAD(0, 2);
  ATT_SWRITE(1, 1); __syncthreads();
  for (int j = 1; j + 1 < NT; j += 2) {
    ATT_SBAR(); qkt(pB0, pB1, K_lds + SHM_K, qr, r32, hi); ATT_MASK(pB0, pB1, j);
    finishSM(pA0, pA1, alA, l_reg, pa0, pa1, pa2, pa3); ATT_SBAR();
    ATT_SLOAD(1, j + 2); ATT_SBAR();
    pv_all<NCB>(o, vb0, pa0, pa1, pa2, pa3); partialSM(pB0, pB1, m_reg, mnB, alB);
    __syncthreads(); ATT_SWRITE(0, 0);
    ATT_RESC(alB); __syncthreads();
    ATT_SBAR(); qkt(pA0, pA1, K_lds, qr, r32, hi); ATT_MASK(pA0, pA1, j + 1);
    finishSM(pB0, pB1, alB, l_reg, pa0, pa1, pa2, pa3); ATT_SBAR();
    if (j + 3 < NT) ATT_SLOAD(0, j + 3); ATT_SBAR();
    pv_all<NCB>(o, vb0 + SHM_V, pa0, pa1, pa2, pa3); partialSM(pA0, pA1, m_reg, mnA, alA);
    __syncthreads(); ATT_SWRITE(1, 1);
    ATT_RESC(alA); __syncthreads();
  }
  ATT_SBAR(); qkt(pB0, pB1, K_lds + SHM_K, qr, r32, hi); ATT_MASK(pB0, pB1, NT - 1);
  finishSM(pA0, pA1, alA, l_reg, pa0, pa1, pa2, pa3); ATT_SBAR();
  pv_all<NCB>(o, vb0, pa0, pa1, pa2, pa3); partialSM(pB0, pB1, m_reg, mnB, alB);
  __syncthreads(); ATT_RESC(alB);
  finishSM(pB0, pB1, alB, l_reg, pa0, pa1, pa2, pa3); ATT_SBAR();
  pv_all<NCB>(o, vb0 + SHM_V, pa0, pa1, pa2, pa3);
  l_reg += __builtin_amdgcn_exp2f(sink_l2 - m_reg);
  if (hi == 0) li_l[r32] = l_reg; asm volatile("s_waitcnt lgkmcnt(0)" ::: "memory");
#pragma unroll
  for (int r = 0; r < 16; ++r) { const float rl = __builtin_amdgcn_rcpf(li_l[crow(r, hi)]);
#pragma unroll
    for (int d = 0; d < NCB; ++d) o[d][r] *= rl; }
#undef ATT_SLOAD
#undef ATT_SWRITE
#undef ATT_RESC
#undef ATT_MASK
}
template <int NCB> __device__ __forceinline__ void store_o(const f32x16 (&o)[NCB], bf16* Ob, int ld, int lane) {
  const int r32 = lane & 31, hi = lane >> 5, odd = lane & 1;
#pragma unroll
  for (int d = 0; d < NCB; ++d)
#pragma unroll
    for (int r = 0; r < 16; r += 2) {
      const float send = odd ? o[d][r] : o[d][r + 1];
      const float recv = dpp_xor1(send);
      const unsigned pk = cvtpk(odd ? recv : o[d][r], odd ? o[d][r + 1] : recv);
      const int row = crow(r + odd, hi);
      *(unsigned*)(Ob + (long)row * ld + d * 32 + (r32 & ~1)) = pk;
    }
}
}


constexpr int NWAVES = 8;
constexpr int DM = 1024, NB = 32, SEQ = 2048, NTOK = NB * SEQ, DEPTH = 4, NE = 16, CAP = 256, FF = 2048, NROWS_E = NB * NE * CAP;
constexpr float RMS_EPS = 1e-6f;
constexpr float QSCALE = 0.125f * 1.4426950408889634f;
constexpr size_t MiB = 1u << 20;
constexpr size_t WS_CTL = 0, CTL_ZERO_BYTES = 64 * 1024;
constexpr size_t WS_TAB = 1 * MiB;
constexpr size_t WS_MISC = 2 * MiB;
constexpr size_t WS_AFF = 3 * MiB;
constexpr size_t WS_GATE = 7 * MiB;
constexpr size_t WS_SLOT = 8 * MiB;
constexpr size_t WS_WATT = 10 * MiB, WATT_STRIDE = 8 * MiB, WATT_O = 6 * MiB;
constexpr size_t WS_WMOE = 42 * MiB, WMOE_STRIDE = 96 * MiB, WMOE_D = 64 * MiB;
constexpr size_t WS_H = 426 * MiB;
constexpr size_t WS_H8 = 554 * MiB;
constexpr size_t WS_BIG = 618 * MiB;
constexpr size_t WS_ATT = WS_BIG + 384 * MiB;
constexpr size_t WS_XE = 1130 * MiB;
constexpr size_t WS_END = 1386 * MiB;
constexpr int CW_BAR = 1024;
constexpr int RING_BYTES = 131072, LDSCTL_OFF = 146432, MISC_OFF = LDSCTL_OFF + 320, LDS_BYTES = 147456;

#define GAS __attribute__((address_space(1)))
#define LAS __attribute__((address_space(3)))
typedef unsigned short bf16;
typedef unsigned v4u __attribute__((ext_vector_type(4)));
typedef unsigned v2u __attribute__((ext_vector_type(2)));
typedef float f32x4 __attribute__((ext_vector_type(4)));
#define LDS_WAIT() asm volatile("s_waitcnt lgkmcnt(0)" ::: "memory")
#define VM_WAIT() asm volatile("s_waitcnt vmcnt(0)" ::: "memory")
__device__ __forceinline__ unsigned pk2(float lo, float hi) { unsigned r; asm volatile("v_cvt_pk_bf16_f32 %0, %1, %2" : "=v"(r) : "v"(lo), "v"(hi)); return r; }
__device__ __forceinline__ float bflo(unsigned w) { return __uint_as_float(w << 16); }
__device__ __forceinline__ float bfhi(unsigned w) { return __uint_as_float(w & 0xffff0000u); }


struct Args {
    const float* x; const float* attn_g; const float* ffn_g; const float* final_g;
    const float* w_in[4]; const float* w_o[4];
    const float* lq1[4]; const float* lk1[4]; const float* lq2[4]; const float* lk2[4]; const float* subln[4];
    const float* qn[4]; const float* kn[4];
    const float* sinks[4];
    const float* w_router; const float* w_gate; const float* w_up; const float* w_down;
    float* out; unsigned char* ws;
    int ph_lo, ph_hi;
};

__device__ __forceinline__ float wave_sum(float v) { return sum64(v); }
__host__ __device__ __forceinline__ int dmap_axial(int u) { const int t = u >> 5, i = u & 31; return i < 16 ? i + 16 * t : 32 + (i - 16) + 16 * t; }

__device__ __forceinline__ void transpose_item(const float* W, size_t ldw, int srccol, bf16* WT, int K, int p0, int k0, LAS float* scr, int lane) {
    const float* src = W + (size_t)k0 * ldw + srccol;
#pragma unroll 16
    for (int kk = 0; kk < 64; ++kk) scr[kk * 65 + lane] = src[(size_t)kk * ldw];
    LDS_WAIT(); asm volatile("" ::: "memory");
    const int c = lane & 7;
#pragma unroll
    for (int j = 0; j < 8; ++j) { const int n = (lane >> 3) + 8 * j; const LAS float* s = scr + (8 * c) * 65 + n;
        v4u o; o.x = pk2(s[0 * 65], s[1 * 65]); o.y = pk2(s[2 * 65], s[3 * 65]); o.z = pk2(s[4 * 65], s[5 * 65]); o.w = pk2(s[6 * 65], s[7 * 65]);
        *(v4u*)(WT + (size_t)(p0 + n) * K + k0 + 8 * c) = o; }
    LDS_WAIT(); asm volatile("" ::: "memory");
}

__device__ __forceinline__ void transpose_item_f8(const float* W, size_t ldw, int srccol, unsigned char* WT, int KB, int p0, int k0, LAS float* scr, int lane, float scale) {
    const float* src = W + (size_t)k0 * ldw + srccol;
#pragma unroll 16
    for (int kk = 0; kk < 64; ++kk) scr[kk * 65 + lane] = src[(size_t)kk * ldw];
    LDS_WAIT(); asm volatile("" ::: "memory");
    const int c = lane & 3;
#pragma unroll
    for (int j = 0; j < 4; ++j) { const int n = (lane >> 2) + 16 * j; const LAS float* t = scr + (16 * c) * 65 + n;
        v4u o;
        o.x = pg8::cvt4_fp8(t[0 * 65] * scale, t[1 * 65] * scale, t[2 * 65] * scale, t[3 * 65] * scale);
        o.y = pg8::cvt4_fp8(t[4 * 65] * scale, t[5 * 65] * scale, t[6 * 65] * scale, t[7 * 65] * scale);
        o.z = pg8::cvt4_fp8(t[8 * 65] * scale, t[9 * 65] * scale, t[10 * 65] * scale, t[11 * 65] * scale);
        o.w = pg8::cvt4_fp8(t[12 * 65] * scale, t[13 * 65] * scale, t[14 * 65] * scale, t[15 * 65] * scale);
        *(v4u*)(WT + (size_t)(p0 + n) * KB + k0 + 16 * c) = o; }
    LDS_WAIT(); asm volatile("" ::: "memory");
}

__device__ __forceinline__ float row_rstd(const f32x4 (&v)[4]) {
    float s = 0.f;
#pragma unroll
    for (int j = 0; j < 4; ++j) s += (v[j].x * v[j].x + v[j].y * v[j].y) + (v[j].z * v[j].z + v[j].w * v[j].w);
    return __builtin_amdgcn_rsqf(wave_sum(s) * (1.0f / DM) + RMS_EPS);
}
__device__ __forceinline__ void store_row_bf16(bf16* orow, const f32x4 (&v)[4], int lane) {
    v2u* o8 = (v2u*)orow + lane;
#pragma unroll
    for (int j = 0; j < 4; ++j) { v2u w; w.x = pk2(v[j].x, v[j].y); w.y = pk2(v[j].z, v[j].w); o8[64 * j] = w; }
}


__device__ __forceinline__ void add_expert_rows(f32x4 (&v)[4], int sl, int b, const bf16* YE, int lane) {
    unsigned mask = (unsigned)__ballot(sl >= 0) & 0xffffu;
    while (mask) {
        v2u w[4][4]; bool ok[4];
#pragma unroll
        for (int k = 0; k < 4; ++k) {
            ok[k] = mask != 0u;
            if (ok[k]) { const int e = __builtin_ctz(mask); mask &= mask - 1u; const int c = __builtin_amdgcn_readlane(sl, e);
                const v2u* yr = (const v2u*)(YE + ((size_t)((e * 32 + b) * 256 + c)) * DM) + lane;
#pragma unroll
                for (int j = 0; j < 4; ++j) w[k][j] = yr[64 * j]; }
        }
#pragma unroll
        for (int k = 0; k < 4; ++k)
            if (ok[k]) {
#pragma unroll
                for (int j = 0; j < 4; ++j) { v[j].x += bflo(w[k][j].x); v[j].y += bfhi(w[k][j].x); v[j].z += bflo(w[k][j].y); v[j].w += bfhi(w[k][j].y); } }
    }
}


#define XB_TMO      128
#define XB_XCNT(j)  (256  + 64 * (j))
#define XB_XSUB(j)  (1280 + 64 * (j))
#define XB_XGEN(j)  (2304 + 64 * (j))
#define XB_TOP      3328
#define XB_TOPGEN   3392
#define XCD_BAR_WORDS 3456
#define XB_SPIN_CAP (1u << 18)

__device__ __forceinline__ unsigned xb_ld(unsigned* p)              { return __hip_atomic_load(p, __ATOMIC_RELAXED, __HIP_MEMORY_SCOPE_AGENT); }
__device__ __forceinline__ unsigned xb_add(unsigned* p, unsigned v) { return __hip_atomic_fetch_add(p, v, __ATOMIC_RELAXED, __HIP_MEMORY_SCOPE_AGENT); }
__device__ __forceinline__ unsigned xb_xcc_id() { return (unsigned)__builtin_amdgcn_s_getreg((3 << 11) | 20) & 0xFu; }
#define XB_SPIN(cond, bar) do { unsigned _sp = 0; while (cond) { __builtin_amdgcn_s_sleep(1); \
    if ((++_sp & 255u) == 0u) { if (xb_ld(&(bar)[XB_TMO])) break; if (_sp > XB_SPIN_CAP) { atomicAdd(&(bar)[XB_TMO], 1u); break; } } } } while (0)

struct XcdBarrier {
    unsigned* bar; unsigned x;
    volatile LAS unsigned* st;
};

__device__ __forceinline__ XcdBarrier xcd_barrier_post(unsigned* bar, volatile LAS unsigned* st) {
    XcdBarrier b; b.bar = bar; b.x = xb_xcc_id(); b.st = st;
    if (threadIdx.x == 0) (void)xb_add(&bar[XB_XCNT(b.x)], 1u);
    return b;
}
__device__ __forceinline__ void xcd_barrier_complete(unsigned* bar, unsigned x, unsigned& nloc, unsigned& nx) {
    const unsigned G = gridDim.x * gridDim.y * gridDim.z;
    unsigned sum, cnt, mine, sp = 0u;
    for (;;) {
        sum = 0u; cnt = 0u; mine = 0u;
#pragma unroll
        for (unsigned j = 0; j < 16; ++j) { const unsigned c = xb_ld(&bar[XB_XCNT(j)]); sum += c; cnt += (c > 0u) ? 1u : 0u; mine = (j == x) ? c : mine; }
        if (sum == G) break;
        __builtin_amdgcn_s_sleep(1);
        if ((++sp & 255u) == 0u) { if (xb_ld(&bar[XB_TMO])) break; if (sp > XB_SPIN_CAP) { atomicAdd(&bar[XB_TMO], 1u); break; } }
    }
    nloc = mine > 0u ? mine : 1u; nx = cnt > 0u ? cnt : 1u;
}

__device__ __forceinline__ void xcd_barrier(const XcdBarrier& b) {
    asm volatile("s_waitcnt vmcnt(0)" ::: "memory");
    __syncthreads();
    if (threadIdx.x == 0) {
        size_t zb_ = 0; asm volatile("" : "+s"(zb_)); unsigned* bar = b.bar + zb_;
        __builtin_amdgcn_s_waitcnt(0);
        unsigned nloc = b.st[0], nx = b.st[1];
        if (nloc == 0u) { xcd_barrier_complete(bar, b.x, nloc, nx); b.st[0] = nloc; b.st[1] = nx; }
        const unsigned old = xb_add(&bar[XB_XSUB(b.x)], 1u);
        const unsigned gen = old / nloc;
        if (old + 1u == (gen + 1u) * nloc) {
            __builtin_amdgcn_fence(__ATOMIC_RELEASE, "agent");
            asm volatile("s_waitcnt vmcnt(0)" ::: "memory");
            const unsigned og = xb_add(&bar[XB_TOP], 1u);
            const unsigned tg = og / nx;
            if (og + 1u == (tg + 1u) * nx) xb_add(&bar[XB_TOPGEN], 1u);
            else XB_SPIN(xb_ld(&bar[XB_TOPGEN]) == tg, bar);
            __builtin_amdgcn_fence(__ATOMIC_ACQUIRE, "agent");
            xb_add(&bar[XB_XGEN(b.x)], 1u);
            asm volatile("s_waitcnt vmcnt(0)" ::: "memory");
        } else {
            XB_SPIN(xb_ld(&bar[XB_XGEN(b.x)]) == gen, bar);
            __builtin_amdgcn_fence(__ATOMIC_ACQUIRE, "agent");
            asm volatile("s_waitcnt vmcnt(0)" ::: "memory");
        }
    }
    __syncthreads();
}


__global__ void __launch_bounds__(NWAVES * 64, 2) mk_fwd(Args args) {
    extern __shared__ __attribute__((aligned(16))) unsigned char lds[];
    LAS unsigned char* ldsl = (LAS unsigned char*)lds;
    const int G = gridDim.x, bx = blockIdx.x;
    const int vcu = (G % 8 == 0) ? (bx % 8) * (G / 8) + bx / 8 : bx;
    const int NGW = G * NWAVES;
#define PHASE_IDS() const int tid = fresh_tid(), lane = tid & 63, wave = __builtin_amdgcn_readfirstlane(tid >> 6), gw = vcu * NWAVES + wave; (void)gw; (void)lane; (void)tid; size_t zero_ = 0; asm volatile("" : "+s"(zero_)); unsigned char* ws = args.ws + zero_; float* XR = args.out + zero_; (void)XR
    unsigned* ctl = (unsigned*)(args.ws + WS_CTL);
#define tab ((float*)(ws + WS_TAB))
#define gperm ((float*)(ws + WS_MISC))
#define AFF ((float*)(ws + WS_AFF))
#define GATE ((float*)(ws + WS_GATE))
#define SLOT ((short*)(ws + WS_SLOT))
#define H ((bf16*)(ws + WS_H))
#define QKV ((bf16*)(ws + WS_BIG))
#define ATT ((bf16*)(ws + WS_ATT))
#define HID8 (ws + WS_BIG)
#define XE ((bf16*)(ws + WS_XE))
#define XE8 (ws + WS_XE)
#define H8 (ws + WS_H8)
    for (int u = threadIdx.x; u < (LDS_BYTES - LDSCTL_OFF) / 4; u += NWAVES * 64) ((LAS unsigned*)(ldsl + LDSCTL_OFF))[u] = 0u;
    __syncthreads();
    volatile LAS unsigned* MISC = (volatile LAS unsigned*)(ldsl + MISC_OFF);
    XcdBarrier bar = xcd_barrier_post(ctl + CW_BAR, MISC + 8);
    const int ph_lo = args.ph_lo, ph_hi = args.ph_hi; int ph = 0;
#define PHASE_ON() (ph >= ph_lo && ph < ph_hi)
#ifndef EN_P0
#define EN_P0 1
#endif
#ifndef EN_N1
#define EN_N1 1
#endif
#ifndef EN_G1
#define EN_G1 1
#endif
#ifndef EN_AT
#define EN_AT 1
#endif
#ifndef EN_ATA
#define EN_ATA 1
#endif
#ifndef EN_ATB
#define EN_ATB 1
#endif
#ifndef EN_G2
#define EN_G2 1
#endif
#ifndef EN_N2
#define EN_N2 1
#endif
#ifndef EN_TK
#define EN_TK 1
#endif
#ifndef EN_G3
#define EN_G3 1
#endif
#ifndef EN_G4
#define EN_G4 1
#endif
#ifndef EN_FIN
#define EN_FIN 1
#endif
#define PHASE_END() do { ++ph; if (ph > ph_lo && ph < ph_hi) xcd_barrier(bar); } while (0)

    if (EN_P0 && PHASE_ON()) {
            PHASE_IDS();
        for (int i = gw * 64 + lane; i < 2 * SEQ * 32; i += NGW * 64) {
            const int which = i >> 16, s = (i >> 5) & 2047, f = i & 31; float ang;
            if (which == 0) ang = (float)s * exp2f(-(float)f * (13.287712379549449f / 32.0f));
            else ang = (float)(f < 16 ? (s >> 6) : (s & 63)) * exp2f(-(float)(f & 15) * (13.287712379549449f / 16.0f));
            tab[which * 131072 + s * 32 + f] = cosf(ang); tab[which * 131072 + 65536 + s * 32 + f] = sinf(ang);
        }
        if (gw == 0) { gperm[lane] = args.qn[1][dmap_axial(lane)]; gperm[64 + lane] = args.kn[1][dmap_axial(lane)]; }
        LAS float* scr = (LAS float*)(ldsl + wave * 16640);
        {
            constexpr int IT_A = 16 * 48 + 256, IT_B = 16 * 24 + 256, IT_ALL = 2 * IT_A + 2 * IT_B;
            for (int it = gw; it < IT_ALL; it += NGW) {
                int l, r = it;
                if (r < IT_A) l = 0; else { r -= IT_A; if (r < IT_B) l = 1; else { r -= IT_B; if (r < IT_B) l = 2; else { r -= IT_B; l = 3; } } }
                const int m = l % 3, n1 = (m == 0) ? 3072 : 1536, nin = 16 * (n1 / 64);
                bf16* wt = (bf16*)(ws + WS_WATT + (size_t)l * WATT_STRIDE);
                if (r < nin) { const int kb = r / (n1 / 64), pb = r % (n1 / 64), p = pb * 64 + lane;
                    const int pn = p >> 8, bj = (p >> 7) & 1, wc = (p >> 5) & 3, i = p & 31, hd = 4 * pn + wc, u = 32 * bj + i;
                    const int d = (m == 1 && hd < 20) ? dmap_axial(u) : u;
                    transpose_item(args.w_in[l], (size_t)n1, 64 * hd + d, wt, DM, pb * 64, kb * 64, scr, lane);
                } else { r -= nin; const int kb = r / 16, pb = r % 16;
                    transpose_item(args.w_o[l], (size_t)DM, pb * 64 + lane, (bf16*)((unsigned char*)wt + WATT_O), DM, pb * 64, kb * 64, scr, lane); }
            }
        }
        for (int it = gw; it < DEPTH * NE * 1536; it += NGW) {
            const int le = it / 1536, r = it % 1536, l = le >> 4, e = le & 15;
            unsigned char* wgu = ws + WS_WMOE + (size_t)l * WMOE_STRIDE + (size_t)e * 4096 * DM;
            unsigned char* wd = ws + WS_WMOE + (size_t)l * WMOE_STRIDE + WMOE_D + (size_t)e * DM * FF;
            if (r < 1024) { const int kb = r >> 6, pb = r & 63, bjj = (pb >> 1) & 1;
                const float* srcm = (bjj ? args.w_up : args.w_gate) + (size_t)le * DM * FF;
                transpose_item_f8(srcm, (size_t)FF, 128 * (pb >> 2) + 64 * (pb & 1) + lane, wgu, DM, pb * 64, kb * 64, scr, lane, pg8::W8_SCALE);
            } else { const int r2 = r - 1024, kb = r2 >> 4, pb = r2 & 15;
                transpose_item_f8(args.w_down + (size_t)le * FF * DM, (size_t)DM, pb * 64 + lane, wd, FF, pb * 64, kb * 64, scr, lane, pg8::W8_SCALE); }
        }
        {
            f32x4 g[4];
#pragma unroll
            for (int j = 0; j < 4; ++j) g[j] = ((const f32x4*)args.attn_g)[lane + 64 * j];
            for (int m = gw; m < NTOK; m += NGW) {
                const f32x4* xr = (const f32x4*)(args.x + (size_t)m * DM) + lane; f32x4 v[4];
#pragma unroll
                for (int j = 0; j < 4; ++j) v[j] = xr[64 * j];
                const float rstd = row_rstd(v);
#pragma unroll
                for (int j = 0; j < 4; ++j) v[j] = v[j] * rstd * g[j];
                store_row_bf16(H + (size_t)m * DM, v, lane);
            }
        }
    }
    PHASE_END();

    for (int layer = 0; layer < DEPTH; ++layer) {
        const int mix = layer % 3;
        const int n1 = (mix == 0) ? 3072 : 1536;
#define Win_t ((const bf16*)(ws + WS_WATT + (size_t)layer * WATT_STRIDE))
#define Wo_t ((const bf16*)(ws + WS_WATT + (size_t)layer * WATT_STRIDE + WATT_O))
#define Wgu8 (ws + WS_WMOE + (size_t)layer * WMOE_STRIDE)
#define Wd8 (ws + WS_WMOE + (size_t)layer * WMOE_STRIDE + WMOE_D)

        if (layer > 0) {
            if (EN_N1 && PHASE_ON()) {
            PHASE_IDS();
                f32x4 g[4];
#pragma unroll
                for (int j = 0; j < 4; ++j) g[j] = ((const f32x4*)(args.attn_g + layer * DM))[lane + 64 * j];
                for (int m = gw; m < NTOK; m += 2 * NGW) {
                    const int m2 = (m + NGW < NTOK) ? m + NGW : m;
                    f32x4* xa = (f32x4*)(XR + (size_t)m * DM) + lane; f32x4* xb = (f32x4*)(XR + (size_t)m2 * DM) + lane; f32x4 va[4], vb[4];
#pragma unroll
                    for (int j = 0; j < 4; ++j) { va[j] = xa[64 * j]; vb[j] = xb[64 * j]; }
                    const int sla = (lane < 16) ? (int)SLOT[(size_t)m * 16 + lane] : -1, slb = (lane < 16) ? (int)SLOT[(size_t)m2 * 16 + lane] : -1;
                    add_expert_rows(va, sla, m >> 11, XE, lane);
                    add_expert_rows(vb, slb, m2 >> 11, XE, lane);
#pragma unroll
                    for (int j = 0; j < 4; ++j) xa[64 * j] = va[j];
                    const float ra = row_rstd(va);
#pragma unroll
                    for (int j = 0; j < 4; ++j) va[j] = va[j] * ra * g[j];
                    store_row_bf16(H + (size_t)m * DM, va, lane);
                    if (m2 != m) {
#pragma unroll
                        for (int j = 0; j < 4; ++j) xb[64 * j] = vb[j];
                        const float rb = row_rstd(vb);
#pragma unroll
                        for (int j = 0; j < 4; ++j) vb[j] = vb[j] * rb * g[j];
                        store_row_bf16(H + (size_t)m2 * DM, vb, lane);
                    }
                }
            }
            PHASE_END();
        }

        if (EN_G1 && PHASE_ON()) {
            PHASE_IDS();
            pg8::Gemm g{H, Win_t, NTOK, n1, DM}; pg8::StaticOrder S; S.init(NTOK, n1, G, bx);
            const float* tc = tab + (mix == 1 ? 131072 : 0);
            LAS float* gl = (LAS float*)(ldsl + RING_BYTES);
            if (mix == 1 && tid < 128) gl[tid] = gperm[tid];
            __syncthreads();
            pg8::EpiQKV E{QKV, n1, tc, tc + 65536, (mix == 0) ? 8 : 5, 4, (mix == 1) ? gl : nullptr, (mix == 1) ? gl + 64 : nullptr, QSCALE};
            pg8::gemm_phase<pg8::EpiQKV, pg8::StaticOrder, true, true>(ldsl, g, S, E);
        }
        PHASE_END();

        if (EN_AT && PHASE_ON()) {
            PHASE_IDS();
            const int xq = bx & 7, jq = bx >> 3;
            if (EN_ATA && mix == 0) {
                const int jl = layer / 3;
                const float lambda_init = (layer == 0) ? 0.2f : 0.55605820416f;
                const float s1 = wave_sum(args.lq1[layer][lane] * args.lk1[layer][lane]), s2 = wave_sum(args.lq2[layer][lane] * args.lk2[layer][lane]);
                const float lam = __uint_as_float(__builtin_amdgcn_readfirstlane(__float_as_uint(__expf(s1) - __expf(s2) + lambda_init))); (void)jl;
                const float* subg = args.subln[layer];
                LAS unsigned* stash = (LAS unsigned*)(ldsl + 65536) + tid;
                for (int i = 0;; ++i) {
                    const int v = (G == 256) ? (i * 8 + xq) * 32 + jq : i * G + bx; if (v >= NB * 8 * 8) break;
                    const int bh = v >> 3, qb = v & 7, b = bh >> 3, h = bh & 7;
                    const bf16* base = QKV + (size_t)(b * SEQ) * 3072;
                    att::f32x16 o[4];
#pragma unroll 1
                    for (int c = 0; c < 2; ++c) {
                        __syncthreads();
                        att::attn_core<4, false>(o, base + (size_t)(qb * 256) * 3072 + 64 * (2 * h + c), base + 1024 + 64 * (2 * h + c), base + 2048 + 128 * h, 3072, SEQ / 64, 0, 0,
                                                 -__builtin_inff(), (char*)lds);
                        if (c == 0) {
#pragma unroll
                            for (int d = 0; d < 4; ++d)
#pragma unroll
                                for (int q = 0; q < 8; ++q) stash[(d * 8 + q) * 512] = att::cvtpk(o[d][2 * q], o[d][2 * q + 1]);
                        }
                    }
                    float ss[16], gs[4];
#pragma unroll
                    for (int d = 0; d < 4; ++d) gs[d] = subg[32 * d + (lane & 31)] * (1.0f - lambda_init);
#pragma unroll
                    for (int r = 0; r < 16; ++r) ss[r] = 0.f;
#pragma unroll
                    for (int d = 0; d < 4; ++d)
#pragma unroll
                        for (int q = 0; q < 8; ++q) { const unsigned w = stash[(d * 8 + q) * 512];
                            const float a = bflo(w) - lam * o[d][2 * q], bq = bfhi(w) - lam * o[d][2 * q + 1];
                            o[d][2 * q] = a; o[d][2 * q + 1] = bq; ss[2 * q] += a * a; ss[2 * q + 1] += bq * bq; }
#pragma unroll
                    for (int r = 0; r < 16; ++r) { const float s = sum32(ss[r]);
                        const float rstd = __builtin_amdgcn_rsqf(s * (1.0f / 128.0f) + RMS_EPS);
#pragma unroll
                        for (int d = 0; d < 4; ++d) o[d][r] *= rstd * gs[d]; }
                    att::store_o<4>(o, ATT + (size_t)(b * SEQ + qb * 256 + wave * 32) * DM + 128 * h, DM, lane);
                }
            } else if (EN_ATB) {
                for (int i = 0;; ++i) {
                    const int v = (G == 256) ? (i * 8 + xq) * 32 + jq : i * G + bx; if (v >= NB * 16 * 8) break;
                    const int grp = v >> 5, w = v & 31, b = grp >> 2, kvh = grp & 3, hq = kvh * 4 + (w >> 3), qb = w & 7;
                    const bf16* base = QKV + (size_t)(b * SEQ) * 1536;
                    att::f32x16 o[2];
                    __syncthreads();
                    if (mix == 1) {
                        att::attn_core<2, false>(o, base + (size_t)(qb * 256) * 1536 + 64 * hq, base + 1024 + 64 * kvh, base + 1280 + 64 * kvh, 1536, SEQ / 64, 0, 0, -__builtin_inff(), (char*)lds);
                    } else {
                        const int klo = (qb * 256 - 128) < 0 ? 0 : qb * 256 - 128, khi = (qb * 256 + 384) > SEQ ? SEQ : qb * 256 + 384;
                        att::attn_core<2, true>(o, base + (size_t)(qb * 256) * 1536 + 64 * hq, base + (size_t)klo * 1536 + 1024 + 64 * kvh, base + (size_t)klo * 1536 + 1280 + 64 * kvh, 1536,
                                                (khi - klo) / 64, qb * 256, klo, args.sinks[layer][hq] * 1.4426950408889634f, (char*)lds);
                    }
                    att::store_o<2>(o, ATT + (size_t)(b * SEQ + qb * 256 + wave * 32) * DM + 64 * hq, DM, lane);
                }
            }
        }
        PHASE_END();

        if (EN_G2 && PHASE_ON()) {
            PHASE_IDS();
            pg8::Gemm g{ATT, Wo_t, NTOK, DM, DM}; pg8::StaticOrder S; S.init(NTOK, DM, G, bx);
            pg8::EpiResF32 E{layer == 0 ? args.x : (const float*)XR, XR, DM};
            pg8::gemm_phase<pg8::EpiResF32, pg8::StaticOrder, true, true>(ldsl, g, S, E);
        }
        PHASE_END();

        if (EN_N2 && PHASE_ON()) {
            PHASE_IDS();
            LAS float* wr = (LAS float*)ldsl;
            const float* wsrc = args.w_router + (size_t)layer * DM * NE;
            for (int i4 = tid; i4 < DM * NE / 4; i4 += NWAVES * 64) { const f32x4 w = ((const f32x4*)wsrc)[i4]; const int col = i4 >> 2, e0 = (i4 & 3) * 4;
                wr[(e0 + 0) * DM + col] = w.x; wr[(e0 + 1) * DM + col] = w.y; wr[(e0 + 2) * DM + col] = w.z; wr[(e0 + 3) * DM + col] = w.w; }
            __syncthreads();
            f32x4 g[4];
#pragma unroll
            for (int j = 0; j < 4; ++j) g[j] = ((const f32x4*)(args.ffn_g + layer * DM))[lane + 64 * j];
            const bool hb3 = (lane & 8) != 0, hb2 = (lane & 4) != 0, hb1 = (lane & 2) != 0, hb0 = (lane & 1) != 0;
            for (int m0 = gw * 4; m0 < NTOK; m0 += NGW * 4) {
                f32x4 v[4][4];
#pragma unroll
                for (int t = 0; t < 4; ++t) { const f32x4* xr = (const f32x4*)(XR + (size_t)(m0 + t) * DM) + lane;
#pragma unroll
                    for (int j = 0; j < 4; ++j) v[t][j] = xr[64 * j]; }
#pragma unroll
                for (int t = 0; t < 4; ++t) { const float rstd = row_rstd(v[t]); unsigned* o4 = (unsigned*)(H8 + (size_t)(m0 + t) * DM) + lane;
#pragma unroll
                    for (int j = 0; j < 4; ++j) { v[t][j] = v[t][j] * rstd * g[j]; o4[64 * j] = pg8::cvt4_fp8(v[t][j].x, v[t][j].y, v[t][j].z, v[t][j].w); } }
                float acc[4][16];
#pragma unroll
                for (int e = 0; e < 16; ++e) {
#pragma unroll
                    for (int t = 0; t < 4; ++t) acc[t][e] = 0.f;
#pragma unroll
                    for (int j = 0; j < 4; ++j) { const f32x4 w = *(const LAS f32x4*)(wr + e * DM + 256 * j + 4 * lane);
#pragma unroll
                        for (int t = 0; t < 4; ++t) acc[t][e] += (v[t][j].x * w.x + v[t][j].y * w.y) + (v[t][j].z * w.z + v[t][j].w * w.w); }
                    if (e & 1) __builtin_amdgcn_sched_barrier(0);
                }
                float a8[4][8], b4[4][4], c2[4][2], d1[4], e2[2];
#pragma unroll
                for (int t = 0; t < 4; ++t)
#pragma unroll
                    for (int e = 0; e < 8; ++e) { auto r = __builtin_amdgcn_permlane32_swap(__float_as_uint(acc[t][e]), __float_as_uint(acc[t][e + 8]), false, false); a8[t][e] = __uint_as_float(r[0]) + __uint_as_float(r[1]); }
#pragma unroll
                for (int t = 0; t < 4; ++t)
#pragma unroll
                    for (int e = 0; e < 4; ++e) { auto r = __builtin_amdgcn_permlane16_swap(__float_as_uint(a8[t][e]), __float_as_uint(a8[t][e + 4]), false, false); b4[t][e] = __uint_as_float(r[0]) + __uint_as_float(r[1]); }
#pragma unroll
                for (int t = 0; t < 4; ++t)
#pragma unroll
                    for (int e = 0; e < 2; ++e) { const float keep = hb3 ? b4[t][e + 2] : b4[t][e], send = hb3 ? b4[t][e] : b4[t][e + 2]; c2[t][e] = keep + dpp_mirror(send); }
#pragma unroll
                for (int t = 0; t < 4; ++t) { const float keep = hb2 ? c2[t][1] : c2[t][0], send = hb2 ? c2[t][0] : c2[t][1]; d1[t] = keep + dpp_hmirror(send); }
#pragma unroll
                for (int t = 0; t < 2; ++t) { const float keep = hb1 ? d1[t + 2] : d1[t], send = hb1 ? d1[t] : d1[t + 2]; e2[t] = keep + dpp_xor2(send); }
                const float lg = (hb0 ? e2[1] : e2[0]) + dpp_xor1(hb0 ? e2[0] : e2[1]);
                float mx = fmaxf(lg, dpp_ror4(lg)); mx = fmaxf(mx, dpp_ror8(mx));
                { auto r = __builtin_amdgcn_permlane16_swap(__float_as_uint(mx), __float_as_uint(mx), false, false); mx = fmaxf(__uint_as_float(r[0]), __uint_as_float(r[1])); }
                { auto r = __builtin_amdgcn_permlane32_swap(__float_as_uint(mx), __float_as_uint(mx), false, false); mx = fmaxf(__uint_as_float(r[0]), __uint_as_float(r[1])); }
                const float p = __expf(lg - mx);
                float sm = p + dpp_ror4(p); sm += dpp_ror8(sm); sm = sum_swap32(sum_swap16(sm));
                AFF[((size_t)(m0 >> 11) * 16 + (lane >> 2)) * SEQ + (m0 & 2047) + (lane & 3)] = p / sm;
            }
            __syncthreads();
        }
        PHASE_END();

        if (EN_TK && PHASE_ON()) {
            PHASE_IDS();
            LAS unsigned* red = (LAS unsigned*)ldsl;
            LAS int* idxs = (LAS int*)(ldsl + 1024);
            for (int pair = bx; pair < NB * NE; pair += G) {
                const int b = pair >> 4, e = pair & 15;
                const f32x4 av = ((const f32x4*)(AFF + (size_t)pair * SEQ))[tid];
                const unsigned u0 = __float_as_uint(av.x), u1 = __float_as_uint(av.y), u2 = __float_as_uint(av.z), u3 = __float_as_uint(av.w);
                unsigned prefix = 0u;
                for (int bit = 30; bit >= 0; --bit) {
                    const unsigned cand = prefix | (1u << bit);
                    const unsigned cw = (unsigned)__popcll(__ballot(u0 >= cand)) + (unsigned)__popcll(__ballot(u1 >= cand)) + (unsigned)__popcll(__ballot(u2 >= cand)) + (unsigned)__popcll(__ballot(u3 >= cand));
                    LAS unsigned* rb = red + (bit & 1) * 8;
                    if (lane == 0) rb[wave] = cw;
                    __syncthreads();
                    unsigned tot = 0;
#pragma unroll
                    for (int w = 0; w < 8; ++w) tot += rb[w];
                    if (tot >= (unsigned)CAP) prefix = cand;
                }
                const unsigned T = prefix;
                const unsigned g0 = u0 > T, g1 = u1 > T, g2 = u2 > T, g3 = u3 > T, q0 = u0 == T, q1 = u1 == T, q2 = u2 == T, q3 = u3 == T;
                const unsigned long long bg0 = __ballot(g0), bg1 = __ballot(g1), bg2 = __ballot(g2), bg3 = __ballot(g3), bq0 = __ballot(q0), bq1 = __ballot(q1), bq2 = __ballot(q2), bq3 = __ballot(q3);
#define MBC(m) __builtin_amdgcn_mbcnt_hi((unsigned)((m) >> 32), __builtin_amdgcn_mbcnt_lo((unsigned)(m), 0u))
                const unsigned pre = (MBC(bg0) + MBC(bg1) + MBC(bg2) + MBC(bg3)) | ((MBC(bq0) + MBC(bq1) + MBC(bq2) + MBC(bq3)) << 16);
#undef MBC
                const unsigned wtot = (unsigned)(__popcll(bg0) + __popcll(bg1) + __popcll(bg2) + __popcll(bg3)) | ((unsigned)(__popcll(bq0) + __popcll(bq1) + __popcll(bq2) + __popcll(bq3)) << 16);
                LAS unsigned* tot8 = red + 16;
                __syncthreads();
                if (lane == 0) tot8[wave] = wtot;
                __syncthreads();
                unsigned woff = 0, all = 0;
#pragma unroll
                for (int w = 0; w < 8; ++w) { const unsigned t = tot8[w]; all += t; woff += (w < wave) ? t : 0u; }
                const unsigned excl = pre + woff;
                int bg = (int)(excl & 0xffffu), be = (int)(excl >> 16); const int ngt = (int)(all & 0xffffu), need = CAP - ngt;
                const size_t rowbase = (size_t)(e * 32 + b) * 256;
                int sl[4]; const unsigned gg[4] = {g0, g1, g2, g3}, qq[4] = {q0, q1, q2, q3}; const float vv[4] = {av.x, av.y, av.z, av.w};
#pragma unroll
                for (int q = 0; q < 4; ++q) { int s = -1;
                    if (gg[q]) s = bg++; else if (qq[q]) { const int r = be++; s = (r < need) ? ngt + r : -1; }
                    sl[q] = s;
                    if (s >= 0) { idxs[s] = 4 * tid + q; GATE[rowbase + s] = vv[q]; }
                    SLOT[((size_t)(b * SEQ + 4 * tid + q)) * 16 + e] = (short)s; }
                __syncthreads();
                for (int r0 = wave; r0 < CAP; r0 += 64) {
                    v4u t[8];
#pragma unroll
                    for (int k = 0; k < 8; ++k) { const int tok = idxs[r0 + 8 * k]; t[k] = ((const v4u*)(H8 + ((size_t)(b * SEQ + tok)) * DM))[lane]; }
#pragma unroll
                    for (int k = 0; k < 8; ++k) ((v4u*)(XE8 + (rowbase + r0 + 8 * k) * DM))[lane] = t[k];
                }
                __syncthreads();
            }
        }
        PHASE_END();

        if (EN_G3 && PHASE_ON()) {
            PHASE_IDS();
            pg8::Gemm g{(const pg8::bf16_t*)XE8, (const pg8::bf16_t*)Wgu8, NROWS_E, NE * 4096, DM}; pg8::GroupedOrder<16> S; S.init(G, bx);
            pg8::EpiSwiGLU8 E{HID8, FF};
            pg8::gemm_phase<pg8::EpiSwiGLU8, pg8::GroupedOrder<16>, true, true, true>(ldsl, g, S, E);
        }
        PHASE_END();

        if (EN_G4 && PHASE_ON()) {
            PHASE_IDS();
            pg8::Gemm g{(const pg8::bf16_t*)HID8, (const pg8::bf16_t*)Wd8, NROWS_E, NE * DM, FF}; pg8::GroupedOrder<4> S; S.init(G, bx);
            pg8::EpiDown E{XE, DM, GATE, 1.0f};
            pg8::gemm_phase<pg8::EpiDown, pg8::GroupedOrder<4>, true, true, true>(ldsl, g, S, E);
        }
        PHASE_END();
    }

    if (EN_FIN && PHASE_ON()) {
            PHASE_IDS();
        f32x4 g[4];
#pragma unroll
        for (int j = 0; j < 4; ++j) g[j] = ((const f32x4*)args.final_g)[lane + 64 * j];
        for (int m = gw; m < NTOK; m += 2 * NGW) {
            const int m2 = (m + NGW < NTOK) ? m + NGW : m;
            f32x4* xa = (f32x4*)(XR + (size_t)m * DM) + lane; f32x4* xb = (f32x4*)(XR + (size_t)m2 * DM) + lane; f32x4 va[4], vb[4];
#pragma unroll
            for (int j = 0; j < 4; ++j) { va[j] = xa[64 * j]; vb[j] = xb[64 * j]; }
            const int sla = (lane < 16) ? (int)SLOT[(size_t)m * 16 + lane] : -1, slb = (lane < 16) ? (int)SLOT[(size_t)m2 * 16 + lane] : -1;
            add_expert_rows(va, sla, m >> 11, XE, lane);
            add_expert_rows(vb, slb, m2 >> 11, XE, lane);
            const float ra = row_rstd(va);
#pragma unroll
            for (int j = 0; j < 4; ++j) xa[64 * j] = va[j] * ra * g[j];
            if (m2 != m) {
                const float rb = row_rstd(vb);
#pragma unroll
                for (int j = 0; j < 4; ++j) xb[64 * j] = vb[j] * rb * g[j];
            }
        }
    }
#undef PHASE_ON
#undef PHASE_END
}

extern "C" void kernel_launch(void* const* d_in, const int* in_sizes, int n_in, void* d_out, int out_size, void* d_ws, size_t ws_size, hipStream_t stream) {
    static int grid = 0;
    if (grid == 0) {
        if (n_in != 22 || in_sizes[0] != NTOK * DM || out_size != NTOK * DM || ws_size < WS_END) {
            fprintf(stderr, "kernel_launch: shape/workspace mismatch (n_in %d, in0 %d, out %d, ws %zu < %zu)\n", n_in, n_in > 0 ? in_sizes[0] : -1, out_size, ws_size, (size_t)WS_END); grid = -1; return; }
        int dev = 0, cus = 0;
        if (hipGetDevice(&dev) != hipSuccess || hipDeviceGetAttribute(&cus, hipDeviceAttributeMultiprocessorCount, dev) != hipSuccess) { grid = -1; return; }
        if (hipFuncSetAttribute((const void*)mk_fwd, hipFuncAttributeMaxDynamicSharedMemorySize, LDS_BYTES) != hipSuccess) { fprintf(stderr, "kernel_launch: hipFuncSetAttribute failed\n"); grid = -1; return; }
        int per_cu = 0;
        if (hipOccupancyMaxActiveBlocksPerMultiprocessor(&per_cu, (const void*)mk_fwd, NWAVES * 64, LDS_BYTES) != hipSuccess || per_cu < 1) fprintf(stderr, "kernel_launch: occupancy query says %d\n", per_cu);
        (void)hipGetLastError();
        grid = cus;
    }
    if (grid < 0) return;
    (void)hipMemsetAsync((char*)d_ws + WS_CTL, 0, CTL_ZERO_BYTES, stream);
    Args a{};
    const float* const* in = (const float* const*)d_in;
    a.x = in[0]; a.attn_g = in[1]; a.ffn_g = in[2]; a.final_g = in[3];
    for (int l = 0; l < 4; ++l) {
        const int m = l % 3, j = l / 3;
        a.w_in[l] = m == 0 ? in[4] + (size_t)j * DM * 3072 : (m == 1 ? in[11] + (size_t)j * DM * 1536 : in[15] + (size_t)j * DM * 1536);
        a.w_o[l] = m == 0 ? in[5] + (size_t)j * DM * DM : (m == 1 ? in[12] + (size_t)j * DM * DM : in[16] + (size_t)j * DM * DM);
        a.lq1[l] = in[6] + j * 64; a.lk1[l] = in[7] + j * 64; a.lq2[l] = in[8] + j * 64; a.lk2[l] = in[9] + j * 64; a.subln[l] = in[10] + j * 128;
        a.qn[l] = in[13]; a.kn[l] = in[14]; a.sinks[l] = in[17];
        if (m != 0) { a.lq1[l] = in[6]; a.lk1[l] = in[7]; a.lq2[l] = in[8]; a.lk2[l] = in[9]; a.subln[l] = in[10]; }
    }
    a.w_router = in[18]; a.w_gate = in[19]; a.w_up = in[20]; a.w_down = in[21];
    a.out = (float*)d_out; a.ws = (unsigned char*)d_ws;
    a.ph_lo = 0; a.ph_hi = 1000;
    hipLaunchKernelGGL(mk_fwd, dim3(grid), dim3(NWAVES * 64), LDS_BYTES, stream, a);
    const hipError_t le = hipPeekAtLastError();
    if (le != hipSuccess) fprintf(stderr, "kernel_launch: launch failed: %s\n", hipGetErrorName(le));
}
```

```cpp
#include <hip/hip_runtime.h>
#include <cstdio>
#include <cstdint>
#include <hip/hip_bf16.h>
#ifndef PROBE_TYPE
#define PROBE_TYPE (-1)
#endif
__device__ __forceinline__ int fresh_lane() { unsigned ones = ~0u; asm volatile("" : "+s"(ones)); return (int)__builtin_amdgcn_mbcnt_hi(ones, __builtin_amdgcn_mbcnt_lo(ones, 0u)); }
__device__ __forceinline__ int fresh_tid(int wv) { asm volatile("" : "+s"(wv)); return (wv << 6) | fresh_lane(); }
__device__ __forceinline__ float dpp_xor1(float v) { return __uint_as_float((unsigned)__builtin_amdgcn_update_dpp(0, (int)__float_as_uint(v), 0xB1, 0xF, 0xF, true)); }
__device__ __forceinline__ float dpp_xor2(float v) { return __uint_as_float((unsigned)__builtin_amdgcn_update_dpp(0, (int)__float_as_uint(v), 0x4E, 0xF, 0xF, true)); }
__device__ __forceinline__ float dpp_hmirror(float v) { return __uint_as_float((unsigned)__builtin_amdgcn_update_dpp(0, (int)__float_as_uint(v), 0x141, 0xF, 0xF, true)); }
__device__ __forceinline__ float dpp_mirror(float v) { return __uint_as_float((unsigned)__builtin_amdgcn_update_dpp(0, (int)__float_as_uint(v), 0x140, 0xF, 0xF, true)); }
__device__ __forceinline__ float dpp_ror4(float v) { return __uint_as_float((unsigned)__builtin_amdgcn_update_dpp(0, (int)__float_as_uint(v), 0x124, 0xF, 0xF, true)); }
__device__ __forceinline__ float dpp_ror8(float v) { return __uint_as_float((unsigned)__builtin_amdgcn_update_dpp(0, (int)__float_as_uint(v), 0x128, 0xF, 0xF, true)); }
__device__ __forceinline__ float sum_swap16(float v) { auto r = __builtin_amdgcn_permlane16_swap(__float_as_uint(v), __float_as_uint(v), false, false); return __uint_as_float(r[0]) + __uint_as_float(r[1]); }
__device__ __forceinline__ float sum_swap32(float v) { auto r = __builtin_amdgcn_permlane32_swap(__float_as_uint(v), __float_as_uint(v), false, false); return __uint_as_float(r[0]) + __uint_as_float(r[1]); }
__device__ __forceinline__ float sum16(float v) { v += dpp_xor1(v); v += dpp_xor2(v); v += dpp_hmirror(v); v += dpp_mirror(v); return v; }
__device__ __forceinline__ float sum32(float v) { return sum_swap16(sum16(v)); }
__device__ __forceinline__ float sum64(float v) { return sum_swap32(sum32(v)); }
namespace pg8 {
#define PG8_LAS __attribute__((address_space(3)))
typedef unsigned short bf16_t;
typedef short bf16x8 __attribute__((ext_vector_type(8)));
typedef float f32x4 __attribute__((ext_vector_type(4)));
typedef unsigned u32x4 __attribute__((ext_vector_type(4)));
constexpr int BM = 256, BK = 64, HALF = 128, HTB = HALF * BK * 2  , STAGE_BYTES = 8 * HTB, NXCD = 8, WGM = 8;

__host__ __device__ __forceinline__ int lds_byte(int r, int c) { const int st = (r >> 4) * 2 + (c >> 5), rr = r & 15, cc = c & 31, ob = rr * 64 + cc * 2; return st * 1024 + (ob ^ (((ob >> 9) & 1) << 5)); }
__host__ __device__ __forceinline__ void stage_rc(int b, int& R, int& C) { const int st = b / 1024, sb = b % 1024, swz = sb ^ (((sb >> 9) & 1) << 5); R = (st >> 1) * 16 + swz / 64; C = (st & 1) * 32 + (swz % 64) / 2; }
__host__ __device__ __forceinline__ int perm32(int rho) { const int n = rho >> 4, i = rho & 15; return 8 * (i >> 2) + 4 * n + (i & 3); }

struct Unit { int pm, pn, par; };
struct Gemm { const bf16_t* A; const bf16_t* Bt; int M, N, K; const int* tok = nullptr; const float* rowv = nullptr; };

struct StaticOrder {
    int nM, nN, nwg, G, c;
    __host__ __device__ void init(int M, int N, int G_, int c_) { nM = M / BM; nN = N / BM; nwg = nM * nN; G = G_; c = c_; }
    __host__ __device__ bool next(int i, Unit& u) const {
        const long L = (long)i * G + c; if (L >= nwg) return false;
        int wgid = (int)L; { const int q = nwg / NXCD, r = nwg % NXCD, xcd = wgid % NXCD, off = wgid / NXCD; wgid = (xcd < r ? xcd * (q + 1) : r * (q + 1) + (xcd - r) * q) + off; }
        const int nig = WGM * nN, gid = wgid / nig, fm = gid * WGM, gsz = (nM - fm) < WGM ? (nM - fm) : WGM;
        u.pm = fm + ((wgid % nig) % gsz); u.pn = (wgid % nig) / gsz; return true;
    }
    __device__ __forceinline__ void a_ready(const Unit&) const {}
    __device__ __forceinline__ void done(const Unit&) const {}
};


template <int NNL> struct GroupedOrder {
    int G, c, nunits;
    __device__ void init(int G_, int c_) { G = G_; c = c_; nunits = 16 * 32 * NNL; }
    __device__ bool next(int i, Unit& u) const {
        const int L = i * G + c; if (L >= nunits) return false;
        if (G == 256) {
            const int x = c & 7, j = c >> 3;
            if (NNL == 16) { const int e = i >> 1, hh = i & 1; u.pm = e * 32 + 4 * x + (j & 3); u.pn = e * 16 + 8 * hh + (j >> 2); }
            else { const int e = 2 * i + (j >> 4); u.pm = e * 32 + 4 * x + (j & 3); u.pn = e * NNL + ((j >> 2) & 3); }
        } else { const int pmg = L / NNL; u.pm = pmg; u.pn = (pmg >> 5) * NNL + (L % NNL); }
        return true;
    }
    __device__ __forceinline__ void a_ready(const Unit&) const {}
    __device__ __forceinline__ void done(const Unit&) const {}
};

__device__ __forceinline__ unsigned cvt_pk_bf16(float lo, float hi) { unsigned r; asm volatile("v_cvt_pk_bf16_f32 %0, %1, %2" : "=v"(r) : "v"(lo), "v"(hi)); return r; }

struct EpiQKV {
    static constexpr bool PERM = true, AFTER_DRAIN = false;
    bf16_t* O; int ldc; const float* tcos; const float* tsin; int nrope, nq; const PG8_LAS float* qg; const PG8_LAS float* kg; float qscale; const float* rstd;
    __device__ __forceinline__ void operator()(const f32x4 (&acc)[2][2][4][2], const Unit& u, int wr, int wc, int fr, int fq) const {
        const int row0 = u.pm * BM + wr * 64 + fr, col0 = u.pn * BM + wc * 64 + 8 * fq;
        const bool rope = u.pn < nrope; const float sc = (u.pn < nq) ? qscale : 1.0f;
        const PG8_LAS float* gp = (u.pn < nq) ? qg : kg;
        float rs[2][4];
#pragma unroll
        for (int ai = 0; ai < 2; ++ai)
#pragma unroll
            for (int m = 0; m < 4; ++m) rs[ai][m] = rstd[row0 + ai * HALF + m * 16];
        f32x4 gv[2][2];
        if (rope && gp) {
#pragma unroll
            for (int bj = 0; bj < 2; ++bj)
#pragma unroll
                for (int n = 0; n < 2; ++n) gv[bj][n] = *(const PG8_LAS f32x4*)(gp + 32 * bj + 8 * fq + 4 * n);
        }
#pragma unroll
        for (int ai = 0; ai < 2; ++ai)
#pragma unroll
            for (int m = 0; m < 4; ++m) {
                const int row = row0 + ai * HALF + m * 16;
                f32x4 v[2][2];
#pragma unroll
                for (int bj = 0; bj < 2; ++bj)
#pragma unroll
                    for (int n = 0; n < 2; ++n) v[bj][n] = acc[ai][bj][m][n] * rs[ai][m];
                if (rope) {
                    if (gp) {
                        float ss = 0.f;
#pragma unroll
                        for (int bj = 0; bj < 2; ++bj)
#pragma unroll
                            for (int n = 0; n < 2; ++n) ss += (v[bj][n][0] * v[bj][n][0] + v[bj][n][1] * v[bj][n][1]) + (v[bj][n][2] * v[bj][n][2] + v[bj][n][3] * v[bj][n][3]);
                        ss = sum_swap32(sum_swap16(ss));
                        const float rstd = __builtin_amdgcn_rsqf(ss * (1.0f / 64.0f) + 1e-6f);
#pragma unroll
                        for (int bj = 0; bj < 2; ++bj)
#pragma unroll
                            for (int n = 0; n < 2; ++n) v[bj][n] = v[bj][n] * rstd * gv[bj][n];
                    }
                    const int s = row & 2047;
#pragma unroll
                    for (int n = 0; n < 2; ++n) {
                        const f32x4 c = *(const f32x4*)(tcos + s * 32 + 8 * fq + 4 * n), sn = *(const f32x4*)(tsin + s * 32 + 8 * fq + 4 * n);
                        const f32x4 x1 = v[0][n], x2 = v[1][n];
                        v[0][n] = x1 * c - x2 * sn; v[1][n] = x2 * c + x1 * sn;
                    }
                }
                bf16_t* rowp = O + (size_t)row * ldc + col0;
#pragma unroll
                for (int bj = 0; bj < 2; ++bj) { const f32x4 v0 = v[bj][0] * sc, v1 = v[bj][1] * sc;
                    u32x4 w; w.x = cvt_pk_bf16(v0[0], v0[1]); w.y = cvt_pk_bf16(v0[2], v0[3]); w.z = cvt_pk_bf16(v1[0], v1[1]); w.w = cvt_pk_bf16(v1[2], v1[3]);
                    *(u32x4*)(rowp + bj * 32) = w; }
            }
    }
};
struct EpiResBf16 {
    static constexpr bool PERM = true, AFTER_DRAIN = false;
    bf16_t* X; int ldc;
    __device__ __forceinline__ void operator()(const f32x4 (&acc)[2][2][4][2], const Unit& u, int wr, int wc, int fr, int fq) const {
        const int row0 = u.pm * BM + wr * 64 + fr, col0 = u.pn * BM + wc * 32 + 8 * fq;
        u32x4 ball[2][4][2];
#pragma unroll
        for (int ai = 0; ai < 2; ++ai)
#pragma unroll
            for (int m = 0; m < 4; ++m)
#pragma unroll
                for (int bj = 0; bj < 2; ++bj) ball[ai][m][bj] = *(const u32x4*)(X + (size_t)(row0 + ai * HALF + m * 16) * ldc + col0 + bj * HALF);
        asm volatile("" ::: "memory");
#pragma unroll
        for (int ai = 0; ai < 2; ++ai)
#pragma unroll
            for (int m = 0; m < 4; ++m) { bf16_t* rowp = X + (size_t)(row0 + ai * HALF + m * 16) * ldc + col0;
#pragma unroll
                for (int bj = 0; bj < 2; ++bj) { const f32x4 a0 = acc[ai][bj][m][0], a1 = acc[ai][bj][m][1]; const u32x4 x = ball[ai][m][bj];
                    u32x4 w;
                    w.x = cvt_pk_bf16(a0[0] + __uint_as_float(x.x << 16), a0[1] + __uint_as_float(x.x & 0xffff0000u));
                    w.y = cvt_pk_bf16(a0[2] + __uint_as_float(x.y << 16), a0[3] + __uint_as_float(x.y & 0xffff0000u));
                    w.z = cvt_pk_bf16(a1[0] + __uint_as_float(x.z << 16), a1[1] + __uint_as_float(x.z & 0xffff0000u));
                    w.w = cvt_pk_bf16(a1[2] + __uint_as_float(x.w << 16), a1[3] + __uint_as_float(x.w & 0xffff0000u));
                    *(u32x4*)(rowp + bj * HALF) = w; }
            }
    }
};
struct EpiSwiGLU {
    static constexpr bool PERM = true, AFTER_DRAIN = false;
    bf16_t* O; int ldc;
    __device__ __forceinline__ void operator()(const f32x4 (&acc)[2][2][4][2], const Unit& u, int wr, int wc, int fr, int fq) const {
        const int row0 = u.pm * BM + wr * 64 + fr, col0 = (u.pn & 15) * HALF + wc * 32 + 8 * fq;
#pragma unroll
        for (int ai = 0; ai < 2; ++ai)
#pragma unroll
            for (int m = 0; m < 4; ++m) { bf16_t* rowp = O + (size_t)(row0 + ai * HALF + m * 16) * ldc + col0;
                f32x4 h[2];
#pragma unroll
                for (int n = 0; n < 2; ++n) { const f32x4 g = acc[ai][0][m][n], up = acc[ai][1][m][n];
#pragma unroll
                    for (int j = 0; j < 4; ++j) { const float e = __builtin_amdgcn_exp2f(g[j] * -1.4426950408889634f); h[n][j] = g[j] * __builtin_amdgcn_rcpf(1.0f + e) * up[j]; } }
                u32x4 w; w.x = cvt_pk_bf16(h[0][0], h[0][1]); w.y = cvt_pk_bf16(h[0][2], h[0][3]); w.z = cvt_pk_bf16(h[1][0], h[1][1]); w.w = cvt_pk_bf16(h[1][2], h[1][3]);
                *(u32x4*)rowp = w; }
    }
};
__device__ __forceinline__ unsigned cvt4_fp8(float a, float b, float c, float d) { int r = __builtin_amdgcn_cvt_pk_fp8_f32(a, b, 0, false); r = __builtin_amdgcn_cvt_pk_fp8_f32(c, d, r, true); return (unsigned)r; }
constexpr float W8_SCALE = 32.0f, W8_INV = 1.0f / 32.0f;
struct EpiSwiGLU8 {
    static constexpr bool PERM = true, AFTER_DRAIN = false;
    unsigned char* O; int ldc;
    __device__ __forceinline__ void operator()(const f32x4 (&acc)[2][2][4][2], const Unit& u, int wr, int wc, int fr, int fq) const {
        const int row0 = u.pm * BM + wr * 64 + fr + 16 * (fq & 1), col0 = (u.pn & 15) * HALF + wc * 32 + 16 * (fq >> 1);
        typedef unsigned u32x2 __attribute__((ext_vector_type(2)));
#pragma unroll
        for (int ai = 0; ai < 2; ++ai)
#pragma unroll
            for (int mp = 0; mp < 4; mp += 2) { unsigned char* rowp = O + (size_t)(row0 + ai * HALF + mp * 16) * ldc + col0;
                u32x2 w[2];
#pragma unroll
                for (int k = 0; k < 2; ++k) { const int m = mp + k;
                    f32x4 h[2];
#pragma unroll
                    for (int n = 0; n < 2; ++n) { const f32x4 g = acc[ai][0][m][n], up = acc[ai][1][m][n];
                        const f32x4 t = g * -1.4426950408889634f, gu = g * up;
                        f32x4 e; e[0] = __builtin_amdgcn_exp2f(t[0]); e[1] = __builtin_amdgcn_exp2f(t[1]); e[2] = __builtin_amdgcn_exp2f(t[2]); e[3] = __builtin_amdgcn_exp2f(t[3]);
                        const f32x4 d = e + 1.0f;
                        f32x4 r; r[0] = __builtin_amdgcn_rcpf(d[0]); r[1] = __builtin_amdgcn_rcpf(d[1]); r[2] = __builtin_amdgcn_rcpf(d[2]); r[3] = __builtin_amdgcn_rcpf(d[3]);
                        h[n] = gu * r; }
                    w[k].x = cvt4_fp8(h[0][0], h[0][1], h[0][2], h[0][3]); w[k].y = cvt4_fp8(h[1][0], h[1][1], h[1][2], h[1][3]); }
                const auto sx = __builtin_amdgcn_permlane16_swap(w[0].x, w[1].x, false, false), sy = __builtin_amdgcn_permlane16_swap(w[0].y, w[1].y, false, false);
                u32x4 o; o.x = sx[0]; o.y = sy[0]; o.z = sx[1]; o.w = sy[1];
                *(u32x4*)rowp = o; }
    }
};
struct EpiDown {
    static constexpr bool PERM = true, AFTER_DRAIN = false;
    unsigned char* O; int ldc; const PG8_LAS float* gate; float osc;
    __device__ __forceinline__ void operator()(const f32x4 (&acc)[2][2][4][2], const Unit& u, int wr, int wc, int fr, int fq) const {
        const int row0 = u.pm * BM + wr * 64 + fr, col0 = (u.pn & 3) * BM + wc * 64 + 16 * (fq >> 1) + 32 * (fq & 1);
        typedef unsigned u32x2 __attribute__((ext_vector_type(2)));
#pragma unroll
        for (int ai = 0; ai < 2; ++ai)
#pragma unroll
            for (int m = 0; m < 4; ++m) { const int row = row0 + ai * HALF + m * 16; const float gt = gate[u.par * 512 + (row & 255)] * osc; unsigned char* rowp = O + (size_t)row * ldc + col0;
                u32x2 w[2];
#pragma unroll
                for (int bj = 0; bj < 2; ++bj) { const f32x4 v0 = acc[ai][bj][m][0] * gt, v1 = acc[ai][bj][m][1] * gt;
                    w[bj].x = cvt4_fp8(v0[0], v0[1], v0[2], v0[3]); w[bj].y = cvt4_fp8(v1[0], v1[1], v1[2], v1[3]); }
                const auto sx = __builtin_amdgcn_permlane16_swap(w[0].x, w[1].x, false, false), sy = __builtin_amdgcn_permlane16_swap(w[0].y, w[1].y, false, false);
                u32x4 o; o.x = sx[0]; o.y = sy[0]; o.z = sx[1]; o.w = sy[1];
                *(u32x4*)rowp = o; }
    }
};


__device__ __forceinline__ void glds16s(const char* gbase, unsigned voff, unsigned lds_dst) {
    unsigned keep; const unsigned dst = __builtin_amdgcn_readfirstlane(lds_dst);
    asm volatile("s_mov_b32 %0, m0\n\ts_mov_b32 m0, %3\n\ts_nop 0\n\tglobal_load_lds_dwordx4 %1, %2\n\ts_mov_b32 m0, %0" : "=&s"(keep) : "v"(voff), "s"(gbase), "s"(dst) : "memory");
}
__device__ __forceinline__ void glds4s(const char* gbase, unsigned voff, unsigned lds_dst) {
    unsigned keep; const unsigned dst = __builtin_amdgcn_readfirstlane(lds_dst);
    asm volatile("s_mov_b32 %0, m0\n\ts_mov_b32 m0, %3\n\ts_nop 0\n\tglobal_load_lds_dword %1, %2\n\ts_mov_b32 m0, %0" : "=&s"(keep) : "v"(voff), "s"(gbase), "s"(dst) : "memory");
}
typedef int i32x4 __attribute__((ext_vector_type(4)));
typedef int i32x8 __attribute__((ext_vector_type(8)));
template <class Epi, class Sched, bool ALIGN_EPI = false, bool SP2 = false, bool F8 = false, bool GATHER = false, bool ROWV = false>
__device__ __forceinline__ void gemm_phase(PG8_LAS unsigned char* lds, const Gemm g, const Sched& S, const Epi& E, int wv) {
    const int tid = fresh_tid(wv), wid = __builtin_amdgcn_readfirstlane(tid >> 6), lane = tid & 63, wr = wid >> 2, wc = wid & 3, fr = lane & 15, fq = lane >> 4;
    const int K = F8 ? g.K / 2 : g.K, nt = K / BK;
    unsigned voffA[2], voffB[2];
#pragma unroll
    for (int i = 0; i < 2; ++i) { int R, C; stage_rc(tid * 16 + i * 8192, R, C); const int Rb = Epi::PERM ? ((R & ~31) + perm32(R & 31)) : R;
        voffA[i] = (unsigned)(R * K + C) * 2u; voffB[i] = (unsigned)(Rb * K + C) * 2u; }
    const size_t kstep = (size_t)(BK * 2);
    const size_t hstep = (size_t)HALF * K * 2;
    const size_t tstep = 2 * hstep;
    static_assert(!GATHER || SP2, "GATHER is written for the SP2 K-loop");
    static_assert(!ROWV || (SP2 && !GATHER), "ROWV is written for the SP2 K-loop without GATHER");
    const size_t hstepA = GATHER ? 0 : hstep, tstepA = GATHER ? 0 : tstep;
    const unsigned rowb = (unsigned)K * 2u;
    const unsigned ldsw = (unsigned)wid * 1024u;
    const int aoff = lds_byte(wr * 64 + fr, fq * 8), boff = lds_byte(wc * 32 + fr, fq * 8);
#define PG8_SA(b, h) (((b) * 2 + (h)) * HTB)
#define PG8_SB(b, h) ((4 + (b) * 2 + (h)) * HTB)
    int sc8 = 0x7f7f7a7a; asm volatile("" : "+v"(sc8));
    const unsigned ldsb = (unsigned)(uintptr_t)lds;
#define PG8_STAGE(bufoff, gbase, voff) do { _Pragma("unroll") for (int _i = 0; _i < 2; ++_i) \
        glds16s((const char*)(gbase), (voff)[_i], ldsb + (unsigned)(bufoff) + ldsw + (unsigned)(_i * 8192)); } while (0)
#define PG8_LDA(dst, b, h) do { _Pragma("unroll") for (int m = 0; m < 4; ++m) _Pragma("unroll") for (int k = 0; k < 2; ++k) dst[m][k] = *(const PG8_LAS bf16x8*)(lds + PG8_SA(b, h) + aoff + m * 2048 + k * 1024); } while (0)
#define PG8_LDB(dst, b, h) do { _Pragma("unroll") for (int n = 0; n < 2; ++n) _Pragma("unroll") for (int k = 0; k < 2; ++k) dst[n][k] = *(const PG8_LAS bf16x8*)(lds + PG8_SB(b, h) + boff + n * 2048 + k * 1024); } while (0)
#define PG8_CAT(x) __builtin_shufflevector(__builtin_bit_cast(i32x4, (x)[0]), __builtin_bit_cast(i32x4, (x)[1]), 0, 1, 2, 3, 4, 5, 6, 7)
#define PG8_MMA(ai, bj, At, Bt) do { __builtin_amdgcn_s_setprio(1); _Pragma("unroll") for (int m = 0; m < 4; ++m) _Pragma("unroll") for (int n = 0; n < 2; ++n) { \
        if constexpr (F8) acc[ai][bj][m][n] = __builtin_amdgcn_mfma_scale_f32_16x16x128_f8f6f4(PG8_CAT(Bt[n]), PG8_CAT(At[m]), acc[ai][bj][m][n], 0, 0, 0, sc8, 2, sc8); \
        else { _Pragma("unroll") for (int k = 0; k < 2; ++k) acc[ai][bj][m][n] = __builtin_amdgcn_mfma_f32_16x16x32_bf16(Bt[n][k], At[m][k], acc[ai][bj][m][n], 0, 0, 0); } } __builtin_amdgcn_s_setprio(0); } while (0)
#define PG8_WAIT_V(n) asm volatile("s_waitcnt vmcnt(" #n ")" ::: "memory")
#define PG8_WAIT_L(n) asm volatile("s_waitcnt lgkmcnt(" #n ")" ::: "memory")
#define PG8_BAR __builtin_amdgcn_s_barrier()
#define PG8_SCHED __builtin_amdgcn_sched_barrier(0)
    Unit cur, nxt; int ui = 0;
    if (!S.next(0, cur)) return;
    f32x4 acc[2][2][4][2];
    float zacc_ = 0.f; asm volatile("" : "+v"(zacc_));
#pragma unroll
    for (int a = 0; a < 2; ++a)
#pragma unroll
        for (int b = 0; b < 2; ++b)
#pragma unroll
            for (int m = 0; m < 4; ++m)
#pragma unroll
                for (int n = 0; n < 2; ++n) acc[a][b][m][n] = (f32x4){zacc_, zacc_, zacc_, zacc_};
    bf16x8 At[4][2], B0[2][2], B1[2][2];
    const char* cA = (const char*)g.A + (size_t)cur.pm * tstepA; const char* cB = (const char*)g.Bt + (size_t)cur.pn * tstep;
    S.a_ready(cur);
    unsigned cv[2][2], sv[2][2];
    const PG8_LAS unsigned* tokl = (const PG8_LAS unsigned*)(lds + STAGE_BYTES + 1024) + wid * 256 + lane;
    if constexpr (GATHER) {
#pragma unroll
        for (int h = 0; h < 2; ++h)
#pragma unroll
            for (int i = 0; i < 2; ++i) { cv[h][i] = (unsigned)g.tok[cur.pm * BM + h * HALF + (int)(voffA[i] / rowb)] * rowb + (voffA[i] & (rowb - 1u)); sv[h][i] = cv[h][i]; }
    }
#define PG8_STAGEA(bufoff, gbase, h, nx) do { unsigned v0_, v1_; if constexpr (GATHER) { v0_ = (nx) ? sv[h][0] : cv[h][0]; v1_ = (nx) ? sv[h][1] : cv[h][1]; } else { v0_ = voffA[0]; v1_ = voffA[1]; } \
        glds16s((const char*)(gbase), v0_, ldsb + (unsigned)(bufoff) + ldsw); glds16s((const char*)(gbase), v1_, ldsb + (unsigned)(bufoff) + ldsw + 8192u); } while (0)
    if constexpr (SP2) {
        PG8_STAGE(PG8_SB(0, 0), cB, voffB); PG8_STAGE(PG8_SB(0, 1), cB + hstep, voffB); PG8_STAGEA(PG8_SA(0, 0), cA, 0, false); PG8_STAGEA(PG8_SA(0, 1), cA + hstepA, 1, false);
        if (wr == 1) PG8_BAR;
        PG8_WAIT_V(2); PG8_BAR;
        PG8_STAGE(PG8_SB(1, 0), cB + kstep, voffB); PG8_STAGEA(PG8_SA(1, 0), cA + kstep, 0, false); PG8_STAGE(PG8_SB(1, 1), cB + hstep + kstep, voffB);
        PG8_WAIT_V(6); PG8_BAR;
    } else {
        PG8_STAGE(PG8_SB(0, 0), cB, voffB); PG8_STAGE(PG8_SA(0, 0), cA, voffA); PG8_STAGE(PG8_SB(0, 1), cB + hstep, voffB); PG8_STAGE(PG8_SA(0, 1), cA + hstep, voffA);
        if (wr == 1) PG8_BAR;
        PG8_WAIT_V(4); PG8_BAR;
        PG8_STAGE(PG8_SB(1, 0), cB + kstep, voffB); PG8_STAGE(PG8_SA(1, 0), cA + kstep, voffA); PG8_STAGE(PG8_SB(1, 1), cB + hstep + kstep, voffB);
        PG8_WAIT_V(6); PG8_BAR;
    }
    for (;;) {
        const bool has_next = S.next(ui + 1, nxt);
        const char* nA = has_next ? (const char*)g.A + (size_t)nxt.pm * tstepA : cA; const char* nB = has_next ? (const char*)g.Bt + (size_t)nxt.pn * tstep : cB;
#pragma unroll 1
        for (int t = 0; t < nt; t += 2) {
            const bool last = (t == nt - 2);
            const char* a1 = cA + (size_t)(t + 1) * kstep;
            const char* a2 = last ? nA : cA + (size_t)(t + 2) * kstep; const char* b2 = last ? nB : cB + (size_t)(t + 2) * kstep;
            const char* a3 = a2 + kstep; const char* b3 = b2 + kstep;
            if (last && has_next) S.a_ready(nxt);
            if constexpr (GATHER) {
                if (last && has_next) {
                    asm volatile("" ::: "memory");
#pragma unroll
                    for (int h = 0; h < 2; ++h)
#pragma unroll
                        for (int i = 0; i < 2; ++i) sv[h][i] = tokl[(h * 2 + i) * 64] * rowb + (voffA[i] & (rowb - 1u));
                    asm volatile("" : "+v"(sv[0][0]), "+v"(sv[0][1]), "+v"(sv[1][0]), "+v"(sv[1][1]) :: "memory");
                }
            }
            if constexpr (SP2) {
            PG8_LDB(B0, 0, 0); PG8_LDB(B1, 0, 1); PG8_SCHED; PG8_LDA(At, 0, 0);
            if (GATHER && t == 0 && has_next) {
#pragma unroll
                for (int h = 0; h < 2; ++h)
#pragma unroll
                    for (int i = 0; i < 2; ++i) glds4s((const char*)g.tok, (unsigned)(nxt.pm * BM + h * HALF + (int)(voffA[i] / rowb)) * 4u, ldsb + (unsigned)STAGE_BYTES + 1024u + (unsigned)wid * 1024u + (unsigned)(h * 2 + i) * 256u);
                PG8_STAGEA(PG8_SA(1, 1), a1 + hstepA, 1, false);
                PG8_WAIT_V(12);
            } else if (ROWV && t == 0) {
                glds4s((const char*)g.rowv, (unsigned)(cur.pm * BM + (wid & 3) * 64 + lane) * 4u, ldsb + (unsigned)STAGE_BYTES + 9216u + (unsigned)(ui & 1) * 2048u + (unsigned)wid * 256u);
                PG8_STAGEA(PG8_SA(1, 1), a1 + hstepA, 1, false);
                PG8_WAIT_V(9);
            } else {
                PG8_STAGEA(PG8_SA(1, 1), a1 + hstepA, 1, false);
                PG8_WAIT_V(8);
            }
            PG8_WAIT_L(0); PG8_BAR; PG8_MMA(0, 0, At, B0); PG8_MMA(0, 1, At, B1); PG8_BAR; PG8_SCHED;
            PG8_LDA(At, 0, 1); PG8_STAGE(PG8_SB(0, 0), b2, voffB); PG8_STAGE(PG8_SB(0, 1), b2 + hstep, voffB); PG8_STAGEA(PG8_SA(0, 0), a2, 0, true);
            PG8_WAIT_V(8); PG8_WAIT_L(0); PG8_BAR; PG8_MMA(1, 0, At, B0); PG8_MMA(1, 1, At, B1); PG8_BAR; PG8_SCHED;
            PG8_LDB(B0, 1, 0); PG8_LDB(B1, 1, 1); PG8_SCHED; PG8_LDA(At, 1, 0); PG8_STAGEA(PG8_SA(0, 1), a2 + hstepA, 1, true);
            PG8_WAIT_V(8); PG8_WAIT_L(0); PG8_BAR; PG8_MMA(0, 0, At, B0); PG8_MMA(0, 1, At, B1); PG8_BAR; PG8_SCHED;
            PG8_LDA(At, 1, 1); PG8_STAGE(PG8_SB(1, 0), b3, voffB); PG8_STAGE(PG8_SB(1, 1), b3 + hstep, voffB); PG8_STAGEA(PG8_SA(1, 0), a3, 0, true);
            PG8_WAIT_V(8); PG8_WAIT_L(0); PG8_BAR; PG8_MMA(1, 0, At, B0); PG8_MMA(1, 1, At, B1); PG8_BAR; PG8_SCHED;
            } else {
            PG8_LDB(B0, 0, 0); PG8_SCHED; PG8_LDA(At, 0, 0); PG8_STAGE(PG8_SA(1, 1), a1 + hstep, voffA);
            PG8_WAIT_L(8); PG8_BAR; PG8_WAIT_L(0); PG8_MMA(0, 0, At, B0); PG8_BAR; PG8_SCHED;
            PG8_LDB(B1, 0, 1); PG8_STAGE(PG8_SB(0, 0), b2, voffB);
            PG8_BAR; PG8_WAIT_L(0); PG8_MMA(0, 1, At, B1); PG8_BAR;
            PG8_LDA(At, 0, 1); PG8_STAGE(PG8_SA(0, 0), a2, voffA);
            PG8_BAR; PG8_WAIT_L(0); PG8_MMA(1, 0, At, B0); PG8_BAR; PG8_SCHED;
            PG8_STAGE(PG8_SB(0, 1), b2 + hstep, voffB);
            PG8_WAIT_V(6); PG8_BAR; PG8_MMA(1, 1, At, B1); PG8_BAR;
            PG8_LDB(B0, 1, 0); PG8_SCHED; PG8_LDA(At, 1, 0); PG8_STAGE(PG8_SA(0, 1), a2 + hstep, voffA);
            PG8_WAIT_L(8); PG8_BAR; PG8_WAIT_L(0); PG8_MMA(0, 0, At, B0); PG8_BAR; PG8_SCHED;
            PG8_LDB(B1, 1, 1); PG8_STAGE(PG8_SB(1, 0), b3, voffB);
            PG8_BAR; PG8_WAIT_L(0); PG8_MMA(0, 1, At, B1); PG8_BAR;
            PG8_LDA(At, 1, 1); PG8_STAGE(PG8_SA(1, 0), a3, voffA);
            PG8_BAR; PG8_WAIT_L(0); PG8_MMA(1, 0, At, B0); PG8_BAR; PG8_SCHED;
            PG8_STAGE(PG8_SB(1, 1), b3 + hstep, voffB);
            PG8_WAIT_V(6); PG8_BAR; PG8_MMA(1, 1, At, B1); PG8_BAR;
            }
        }
        if constexpr (ALIGN_EPI) { if (wr == 0) PG8_BAR; }
        cur.par = ui & 1;
        if constexpr (!Epi::AFTER_DRAIN) { const int l_ = fresh_lane(); E(acc, cur, wr, wc, l_ & 15, l_ >> 4); S.done(cur); }
        if (!has_next) break;
#pragma unroll
        for (int a = 0; a < 2; ++a)
#pragma unroll
            for (int b = 0; b < 2; ++b)
#pragma unroll
                for (int m = 0; m < 4; ++m)
#pragma unroll
                    for (int n = 0; n < 2; ++n) acc[a][b][m][n] = (f32x4){zacc_, zacc_, zacc_, zacc_};
        cur = nxt; cA = nA; cB = nB; ++ui;
        if constexpr (GATHER) { cv[0][0] = sv[0][0]; cv[0][1] = sv[0][1]; cv[1][0] = sv[1][0]; cv[1][1] = sv[1][1]; }
        if constexpr (ALIGN_EPI) { if (wr == 1) PG8_BAR; }
    }
    PG8_WAIT_V(0);
    if constexpr (!ALIGN_EPI) { if (wr == 0) PG8_BAR; }
    PG8_BAR;
    if constexpr (Epi::AFTER_DRAIN) { E.fused(acc, cur, wr, wc, fr, fq, lds, wid, lane); S.done(cur); }
#undef PG8_SA
#undef PG8_SB
#undef PG8_STAGEA
#undef PG8_STAGE
#undef PG8_LDA
#undef PG8_LDB
#undef PG8_MMA
#undef PG8_CAT
#undef PG8_WAIT_V
#undef PG8_WAIT_L
#undef PG8_BAR
#undef PG8_SCHED
}
}


namespace att {
using bf16 = unsigned short;
using bf16x8 = __attribute__((ext_vector_type(8))) short;
using s16x4  = __attribute__((ext_vector_type(4))) short;
using f32x16 = __attribute__((ext_vector_type(16))) float;
using u32x4  = __attribute__((ext_vector_type(4))) unsigned;
constexpr int KVBLK = 64;
constexpr float THR = 8.f;
constexpr int SHM_K = KVBLK * 64 * 2;
#define ATT_KSWZ(row, colB) ((row) * 128 + ((colB) ^ ((((row) >> 1) & 7) << 4)))
#define ATT_SBAR() __builtin_amdgcn_sched_barrier(0)
__device__ __forceinline__ int crow(int r, int hi) { return (r & 3) + 8 * (r >> 2) + 4 * hi; }
__device__ __forceinline__ unsigned cvtpk(float lo, float hi) { unsigned r; asm volatile("v_cvt_pk_bf16_f32 %0, %1, %2" : "=v"(r) : "v"(lo), "v"(hi)); return r; }

__device__ __forceinline__ void partialSM(f32x16& p0, f32x16& p1, float& m_reg, float& mn, float& alpha) {
  float pmax = p0[0];
#pragma unroll
  for (int r = 1; r < 16; ++r) pmax = fmaxf(pmax, p0[r]);
#pragma unroll
  for (int r = 0; r < 16; ++r) pmax = fmaxf(pmax, p1[r]);
  { auto rr = __builtin_amdgcn_permlane32_swap(__float_as_uint(pmax), __float_as_uint(pmax), false, false);
    pmax = fmaxf(__uint_as_float(rr[0]), __uint_as_float(rr[1])); }
  if (__builtin_expect(__all(pmax - m_reg <= THR), 1)) { mn = m_reg; alpha = 1.f; }
  else { mn = fmaxf(m_reg, pmax); alpha = __builtin_amdgcn_exp2f(m_reg - mn); m_reg = mn; }
#pragma unroll
  for (int r = 0; r < 16; ++r) p0[r] = p0[r] - mn;
#pragma unroll
  for (int r = 0; r < 16; ++r) p1[r] = p1[r] - mn;
#pragma unroll
  for (int r = 0; r < 16; ++r) p0[r] = __builtin_amdgcn_exp2f(p0[r]);
}
__device__ __forceinline__ void finishSM(f32x16& p0, f32x16& p1, float alpha, float& l_reg, bf16x8& pa0, bf16x8& pa1, bf16x8& pa2, bf16x8& pa3) {
#pragma unroll
  for (int r = 0; r < 16; ++r) p1[r] = __builtin_amdgcn_exp2f(p1[r]);
  typedef float f32x2 __attribute__((ext_vector_type(2)));
  f32x2 s2 = (f32x2){p0[0], p0[1]} + (f32x2){p1[0], p1[1]};
#pragma unroll
  for (int r = 2; r < 16; r += 2) s2 += (f32x2){p0[r], p0[r + 1]} + (f32x2){p1[r], p1[r + 1]};
  float ps = s2.x + s2.y;
  { auto rr = __builtin_amdgcn_permlane32_swap(__float_as_uint(ps), __float_as_uint(ps), false, false);
    ps = __uint_as_float(rr[0]) + __uint_as_float(rr[1]); }
  l_reg = l_reg * alpha + ps;
#define ATT_PK4(P, BASE, OUT) do { unsigned a0 = cvtpk(P[BASE + 0], P[BASE + 1]), a1 = cvtpk(P[BASE + 2], P[BASE + 3]);   \
    unsigned b0 = cvtpk(P[BASE + 4], P[BASE + 5]), b1 = cvtpk(P[BASE + 6], P[BASE + 7]);                              \
    auto r0 = __builtin_amdgcn_permlane32_swap(a0, b0, false, false); auto r1 = __builtin_amdgcn_permlane32_swap(a1, b1, false, false); \
    u32x4 w = {r0[0], r1[0], r0[1], r1[1]}; OUT = *reinterpret_cast<bf16x8*>(&w); } while (0)
  ATT_PK4(p0, 0, pa0); ATT_PK4(p0, 8, pa1); ATT_PK4(p1, 0, pa2); ATT_PK4(p1, 8, pa3);
#undef ATT_PK4
}
__device__ __forceinline__ void qkt(f32x16& p0, f32x16& p1, const char* Ks, const bf16x8* qr, int r32, int hi) {
  p0 = f32x16{}; p1 = f32x16{};
#pragma unroll
  for (int d0 = 0; d0 < 4; ++d0) { const int cb = (d0 * 16 + hi * 8) * 2;
    bf16x8 b0 = *reinterpret_cast<const bf16x8*>(Ks + ATT_KSWZ(r32, cb));
    bf16x8 b1 = *reinterpret_cast<const bf16x8*>(Ks + ATT_KSWZ(32 + r32, cb));
    p0 = __builtin_amdgcn_mfma_f32_32x32x16_bf16(b0, qr[d0], p0, 0, 0, 0);
    p1 = __builtin_amdgcn_mfma_f32_32x32x16_bf16(b1, qr[d0], p1, 0, 0, 0); }
}
__device__ __forceinline__ void qkt_fold(f32x16& p0, f32x16& p1, const char* Ks, const bf16x8* qr, const f32x16& negm, int r32, int hi) {
  { const bf16x8 b0 = *reinterpret_cast<const bf16x8*>(Ks + ATT_KSWZ(r32, hi * 16)), b1 = *reinterpret_cast<const bf16x8*>(Ks + ATT_KSWZ(32 + r32, hi * 16));
    p0 = __builtin_amdgcn_mfma_f32_32x32x16_bf16(b0, qr[0], negm, 0, 0, 0); p1 = __builtin_amdgcn_mfma_f32_32x32x16_bf16(b1, qr[0], negm, 0, 0, 0); }
#pragma unroll
  for (int d0 = 1; d0 < 4; ++d0) { const int cb = (d0 * 16 + hi * 8) * 2;
    bf16x8 b0 = *reinterpret_cast<const bf16x8*>(Ks + ATT_KSWZ(r32, cb));
    bf16x8 b1 = *reinterpret_cast<const bf16x8*>(Ks + ATT_KSWZ(32 + r32, cb));
    p0 = __builtin_amdgcn_mfma_f32_32x32x16_bf16(b0, qr[d0], p0, 0, 0, 0);
    p1 = __builtin_amdgcn_mfma_f32_32x32x16_bf16(b1, qr[d0], p1, 0, 0, 0); }
}
__device__ __forceinline__ float rowmax32(const f32x16& p0, const f32x16& p1) {
  float pmax = p0[0];
#pragma unroll
  for (int r = 1; r < 16; ++r) pmax = fmaxf(pmax, p0[r]);
#pragma unroll
  for (int r = 0; r < 16; ++r) pmax = fmaxf(pmax, p1[r]);
  auto rr = __builtin_amdgcn_permlane32_swap(__float_as_uint(pmax), __float_as_uint(pmax), false, false);
  return fmaxf(__uint_as_float(rr[0]), __uint_as_float(rr[1]));
}
__device__ __forceinline__ void partialSM_first(f32x16& p0, f32x16& p1, float& m_reg, float& alpha, f32x16& negm) {
  const float pmax = rowmax32(p0, p1); m_reg = pmax; alpha = 1.f;
#pragma unroll
  for (int r = 0; r < 16; ++r) { p0[r] -= pmax; p1[r] -= pmax; negm[r] = -pmax; }
#pragma unroll
  for (int r = 0; r < 16; ++r) p0[r] = __builtin_amdgcn_exp2f(p0[r]);
}
__device__ __forceinline__ void partialSM_fold(f32x16& p0, f32x16& p1, float& m_reg, float& alpha, f32x16& negm) {
  const float pmax = rowmax32(p0, p1);
  if (__builtin_expect(__all(pmax <= THR), 1)) alpha = 1.f;
  else { const float delta = fmaxf(pmax, 0.f); m_reg += delta; alpha = __builtin_amdgcn_exp2f(-delta); const float nm = -m_reg;
#pragma unroll
    for (int r = 0; r < 16; ++r) { p0[r] -= delta; p1[r] -= delta; negm[r] = nm; } }
#pragma unroll
  for (int r = 0; r < 16; ++r) p0[r] = __builtin_amdgcn_exp2f(p0[r]);
}
__device__ __forceinline__ void wmask(f32x16& p0, f32x16& p1, int dq  , int hi) {
  const float ninf = -__builtin_inff();
#pragma unroll
  for (int r = 0; r < 16; ++r) { const unsigned d = (unsigned)(dq + crow(r, hi)); p0[r] = d <= 256u ? p0[r] : ninf; const unsigned d1 = d + 32u; p1[r] = d1 <= 256u ? p1[r] : ninf; }
}
template <int NCB> __device__ __forceinline__ int v_st(int k, int c) { const int kk = (k & ~0xC) | ((k & 4) << 1) | ((k & 8) >> 1); return ((kk >> 3) * NCB + (c >> 5)) * 512 + ((kk & 7) * 32 + (c & 31)) * 2; }
__device__ __forceinline__ int v_rd_base(int lane) { return ((lane & 3) << 3) | (((lane >> 2) & 3) << 6) | (((lane >> 4) & 1) << 5) | (((lane >> 5) & 1) << 8); }
template <int OFF> __device__ __forceinline__ s16x4 tr_read(int vb) {
  s16x4 r; asm volatile("ds_read_b64_tr_b16 %0, %1 offset:%2" : "=&v"(r) : "v"(vb), "i"(OFF) : "memory"); return r;
}
template <int NCB, int D0> __device__ __forceinline__ void pv_one(f32x16& od, int vb, bf16x8 pa0, bf16x8 pa1, bf16x8 pa2, bf16x8 pa3) {
#define ATT_VOFF(ks, half) (D0 * 512 + (ks) * (NCB * 1024) + (half) * (NCB * 512))
  const s16x4 l0 = tr_read<ATT_VOFF(0, 0)>(vb), h0 = tr_read<ATT_VOFF(0, 1)>(vb), l1 = tr_read<ATT_VOFF(1, 0)>(vb), h1 = tr_read<ATT_VOFF(1, 1)>(vb);
  const s16x4 l2 = tr_read<ATT_VOFF(2, 0)>(vb), h2 = tr_read<ATT_VOFF(2, 1)>(vb), l3 = tr_read<ATT_VOFF(3, 0)>(vb), h3 = tr_read<ATT_VOFF(3, 1)>(vb);
#undef ATT_VOFF
  asm volatile("s_waitcnt lgkmcnt(0)" ::: "memory"); ATT_SBAR();
#define ATT_PK(L, H) (bf16x8){L[0], L[1], L[2], L[3], H[0], H[1], H[2], H[3]}
  od = __builtin_amdgcn_mfma_f32_32x32x16_bf16(pa0, ATT_PK(l0, h0), od, 0, 0, 0);
  od = __builtin_amdgcn_mfma_f32_32x32x16_bf16(pa1, ATT_PK(l1, h1), od, 0, 0, 0);
  od = __builtin_amdgcn_mfma_f32_32x32x16_bf16(pa2, ATT_PK(l2, h2), od, 0, 0, 0);
  od = __builtin_amdgcn_mfma_f32_32x32x16_bf16(pa3, ATT_PK(l3, h3), od, 0, 0, 0);
#undef ATT_PK
}
template <int NCB> __device__ __forceinline__ void pv_all(f32x16* o, int vb, bf16x8 pa0, bf16x8 pa1, bf16x8 pa2, bf16x8 pa3) {
  pv_one<NCB, 0>(o[0], vb, pa0, pa1, pa2, pa3); pv_one<NCB, 1>(o[1], vb, pa0, pa1, pa2, pa3);
  if constexpr (NCB == 4) { pv_one<NCB, 2>(o[2], vb, pa0, pa1, pa2, pa3); pv_one<NCB, 3>(o[3], vb, pa0, pa1, pa2, pa3); }
}

template <int NCB> constexpr int attn_lds_bytes() { return 3 * (KVBLK * 32 * NCB * 2) + 3 * SHM_K + 2048; }
template <int NCB, bool WINDOW>
__device__ __forceinline__ void attn_core(f32x16 (&o)[NCB], const bf16* __restrict__ Qb, const bf16* __restrict__ Kh, const bf16* __restrict__ Vh, int ld, int ntiles,
                                          int qpos0, int kpos0, float sink_l2, char* lds, int wv) {
  constexpr bool FOLD = (NCB == 2) && !WINDOW;
  constexpr int SHM_V = KVBLK * 32 * NCB * 2;
  const int tid = fresh_tid(wv), wid = tid >> 6, lane = tid & 63, r32 = lane & 31, hi = lane >> 5;
  char* V_lds = lds; char* K_lds = lds + 3 * SHM_V;
  float* wsf = (float*)(lds + 3 * SHM_V + 3 * SHM_K) + wid * 64; float* li_l = wsf; float* al_l = wsf + 32;
  float m_reg = -1e30f, l_reg = 0; asm volatile("" : "+v"(m_reg));
#pragma unroll
  for (int d = 0; d < NCB; ++d) o[d] = f32x16{};
  bf16x8 qr[4];
  const bf16* Qw = Qb + (long)(wid * 32 + r32) * ld + hi * 8;
#pragma unroll
  for (int d0 = 0; d0 < 4; ++d0) qr[d0] = *reinterpret_cast<const bf16x8*>(Qw + d0 * 16);
  const int dq0 = kpos0 - (qpos0 + wid * 32 + r32) + 128;
  const int ksr = tid >> 3, ksc = (tid & 7) * 8, kst = ATT_KSWZ(ksr, ksc * 2);
  constexpr int VCPR = 4 * NCB;
  const int vsr = tid / VCPR, vsc = (tid % VCPR) * 8, vst0 = v_st<NCB>(vsr, vsc), vst1 = v_st<NCB>(vsr + 32, vsc);
  const int vb0 = (int)(uintptr_t)V_lds + v_rd_base(lane);
  struct { bf16x8 ks, vs0, vs1; } sr_[2];
#define ATT_SLOAD(i, t) do { const long k0_ = (long)(t) * KVBLK; sr_[i].ks = *reinterpret_cast<const bf16x8*>(Kh + (k0_ + ksr) * ld + ksc); \
    sr_[i].vs0 = *reinterpret_cast<const bf16x8*>(Vh + (k0_ + vsr) * ld + vsc); \
    if constexpr (NCB == 4) sr_[i].vs1 = *reinterpret_cast<const bf16x8*>(Vh + (k0_ + vsr + 32) * ld + vsc); } while (0)
#define ATT_SWRITE(b, i) do { *(bf16x8*)(K_lds + (b) * SHM_K + kst) = sr_[i].ks; *(bf16x8*)(V_lds + (b) * SHM_V + vst0) = sr_[i].vs0; \
    if constexpr (NCB == 4) *(bf16x8*)(V_lds + (b) * SHM_V + vst1) = sr_[i].vs1; } while (0)
#define ATT_RESC(a) do { if (__any((a) < 1.f)) { if (hi == 0) al_l[r32] = (a); asm volatile("s_waitcnt lgkmcnt(0)" ::: "memory"); \
    _Pragma("unroll") for (int r = 0; r < 16; ++r) { const float al_ = al_l[crow(r, hi)]; _Pragma("unroll") for (int d = 0; d < NCB; ++d) o[d][r] *= al_; } } } while (0)
#define ATT_MASK(P0, P1, t) do { if constexpr (WINDOW) wmask(P0, P1, dq0 + (t) * KVBLK, hi); } while (0)
#define ATT_STEP(J, X0, X1, ALX, Y0, Y1, ALY, SLOT) do { const int j_ = (J); const int bn_ = bc == 2 ? 0 : bc + 1, bp_ = bc == 0 ? 2 : bc - 1; \
    __syncthreads(); \
    if (j_ + 1 < NT) ATT_SWRITE(bn_, SLOT); \
    if (j_ + 3 < NT) ATT_SLOAD(SLOT, j_ + 3); \
    ATT_SBAR(); \
    if constexpr (FOLD) qkt_fold(X0, X1, K_lds + bc * SHM_K, qr, negm, r32, hi); else { qkt(X0, X1, K_lds + bc * SHM_K, qr, r32, hi); ATT_MASK(X0, X1, j_); } \
    finishSM(Y0, Y1, ALY, l_reg, pa0, pa1, pa2, pa3); ATT_SBAR(); \
    pv_all<NCB>(o, vb0 + bp_ * SHM_V, pa0, pa1, pa2, pa3); \
    if constexpr (FOLD) partialSM_fold(X0, X1, m_reg, ALX, negm); else { float mn_; partialSM(X0, X1, m_reg, mn_, ALX); } \
    ATT_RESC(ALX); bc = bn_; } while (0)
  f32x16 pA0, pA1, pB0, pB1; float alA, alB; bf16x8 pa0, pa1, pa2, pa3; const int NT = ntiles;
  f32x16 negm = f32x16{};
  ATT_SLOAD(0, 0); asm volatile("s_waitcnt vmcnt(0)" ::: "memory"); ATT_SWRITE(0, 0);
  ATT_SLOAD(1, 1); if (2 < NT) ATT_SLOAD(0, 2);
  int bc = 0;
  __syncthreads();
  ATT_SWRITE(1, 1); if (3 < NT) ATT_SLOAD(1, 3);
  ATT_SBAR();
  if constexpr (FOLD) { qkt_fold(pA0, pA1, K_lds, qr, negm, r32, hi); partialSM_first(pA0, pA1, m_reg, alA, negm); }
  else { qkt(pA0, pA1, K_lds, qr, r32, hi); ATT_MASK(pA0, pA1, 0); float mn_; partialSM(pA0, pA1, m_reg, mn_, alA); }
  bc = 1;
  for (int j = 1; j + 1 < NT; j += 2) {
    ATT_STEP(j, pB0, pB1, alB, pA0, pA1, alA, 0);
    ATT_STEP(j + 1, pA0, pA1, alA, pB0, pB1, alB, 1);
  }
  ATT_STEP(NT - 1, pB0, pB1, alB, pA0, pA1, alA, 0);
  finishSM(pB0, pB1, alB, l_reg, pa0, pa1, pa2, pa3); ATT_SBAR();
  { const int bp_ = bc == 0 ? 2 : bc - 1; pv_all<NCB>(o, vb0 + bp_ * SHM_V, pa0, pa1, pa2, pa3); }
  l_reg += __builtin_amdgcn_exp2f(sink_l2 - m_reg);
  if (hi == 0) li_l[r32] = l_reg; asm volatile("s_waitcnt lgkmcnt(0)" ::: "memory");
#pragma unroll
  for (int r = 0; r < 16; ++r) { const float rl = __builtin_amdgcn_rcpf(li_l[crow(r, hi)]);
#pragma unroll
    for (int d = 0; d < NCB; ++d) o[d][r] *= rl; }
#undef ATT_SLOAD
#undef ATT_SWRITE
#undef ATT_RESC
#undef ATT_MASK
#undef ATT_STEP
}
template <int NCB> __device__ __forceinline__ void store_o(const f32x16 (&o)[NCB], bf16* Ob, int ld, int lane) {
  const int r32 = lane & 31, hi = lane >> 5, odd = lane & 1;
#pragma unroll
  for (int d = 0; d < NCB; ++d)
#pragma unroll
    for (int r = 0; r < 16; r += 2) {
      const float send = odd ? o[d][r] : o[d][r + 1];
      const float recv = dpp_xor1(send);
      const unsigned pk = cvtpk(odd ? recv : o[d][r], odd ? o[d][r + 1] : recv);
      const int row = crow(r + odd, hi);
      *(unsigned*)(Ob + (long)row * ld + d * 32 + (r32 & ~1)) = pk;
    }
}
template <int NCB> __device__ __forceinline__ void stage_o(const f32x16 (&o)[NCB], __attribute__((address_space(3))) unsigned char* stg, int ldb, int lane) {
  const int r32 = lane & 31, hi = lane >> 5, odd = lane & 1;
#pragma unroll
  for (int d = 0; d < NCB; ++d)
#pragma unroll
    for (int r = 0; r < 16; r += 2) {
      const float send = odd ? o[d][r] : o[d][r + 1];
      const float recv = dpp_xor1(send);
      const unsigned pk = cvtpk(odd ? recv : o[d][r], odd ? o[d][r + 1] : recv);
      const int row = crow(r + odd, hi);
      *(__attribute__((address_space(3))) unsigned*)(stg + row * ldb + (d * 32 + (r32 & ~1)) * 2) = pk;
    }
}
}


namespace ab2 {
using bf16=__hip_bfloat16;
using bf16x8=__attribute__((ext_vector_type(8)))short;
using s16x4=__attribute__((ext_vector_type(4)))short;
using f32x16=__attribute__((ext_vector_type(16)))float;
using u32x4=__attribute__((ext_vector_type(4)))unsigned;
constexpr int D=64;
constexpr int NW=8,QBLK=32,QB=QBLK*NW,KVBLK=64;
__device__ __forceinline__ int crow(int r,int hi){return (r&3)+8*(r>>2)+4*hi;}
#define SBAR() __builtin_amdgcn_sched_barrier(0)
__device__ __forceinline__ void wmask2(f32x16&p0,f32x16&p1,int dq,int hi){
  const float NEG=-__builtin_inff();
  #pragma unroll
  for(int r=0;r<16;++r){const unsigned d=(unsigned)(dq+crow(r,hi)); if(d>256u)p0[r]=NEG; if(d+32u>256u)p1[r]=NEG;}
}

constexpr int NSLOT=3, SLOTB=8192;
constexpr int LDS_K=0, LDS_V=NSLOT*SLOTB, LDS_WS=2*NSLOT*SLOTB, LDS_OST=LDS_WS+NW*64*4, LDS_BYTES=LDS_OST+NW*4096;
constexpr float C2=0.125f*1.4426950408889634f;
__device__ __forceinline__ void glds16(const void*gsrc,unsigned lds_dst){unsigned keep;
  asm volatile("s_mov_b32 %0, m0\n\ts_mov_b32 m0, %2\n\ts_nop 0\n\tglobal_load_lds_dwordx4 %1, off\n\ts_mov_b32 m0, %0":"=&s"(keep):"v"(gsrc),"s"(lds_dst):"memory");}
__device__ __forceinline__ float max3f(float a,float b,float c){float r;asm("v_max3_f32 %0, %1, %2, %3":"=v"(r):"v"(a),"v"(b),"v"(c));return r;}
__device__ __forceinline__ float max2f(float a,float b){float r;asm("v_max_f32_e32 %0, %1, %2":"=v"(r):"v"(a),"v"(b));return r;}
__device__ __forceinline__ float fadd_s(float a,float b){float r;asm("v_add_f32_e32 %0, %1, %2":"=v"(r):"v"(a),"v"(b));return r;}
__device__ __forceinline__ float fsub_s(float a,float b){float r;asm("v_sub_f32_e32 %0, %1, %2":"=v"(r):"v"(a),"v"(b));return r;}
typedef float f32x2_t __attribute__((ext_vector_type(2))); typedef __bf16 bf16x2_t __attribute__((ext_vector_type(2)));
__device__ __forceinline__ unsigned cvtpk_s(float lo,float hi){f32x2_t v={lo,hi};bf16x2_t b=__builtin_convertvector(v,bf16x2_t);return __builtin_bit_cast(unsigned,b);}
#define WAIT_BAR(N) asm volatile("s_waitcnt vmcnt(" #N ") lgkmcnt(0)\n\ts_barrier":::"memory")

__device__ __forceinline__ void qkt(f32x16&p0,f32x16&p1,const char*Kslot,const bf16x8*qr,const f32x16&negm,int r32,int hi){
  const char*kb=Kslot+hi*1024+r32*16;
  #pragma unroll
  for(int d0=0;d0<4;++d0){
    const bf16x8 b0=*reinterpret_cast<const bf16x8*>(kb+d0*2048);
    const bf16x8 b1=*reinterpret_cast<const bf16x8*>(kb+d0*2048+512);
    if(d0==0){p0=__builtin_amdgcn_mfma_f32_32x32x16_bf16(b0,qr[0],negm,0,0,0);p1=__builtin_amdgcn_mfma_f32_32x32x16_bf16(b1,qr[0],negm,0,0,0);}
    else{p0=__builtin_amdgcn_mfma_f32_32x32x16_bf16(b0,qr[d0],p0,0,0,0);p1=__builtin_amdgcn_mfma_f32_32x32x16_bf16(b1,qr[d0],p1,0,0,0);}}
}
typedef __attribute__((address_space(3))) const char* lds_cptr;
typedef short v4i16_t __attribute__((ext_vector_type(4)));
__device__ __forceinline__ void kload8(bf16x8*kf,lds_cptr kp){
  kf[0]=*(const __attribute__((address_space(3))) bf16x8*)(kp);      kf[1]=*(const __attribute__((address_space(3))) bf16x8*)(kp+512);
  kf[2]=*(const __attribute__((address_space(3))) bf16x8*)(kp+2048); kf[3]=*(const __attribute__((address_space(3))) bf16x8*)(kp+2560);
  kf[4]=*(const __attribute__((address_space(3))) bf16x8*)(kp+4096); kf[5]=*(const __attribute__((address_space(3))) bf16x8*)(kp+4608);
  kf[6]=*(const __attribute__((address_space(3))) bf16x8*)(kp+6144); kf[7]=*(const __attribute__((address_space(3))) bf16x8*)(kp+6656);
}
__device__ __forceinline__ void kload2(bf16x8*kf,lds_cptr kp,int j){ kf[2*j]=*(const __attribute__((address_space(3))) bf16x8*)(kp+j*2048); kf[2*j+1]=*(const __attribute__((address_space(3))) bf16x8*)(kp+j*2048+512); }
__device__ __forceinline__ s16x4 vtr(lds_cptr p){ return __builtin_bit_cast(s16x4,__builtin_amdgcn_ds_read_tr16_b64_v4i16((__attribute__((address_space(3))) v4i16_t*)p)); }
__device__ __forceinline__ float rowmax(const f32x16&p0,const f32x16&p1){
  float a=max3f(p0[0],p0[1],p1[0]),b=max3f(p0[2],p0[3],p1[1]);a=max3f(a,p1[2],p1[3]);
  #pragma unroll
  for(int r=4;r<16;r+=4){a=max3f(a,p0[r],p0[r+1]);b=max3f(b,p0[r+2],p0[r+3]);a=max3f(a,p1[r],p1[r+1]);b=max3f(b,p1[r+2],p1[r+3]);}
  const float m=max2f(a,b);
  auto rr=__builtin_amdgcn_permlane32_swap(__float_as_uint(m),__float_as_uint(m),false,false);
  return max2f(__uint_as_float(rr[0]),__uint_as_float(rr[1]));
}
__device__ __forceinline__ void pv(f32x16*o,int vb,bf16x8 pa0,bf16x8 pa1,bf16x8 pa2,bf16x8 pa3){
  #pragma unroll
  for(int d0=0;d0<2;++d0){s16x4 lo[4],hi[4];
    #pragma unroll
    for(int ks=0;ks<4;++ks){
      asm volatile("ds_read_b64_tr_b16 %0,%1 offset:%c2":"=&v"(lo[ks]):"v"(vb),"i"(d0*4096+ks*1024):"memory");
      asm volatile("ds_read_b64_tr_b16 %0,%1 offset:%c2":"=&v"(hi[ks]):"v"(vb),"i"(d0*4096+ks*1024+512):"memory");}
    asm volatile("s_waitcnt lgkmcnt(0)":::"memory");SBAR();
    #define PK(k) (bf16x8){lo[k][0],lo[k][1],lo[k][2],lo[k][3],hi[k][0],hi[k][1],hi[k][2],hi[k][3]}
    o[d0]=__builtin_amdgcn_mfma_f32_32x32x16_bf16(pa0,PK(0),o[d0],0,0,0);
    o[d0]=__builtin_amdgcn_mfma_f32_32x32x16_bf16(pa1,PK(1),o[d0],0,0,0);
    o[d0]=__builtin_amdgcn_mfma_f32_32x32x16_bf16(pa2,PK(2),o[d0],0,0,0);
    o[d0]=__builtin_amdgcn_mfma_f32_32x32x16_bf16(pa3,PK(3),o[d0],0,0,0);
    #undef PK
  }
}

#ifndef ATTN_STORE16
#define ATTN_STORE16(p,v) (*(u32x4*)(p)=(v))
#endif
template<int THRL,int LDQ,int LDO,bool WINDOW> __device__ __forceinline__ void attn_unit(const bf16*Qb,const bf16*__restrict__ Kh,const bf16*__restrict__ Vh,bf16*Ob,int ntiles,int qpos0,int kpos0,float sink_l2,char*shm,int wv){
  const int tid=fresh_tid(wv),lane=tid&63,r32=lane&31,hi=lane>>5; const int wid=__builtin_amdgcn_readfirstlane(tid>>6);
  const bf16*Qw=Qb+(long)(wid*QBLK)*LDQ;
  const unsigned lds0=(unsigned)(uintptr_t)shm;
  float*wsf=(float*)(shm+LDS_WS)+wid*64;
  const bf16*ksrc=Kh+(long)lane*LDQ+wid*8;
  const bf16*vsrc=Vh+(long)(16*(wid&3)+(lane>>2))*LDQ+(wid>>2)*32+(lane&3)*8;
  const unsigned kdst=lds0+LDS_K+wid*1024, vdst=lds0+LDS_V+wid*1024;
  #define DMA_K(t,slot) glds16(ksrc+(long)(t)*KVBLK*LDQ,(unsigned)__builtin_amdgcn_readfirstlane(kdst+(slot)))
  #define DMA_V(t,slot) glds16(vsrc+(long)(t)*KVBLK*LDQ,(unsigned)__builtin_amdgcn_readfirstlane(vdst+(slot)))
  const int vb0=(int)(lds0+LDS_V)+((lane>>4)&1)*32+(lane&3)*8+(4*hi+((lane&15)>>2))*64;
  const char*Kbase=shm+LDS_K; bf16x8 kf[8];
  const lds_cptr shm3=(lds_cptr)shm; const lds_cptr kp0=shm3+LDS_K+hi*1024+r32*16; const lds_cptr vp0=shm3+LDS_V+((lane>>4)&1)*32+(lane&3)*8+(4*hi+((lane&15)>>2))*64;
  const int NT=ntiles;
  DMA_K(0,0);DMA_V(0,0);DMA_K(1,SLOTB);
  bf16x8 qr[4];
  #pragma unroll
  for(int d0=0;d0<4;++d0)qr[d0]=*reinterpret_cast<const bf16x8*>(&Qw[(long)r32*LDQ+d0*16+hi*8]);
  float mhat=0.f,l_reg=0.f;f32x16 o[2];o[0]=f32x16{};o[1]=f32x16{};f32x16 negm=f32x16{};asm volatile("":"+v"(negm));
  const int dq0=kpos0-(qpos0+wid*QBLK+r32)+128;
  #define CMASK(P0,P1,t) do{ if constexpr(WINDOW) wmask2(P0,P1,dq0+(t)*KVBLK,hi); }while(0)
  bool resc=false;
  #define START(P0,P1) do{ const float rm=rowmax(P0,P1); resc=false; \
    { const float dl=__builtin_fmaxf(rm,0.f); mhat=fadd_s(mhat,dl); \
      _Pragma("unroll") for(int r=0;r<16;++r){P0[r]=fsub_s(P0[r],dl);P1[r]=fsub_s(P1[r],dl);} \
      _Pragma("unroll") for(int r=0;r<16;++r)negm[r]=-mhat; asm volatile("":"+v"(negm)); } \
    _Pragma("unroll") for(int r=0;r<16;++r)P0[r]=__builtin_amdgcn_exp2f(P0[r]); }while(0)
  #define RESC() do{ if(resc){ asm volatile("s_waitcnt lgkmcnt(0)":::"memory"); \
      _Pragma("unroll") for(int d_=0;d_<2;++d_) _Pragma("unroll") for(int r=0;r<16;++r)o[d_][r]*=wsf[crow(r,hi)]; } }while(0)
  f32x16 pA0,pA1,pB0,pB1;
  int sl_prev=0,sl_cur=0,sl_next=SLOTB;
  #define ROT() do{sl_prev=sl_cur;sl_cur=sl_next;sl_next=(sl_next==(NSLOT-1)*SLOTB)?0:sl_next+SLOTB;}while(0)
  DMA_K(2,2*SLOTB);
  WAIT_BAR(3);
  qkt(pA0,pA1,Kbase,qr,negm,r32,hi);asm volatile("s_nop 15\n\ts_nop 7":"+v"(pA0),"+v"(pA1));CMASK(pA0,pA1,0);
  START(pA0,pA1);
  _Pragma("unroll") for(int r=0;r<16;++r)pA1[r]=__builtin_amdgcn_exp2f(pA1[r]);
  WAIT_BAR(0);
  DMA_K(3,0);DMA_V(1,SLOTB);
  ROT();
  kload8(kf,kp0+sl_cur);
  WAIT_BAR(2);
  s16x4 vlo[8],vhi[8]; u32x4 pw0,pw1,pw2,pw3;
  #define PKW(P,B) cvtpk_s(P[B],P[B+1])
  #define PAF(k) __builtin_bit_cast(bf16x8,pw##k)
  #define VFR(i) (bf16x8){vlo[i][0],vlo[i][1],vlo[i][2],vlo[i][3],vhi[i][0],vhi[i][1],vhi[i][2],vhi[i][3]}
  #define PIN(x) asm volatile("":"+v"(x))
  #define MX3(a,b,c) __builtin_fmaxf(__builtin_fmaxf((a),(b)),(c))
  #define GAPA(MF,A0,A1,A2,A3,W0,W1,PW) do{ MF; sacc+=A0; sacc+=A1; sacc+=A2; sacc+=A3; PIN(sacc); W0; W1; PIN(PW); SBAR(); }while(0)
  #define EX(v) __builtin_amdgcn_exp2f(v)
  #define GAPB(MF,X,B) do{ MF; X[B]=EX(X[B]); X[B+1]=EX(X[B+1]); X[B+2]=EX(X[B+2]); X[B+3]=EX(X[B+3]); PIN(X); SBAR(); }while(0)
  #define VRD(i) do{ vlo[i]=vtr(vp_+(((i)>>2)*4096+((i)&3)*1024)); vhi[i]=vtr(vp_+(((i)>>2)*4096+((i)&3)*1024+512)); }while(0)
  #define KRD(G,j) do{ if(G){ kload2(kf,kp0+sl_next,j); SBAR(); } }while(0)
  #define STEP(C0,C1,P0,P1,t,GK,GV,GL) do{ SBAR(); \
    const lds_cptr vp_=vp0+sl_prev; \
    VRD(0); SBAR(); float sacc=(P0[0]+P0[1]); \
    GAPA(C0=__builtin_amdgcn_mfma_f32_32x32x16_bf16(kf[0],qr[0],negm,0,0,0), P0[2],P0[3],P0[4],P0[5],     pw0[0]=PKW(P0,0), pw0[1]=PKW(P0,2), pw0); \
    VRD(4); SBAR(); GAPA(C1=__builtin_amdgcn_mfma_f32_32x32x16_bf16(kf[1],qr[0],negm,0,0,0), P0[6],P0[7],P0[8],P0[9],     pw0[2]=PKW(P0,4), pw0[3]=PKW(P0,6), pw0); \
    VRD(1); SBAR(); GAPA(C0=__builtin_amdgcn_mfma_f32_32x32x16_bf16(kf[2],qr[1],C0,0,0,0),   P0[10],P0[11],P0[12],P0[13], pw1[0]=PKW(P0,8), pw1[1]=PKW(P0,10), pw1); \
    VRD(5); SBAR(); GAPA(C1=__builtin_amdgcn_mfma_f32_32x32x16_bf16(kf[3],qr[1],C1,0,0,0),   P0[14],P0[15],P1[0],P1[1],   pw1[2]=PKW(P0,12),pw1[3]=PKW(P0,14), pw1); \
    VRD(2); SBAR(); GAPA(C0=__builtin_amdgcn_mfma_f32_32x32x16_bf16(kf[4],qr[2],C0,0,0,0),   P1[2],P1[3],P1[4],P1[5],     pw2[0]=PKW(P1,0), pw2[1]=PKW(P1,2), pw2); \
    VRD(6); SBAR(); GAPA(C1=__builtin_amdgcn_mfma_f32_32x32x16_bf16(kf[5],qr[2],C1,0,0,0),   P1[6],P1[7],P1[8],P1[9],     pw2[2]=PKW(P1,4), pw2[3]=PKW(P1,6), pw2); \
    VRD(3); SBAR(); GAPA(C0=__builtin_amdgcn_mfma_f32_32x32x16_bf16(kf[6],qr[3],C0,0,0,0),   P1[10],P1[11],P1[12],P1[13], pw3[0]=PKW(P1,8), pw3[1]=PKW(P1,10), pw3); \
    VRD(7); SBAR(); GAPA(C1=__builtin_amdgcn_mfma_f32_32x32x16_bf16(kf[7],qr[3],C1,0,0,0),   P1[14],P1[15],0.f,0.f,       pw3[2]=PKW(P1,12),pw3[3]=PKW(P1,14), pw3); \
    l_reg+=sacc; \
    if(GK){DMA_K((t)+3,sl_cur);} if(GV){DMA_V((t)+1,sl_next);} \
    CMASK(C0,C1,t); \
    { float a=MX3(C0[0],C0[1],C1[0]),b=MX3(C0[2],C0[3],C1[1]); a=MX3(a,C1[2],C1[3]); \
      _Pragma("unroll") for(int r=4;r<16;r+=4){a=MX3(a,C0[r],C0[r+1]);b=MX3(b,C0[r+2],C0[r+3]);a=MX3(a,C1[r],C1[r+1]);b=MX3(b,C1[r+2],C1[r+3]);} \
      float rm=__builtin_fmaxf(a,b); { auto rr=__builtin_amdgcn_permlane32_swap(__float_as_uint(rm),__float_as_uint(rm),false,false); rm=__builtin_fmaxf(__uint_as_float(rr[0]),__uint_as_float(rr[1])); } \
      resc=false; \
      if(__builtin_expect(__any(rm>(float)THRL),0)){ const float dl=__builtin_fmaxf(rm,0.f); mhat+=dl; \
        _Pragma("unroll") for(int r=0;r<16;++r){C0[r]-=dl;C1[r]-=dl;} \
        _Pragma("unroll") for(int r=0;r<16;++r)negm[r]=-mhat; asm volatile("":"+v"(negm)); \
        const float f=__builtin_amdgcn_exp2f(-dl); l_reg*=f; if(hi==0)wsf[r32]=f; resc=true; } } \
    SBAR(); \
    GAPB(o[0]=__builtin_amdgcn_mfma_f32_32x32x16_bf16(PAF(0),VFR(0),o[0],0,0,0), C0,0); \
    GAPB(o[1]=__builtin_amdgcn_mfma_f32_32x32x16_bf16(PAF(0),VFR(4),o[1],0,0,0), C0,4); \
    KRD(GL,0); GAPB(o[0]=__builtin_amdgcn_mfma_f32_32x32x16_bf16(PAF(1),VFR(1),o[0],0,0,0), C0,8); \
    KRD(GL,1); GAPB(o[1]=__builtin_amdgcn_mfma_f32_32x32x16_bf16(PAF(1),VFR(5),o[1],0,0,0), C0,12); \
    KRD(GL,2); GAPB(o[0]=__builtin_amdgcn_mfma_f32_32x32x16_bf16(PAF(2),VFR(2),o[0],0,0,0), C1,0); \
    KRD(GL,3); GAPB(o[1]=__builtin_amdgcn_mfma_f32_32x32x16_bf16(PAF(2),VFR(6),o[1],0,0,0), C1,4); \
    GAPB(o[0]=__builtin_amdgcn_mfma_f32_32x32x16_bf16(PAF(3),VFR(3),o[0],0,0,0), C1,8); \
    GAPB(o[1]=__builtin_amdgcn_mfma_f32_32x32x16_bf16(PAF(3),VFR(7),o[1],0,0,0), C1,12); \
    }while(0)
  int t=1;
  for(;t+5<NT;t+=2){
    STEP(pB0,pB1,pA0,pA1,t,true,true,true);     WAIT_BAR(2); RESC(); ROT();
    STEP(pA0,pA1,pB0,pB1,t+1,true,true,true);   WAIT_BAR(2); RESC(); ROT();
  }
  #define ENDW(tt) do{ if((tt)+3<NT){WAIT_BAR(2);} else if((tt)+2<NT){WAIT_BAR(1);} else {WAIT_BAR(0);} }while(0)
  for(;t+1<NT;t+=2){
    STEP(pB0,pB1,pA0,pA1,t,(t+3<NT),(t+1<NT),(t+1<NT));       ENDW(t);   RESC(); ROT();
    STEP(pA0,pA1,pB0,pB1,t+1,(t+4<NT),(t+2<NT),(t+2<NT));     ENDW(t+1); RESC(); ROT();
  }
  STEP(pB0,pB1,pA0,pA1,NT-1,false,false,false); RESC();
  { float sacc=pB0[0]+pB0[1]; _Pragma("unroll") for(int r=2;r<16;++r)sacc+=pB0[r]; _Pragma("unroll") for(int r=0;r<16;++r)sacc+=pB1[r]; l_reg+=sacc;
    pw0=(u32x4){PKW(pB0,0),PKW(pB0,2),PKW(pB0,4),PKW(pB0,6)};pw1=(u32x4){PKW(pB0,8),PKW(pB0,10),PKW(pB0,12),PKW(pB0,14)};pw2=(u32x4){PKW(pB1,0),PKW(pB1,2),PKW(pB1,4),PKW(pB1,6)};pw3=(u32x4){PKW(pB1,8),PKW(pB1,10),PKW(pB1,12),PKW(pB1,14)};
    SBAR(); pv(o,vb0+sl_cur,PAF(0),PAF(1),PAF(2),PAF(3)); }
  #undef PKW
  #undef PAF
  #undef VFR
  #undef PIN
  #undef MX3
  #undef GAPA
  #undef GAPB
  #undef EX
  #undef VRD
  #undef KRD
  #undef STEP
  #undef ENDW
  {auto rr=__builtin_amdgcn_permlane32_swap(__float_as_uint(l_reg),__float_as_uint(l_reg),false,false);l_reg=__uint_as_float(rr[0])+__uint_as_float(rr[1]);}
  l_reg+=__builtin_amdgcn_exp2f(sink_l2-mhat);
  if(hi==0)wsf[32+r32]=l_reg;asm volatile("s_waitcnt lgkmcnt(0)":::"memory");
  float rli[16];
  #pragma unroll
  for(int r=0;r<16;++r)rli[r]=__builtin_amdgcn_rcpf(wsf[32+crow(r,hi)]);
  bf16*Ow=Ob+(long)(wid*QBLK)*LDO;
  { bf16*stg=(bf16*)(shm+LDS_OST)+wid*2048;
    #pragma unroll
    for(int r=0;r<16;++r){const int orow=crow(r,hi);
      #pragma unroll
      for(int d0=0;d0<2;++d0)stg[orow*64+d0*32+r32]=__float2bfloat16(o[d0][r]*rli[r]);}
    asm volatile("s_waitcnt lgkmcnt(0)":::"memory");
    #pragma unroll
    for(int i=0;i<4;++i){const int row=i*8+(lane>>3),ch=lane&7; const u32x4 v=*(const u32x4*)(stg+row*64+ch*8); ATTN_STORE16(Ow+(long)row*LDO+ch*8,v);} }
  asm volatile("s_waitcnt lgkmcnt(0)\n\ts_barrier":::"memory");
  #undef DMA_K
  #undef DMA_V
  #undef CMASK
  #undef START
  #undef RESC
  #undef ROT
}

constexpr int LDS128_K=0, LDS128_V=3*SLOTB, LDS128_WS=LDS128_V+3*2*SLOTB, LDS128_BYTES=LDS128_WS+NW*64*4;
__device__ __forceinline__ void pv128(f32x16*o,int vb,bf16x8 pa0,bf16x8 pa1,bf16x8 pa2,bf16x8 pa3){
  #pragma unroll
  for(int d0=0;d0<4;++d0){s16x4 lo[4],hi[4];
    #pragma unroll
    for(int ks=0;ks<4;++ks){
      asm volatile("ds_read_b64_tr_b16 %0,%1 offset:%c2":"=&v"(lo[ks]):"v"(vb),"i"(d0*4096+ks*1024):"memory");
      asm volatile("ds_read_b64_tr_b16 %0,%1 offset:%c2":"=&v"(hi[ks]):"v"(vb),"i"(d0*4096+ks*1024+512):"memory");}
    asm volatile("s_waitcnt lgkmcnt(0)":::"memory");SBAR();
    #define PK(k) (bf16x8){lo[k][0],lo[k][1],lo[k][2],lo[k][3],hi[k][0],hi[k][1],hi[k][2],hi[k][3]}
    o[d0]=__builtin_amdgcn_mfma_f32_32x32x16_bf16(pa0,PK(0),o[d0],0,0,0);
    o[d0]=__builtin_amdgcn_mfma_f32_32x32x16_bf16(pa1,PK(1),o[d0],0,0,0);
    o[d0]=__builtin_amdgcn_mfma_f32_32x32x16_bf16(pa2,PK(2),o[d0],0,0,0);
    o[d0]=__builtin_amdgcn_mfma_f32_32x32x16_bf16(pa3,PK(3),o[d0],0,0,0);
    #undef PK
  }
}
template<int THRL,int LDQ> __device__ __forceinline__ void attn_unit128(f32x16 (&o)[4],const bf16*Qb,const bf16*__restrict__ Kh,const bf16*__restrict__ Vh,int ntiles,char*shm,int wv){
  const int tid=fresh_tid(wv),lane=tid&63,r32=lane&31,hi=lane>>5; const int wid=__builtin_amdgcn_readfirstlane(tid>>6);
  const bf16*Qw=Qb+(long)(wid*QBLK)*LDQ;
  const unsigned lds0=(unsigned)(uintptr_t)shm;
  float*wsf=(float*)(shm+LDS128_WS)+wid*64;
  const bf16*ksrc=Kh+(long)lane*LDQ+wid*8;
  const bf16*vsrc=Vh+(long)(16*(wid&3)+(lane>>2))*LDQ+(wid>>2)*32+(lane&3)*8;
  const unsigned kdst=lds0+LDS128_K+wid*1024, vdst=lds0+LDS128_V+wid*1024;
  #define DMA_K(t,slot) glds16(ksrc+(long)(t)*KVBLK*LDQ,(unsigned)__builtin_amdgcn_readfirstlane(kdst+(slot)))
  #define DMA_V(t,slot) do{ glds16(vsrc+(long)(t)*KVBLK*LDQ,(unsigned)__builtin_amdgcn_readfirstlane(vdst+2*(slot))); glds16(vsrc+(long)(t)*KVBLK*LDQ+64,(unsigned)__builtin_amdgcn_readfirstlane(vdst+2*(slot)+8192)); }while(0)
  const int vb0=(int)(lds0+LDS128_V)+((lane>>4)&1)*32+(lane&3)*8+(4*hi+((lane&15)>>2))*64;
  const char*Kbase=shm+LDS128_K; bf16x8 kfa[2],kfb[2];
  const lds_cptr shm3=(lds_cptr)shm; const lds_cptr kp0=shm3+LDS128_K+hi*1024+r32*16; const lds_cptr vp0=shm3+LDS128_V+((lane>>4)&1)*32+(lane&3)*8+(4*hi+((lane&15)>>2))*64;
  const int NT=ntiles;
  DMA_K(0,0);DMA_V(0,0);DMA_K(1,SLOTB);
  bf16x8 qr[4];
  #pragma unroll
  for(int d0=0;d0<4;++d0)qr[d0]=*reinterpret_cast<const bf16x8*>(&Qw[(long)r32*LDQ+d0*16+hi*8]);
  float mhat=0.f,l_reg=0.f;
  float z0_=0.f; asm volatile("":"+v"(z0_));
  f32x16 negm;
  #pragma unroll
  for(int r=0;r<16;++r){negm[r]=z0_;
    #pragma unroll
    for(int d_=0;d_<4;++d_)o[d_][r]=z0_;}
  asm volatile("":"+v"(negm));
  bool resc=false;
  #define START(P0,P1) do{ const float rm=rowmax(P0,P1); resc=false; \
    { const float dl=__builtin_fmaxf(rm,0.f); mhat=fadd_s(mhat,dl); \
      _Pragma("unroll") for(int r=0;r<16;++r){P0[r]=fsub_s(P0[r],dl);P1[r]=fsub_s(P1[r],dl);} \
      _Pragma("unroll") for(int r=0;r<16;++r)negm[r]=-mhat; asm volatile("":"+v"(negm)); } \
    _Pragma("unroll") for(int r=0;r<16;++r)P0[r]=__builtin_amdgcn_exp2f(P0[r]); }while(0)
  #define RESC() do{ if(resc){ asm volatile("s_waitcnt lgkmcnt(0)":::"memory"); \
      _Pragma("unroll") for(int d_=0;d_<4;++d_) _Pragma("unroll") for(int r=0;r<16;++r)o[d_][r]*=wsf[crow(r,hi)]; } }while(0)
  f32x16 pA0,pA1,pB0,pB1;
  int sl_prev=0,sl_cur=0,sl_next=SLOTB;
  #define ROT() do{sl_prev=sl_cur;sl_cur=sl_next;sl_next=(sl_next==(NSLOT-1)*SLOTB)?0:sl_next+SLOTB;}while(0)
  WAIT_BAR(3);
  qkt(pA0,pA1,Kbase,qr,negm,r32,hi);asm volatile("s_nop 15\n\ts_nop 7":"+v"(pA0),"+v"(pA1));
  START(pA0,pA1);
  _Pragma("unroll") for(int r=0;r<16;++r)pA1[r]=__builtin_amdgcn_exp2f(pA1[r]);
  WAIT_BAR(0);
  DMA_K(2,2*SLOTB);DMA_V(1,SLOTB);
  ROT();
  s16x4 vlo[4],vhi[4]; u32x4 pw0,pw1,pw2,pw3;
  #define PKW(P,B) cvtpk_s(P[B],P[B+1])
  #define PAF(k) __builtin_bit_cast(bf16x8,pw##k)
  #define VFR(i) (bf16x8){vlo[i][0],vlo[i][1],vlo[i][2],vlo[i][3],vhi[i][0],vhi[i][1],vhi[i][2],vhi[i][3]}
  #define PIN(x) asm volatile("":"+v"(x))
  #define MX3(a,b,c) __builtin_fmaxf(__builtin_fmaxf((a),(b)),(c))
  #define GAPA(MF,A0,A1,A2,A3,W0,W1,PW) do{ MF; sacc+=A0; sacc+=A1; sacc+=A2; sacc+=A3; PIN(sacc); W0; W1; PIN(PW); SBAR(); }while(0)
  #define EX(v) __builtin_amdgcn_exp2f(v)
  #define GAPB2(MF,X,B) do{ MF; X[B]=EX(X[B]); X[B+1]=EX(X[B+1]); PIN(X); SBAR(); }while(0)
  #define VRDX(s,DB,KS) do{ vlo[s]=vtr(vp_+((DB)*4096+(KS)*1024)); vhi[s]=vtr(vp_+((DB)*4096+(KS)*1024+512)); }while(0)
  #define KRDP(DST,j) do{ DST[0]=*(const __attribute__((address_space(3))) bf16x8*)(kp_+(j)*2048); DST[1]=*(const __attribute__((address_space(3))) bf16x8*)(kp_+(j)*2048+512); }while(0)
  #define MF32(A,B,C) __builtin_amdgcn_mfma_f32_32x32x16_bf16(A,B,C,0,0,0)
  #define STEP128(C0,C1,P0,P1,t,GK,GV) do{ SBAR(); \
    if(GK){DMA_K((t)+2,sl_prev);} if(GV){DMA_V((t)+1,sl_next);} \
    const lds_cptr vp_=vp0+2*sl_prev; const lds_cptr kp_=kp0+sl_cur; \
    KRDP(kfa,0); KRDP(kfb,1); SBAR(); \
    VRDX(0,0,0); SBAR(); float sacc=(P0[0]+P0[1]); \
    GAPA(C0=MF32(kfa[0],qr[0],negm), P0[2],P0[3],P0[4],P0[5],     pw0[0]=PKW(P0,0), pw0[1]=PKW(P0,2), pw0); \
    VRDX(1,1,0); SBAR(); GAPA(C1=MF32(kfa[1],qr[0],negm), P0[6],P0[7],P0[8],P0[9],     pw0[2]=PKW(P0,4), pw0[3]=PKW(P0,6), pw0); \
    KRDP(kfa,2); SBAR(); \
    VRDX(2,2,0); SBAR(); GAPA(C0=MF32(kfb[0],qr[1],C0),   P0[10],P0[11],P0[12],P0[13], pw1[0]=PKW(P0,8), pw1[1]=PKW(P0,10), pw1); \
    VRDX(3,3,0); SBAR(); GAPA(C1=MF32(kfb[1],qr[1],C1),   P0[14],P0[15],P1[0],P1[1],   pw1[2]=PKW(P0,12),pw1[3]=PKW(P0,14), pw1); \
    KRDP(kfb,3); SBAR(); \
    GAPA(C0=MF32(kfa[0],qr[2],C0),   P1[2],P1[3],P1[4],P1[5],     pw2[0]=PKW(P1,0), pw2[1]=PKW(P1,2), pw2); \
    GAPA(C1=MF32(kfa[1],qr[2],C1),   P1[6],P1[7],P1[8],P1[9],     pw2[2]=PKW(P1,4), pw2[3]=PKW(P1,6), pw2); \
    GAPA(C0=MF32(kfb[0],qr[3],C0),   P1[10],P1[11],P1[12],P1[13], pw3[0]=PKW(P1,8), pw3[1]=PKW(P1,10), pw3); \
    GAPA(C1=MF32(kfb[1],qr[3],C1),   P1[14],P1[15],0.f,0.f,       pw3[2]=PKW(P1,12),pw3[3]=PKW(P1,14), pw3); \
    l_reg+=sacc; \
    { float a=MX3(C0[0],C0[1],C1[0]),b=MX3(C0[2],C0[3],C1[1]); a=MX3(a,C1[2],C1[3]); \
      _Pragma("unroll") for(int r=4;r<16;r+=4){a=MX3(a,C0[r],C0[r+1]);b=MX3(b,C0[r+2],C0[r+3]);a=MX3(a,C1[r],C1[r+1]);b=MX3(b,C1[r+2],C1[r+3]);} \
      float rm=__builtin_fmaxf(a,b); { auto rr=__builtin_amdgcn_permlane32_swap(__float_as_uint(rm),__float_as_uint(rm),false,false); rm=__builtin_fmaxf(__uint_as_float(rr[0]),__uint_as_float(rr[1])); } \
      resc=false; \
      if(__builtin_expect(__any(rm>(float)THRL),0)){ const float dl=__builtin_fmaxf(rm,0.f); mhat+=dl; \
        _Pragma("unroll") for(int r=0;r<16;++r){C0[r]-=dl;C1[r]-=dl;} \
        _Pragma("unroll") for(int r=0;r<16;++r)negm[r]=-mhat; asm volatile("":"+v"(negm)); \
        const float f=__builtin_amdgcn_exp2f(-dl); l_reg*=f; if(hi==0)wsf[r32]=f; resc=true; } } \
    SBAR(); \
    GAPB2(o[0]=MF32(PAF(0),VFR(0),o[0]), C0,0);  VRDX(0,0,1); SBAR(); \
    GAPB2(o[1]=MF32(PAF(0),VFR(1),o[1]), C0,2);  VRDX(1,1,1); SBAR(); \
    GAPB2(o[2]=MF32(PAF(0),VFR(2),o[2]), C0,4);  VRDX(2,2,1); SBAR(); \
    GAPB2(o[3]=MF32(PAF(0),VFR(3),o[3]), C0,6);  VRDX(3,3,1); SBAR(); \
    GAPB2(o[0]=MF32(PAF(1),VFR(0),o[0]), C0,8);  VRDX(0,0,2); SBAR(); \
    GAPB2(o[1]=MF32(PAF(1),VFR(1),o[1]), C0,10); VRDX(1,1,2); SBAR(); \
    GAPB2(o[2]=MF32(PAF(1),VFR(2),o[2]), C0,12); VRDX(2,2,2); SBAR(); \
    GAPB2(o[3]=MF32(PAF(1),VFR(3),o[3]), C0,14); VRDX(3,3,2); SBAR(); \
    GAPB2(o[0]=MF32(PAF(2),VFR(0),o[0]), C1,0);  VRDX(0,0,3); SBAR(); \
    GAPB2(o[1]=MF32(PAF(2),VFR(1),o[1]), C1,2);  VRDX(1,1,3); SBAR(); \
    GAPB2(o[2]=MF32(PAF(2),VFR(2),o[2]), C1,4);  VRDX(2,2,3); SBAR(); \
    GAPB2(o[3]=MF32(PAF(2),VFR(3),o[3]), C1,6);  VRDX(3,3,3); SBAR(); \
    GAPB2(o[0]=MF32(PAF(3),VFR(0),o[0]), C1,8); \
    GAPB2(o[1]=MF32(PAF(3),VFR(1),o[1]), C1,10); \
    GAPB2(o[2]=MF32(PAF(3),VFR(2),o[2]), C1,12); \
    GAPB2(o[3]=MF32(PAF(3),VFR(3),o[3]), C1,14); \
    }while(0)
  #define ENDW128(tt) do{ if((tt)+2<NT){WAIT_BAR(3);} else {WAIT_BAR(0);} }while(0)
  for(int t=1;t+1<NT;t+=2){
    STEP128(pB0,pB1,pA0,pA1,t,(t+2<NT),(t+1<NT));       ENDW128(t);   RESC(); ROT();
    STEP128(pA0,pA1,pB0,pB1,t+1,(t+3<NT),(t+2<NT));     ENDW128(t+1); RESC(); ROT();
  }
  STEP128(pB0,pB1,pA0,pA1,NT-1,false,false); RESC();
  { float sacc=pB0[0]+pB0[1]; _Pragma("unroll") for(int r=2;r<16;++r)sacc+=pB0[r]; _Pragma("unroll") for(int r=0;r<16;++r)sacc+=pB1[r]; l_reg+=sacc;
    pw0=(u32x4){PKW(pB0,0),PKW(pB0,2),PKW(pB0,4),PKW(pB0,6)};pw1=(u32x4){PKW(pB0,8),PKW(pB0,10),PKW(pB0,12),PKW(pB0,14)};pw2=(u32x4){PKW(pB1,0),PKW(pB1,2),PKW(pB1,4),PKW(pB1,6)};pw3=(u32x4){PKW(pB1,8),PKW(pB1,10),PKW(pB1,12),PKW(pB1,14)};
    SBAR(); pv128(o,vb0+2*sl_cur,PAF(0),PAF(1),PAF(2),PAF(3)); }
  #undef PKW
  #undef PAF
  #undef VFR
  #undef PIN
  #undef MX3
  #undef GAPA
  #undef GAPB2
  #undef EX
  #undef VRDX
  #undef KRDP
  #undef MF32
  #undef STEP128
  #undef ENDW128
  {auto rr=__builtin_amdgcn_permlane32_swap(__float_as_uint(l_reg),__float_as_uint(l_reg),false,false);l_reg=__uint_as_float(rr[0])+__uint_as_float(rr[1]);}
  if(hi==0)wsf[32+r32]=l_reg;asm volatile("s_waitcnt lgkmcnt(0)":::"memory");
  #pragma unroll
  for(int r=0;r<16;++r){const float rl=__builtin_amdgcn_rcpf(wsf[32+crow(r,hi)]);
    #pragma unroll
    for(int d_=0;d_<4;++d_)o[d_][r]*=rl;}
  asm volatile("s_waitcnt lgkmcnt(0)\n\ts_barrier":::"memory");
  #undef DMA_K
  #undef DMA_V
  #undef START
  #undef RESC
  #undef ROT
}

#undef SBAR
#undef WAIT_BAR
}

constexpr int NWAVES = 8;
constexpr int DM = 1024, NB = 32, SEQ = 2048, NTOK = NB * SEQ, DEPTH = 4, NE = 16, CAP = 256, FF = 2048, NROWS_E = NB * NE * CAP;
constexpr float RMS_EPS = 1e-6f;
constexpr float YE_SCALE = 32.0f, YE_INV = 1.0f / 32.0f;
constexpr float QSCALE = 0.125f * 1.4426950408889634f;
constexpr size_t MiB = 1u << 20;
constexpr size_t WS_CTL = 0, CTL_ZERO_BYTES = 64 * 1024;
constexpr size_t WS_TAB = 1 * MiB;
constexpr size_t WS_MISC = 2 * MiB;
constexpr size_t WS_AFF = 3 * MiB;
constexpr size_t WS_GATE = 7 * MiB;
constexpr size_t WS_TOK = 2 * MiB + 512 * 1024;
constexpr size_t WS_SLOT = 8 * MiB;
constexpr size_t WS_WATT = 10 * MiB, WATT_STRIDE = 8 * MiB, WATT_O = 6 * MiB;
constexpr size_t WS_WMOE = 42 * MiB, WMOE_STRIDE = 96 * MiB, WMOE_D = 64 * MiB;
constexpr size_t WS_H = 426 * MiB;
constexpr size_t WS_H8 = 554 * MiB;
constexpr size_t WS_BIG = 618 * MiB;
constexpr size_t WS_ATT = WS_BIG + 384 * MiB;
constexpr size_t WS_XE = 1130 * MiB;
constexpr size_t WS_XB = 1386 * MiB;
constexpr size_t WS_HID = 1514 * MiB;
constexpr size_t WS_END = 1770 * MiB;
constexpr int CW_BAR = 1024;
constexpr int RING_BYTES = 131072, LDSCTL_OFF = 146432, MISC_OFF = LDSCTL_OFF + 320, LDS_BYTES = 147456;

#define GAS __attribute__((address_space(1)))
#define LAS __attribute__((address_space(3)))
typedef unsigned short bf16;
typedef unsigned v4u __attribute__((ext_vector_type(4)));
typedef unsigned v2u __attribute__((ext_vector_type(2)));
typedef float f32x4 __attribute__((ext_vector_type(4)));
#define LDS_WAIT() asm volatile("s_waitcnt lgkmcnt(0)" ::: "memory")
#define VM_WAIT() asm volatile("s_waitcnt vmcnt(0)" ::: "memory")
__device__ __forceinline__ unsigned pk2(float lo, float hi) { unsigned r; asm volatile("v_cvt_pk_bf16_f32 %0, %1, %2" : "=v"(r) : "v"(lo), "v"(hi)); return r; }
__device__ __forceinline__ float bflo(unsigned w) { return __uint_as_float(w << 16); }
__device__ __forceinline__ float bfhi(unsigned w) { return __uint_as_float(w & 0xffff0000u); }


struct Args {
    const float* x; const float* attn_g; const float* ffn_g; const float* final_g;
    const float* w_in[4]; const float* w_o[4];
    const float* lq1[4]; const float* lk1[4]; const float* lq2[4]; const float* lk2[4]; const float* subln[4];
    const float* qn[4]; const float* kn[4];
    const float* sinks[4];
    const float* w_router; const float* w_gate; const float* w_up; const float* w_down;
    float* out; unsigned char* ws;
};

__device__ __forceinline__ float wave_sum(float v) { return sum64(v); }
__host__ __device__ __forceinline__ int dmap_axial(int u) { const int t = u >> 5, i = u & 31; return i < 16 ? i + 16 * t : 32 + (i - 16) + 16 * t; }

__device__ __forceinline__ void transpose_item(const float* W, size_t ldw, int srccol, bf16* WT, int K, int p0, int k0, LAS float* scr, int lane, const float* kscale = nullptr) {
    const float* src = W + (size_t)k0 * ldw + srccol;
    if (kscale) {
#pragma unroll 16
        for (int kk = 0; kk < 64; ++kk) scr[kk * 65 + lane] = __builtin_nontemporal_load(&src[(size_t)kk * ldw]) * kscale[k0 + kk];
    } else {
#pragma unroll 16
    for (int kk = 0; kk < 64; ++kk) scr[kk * 65 + lane] = __builtin_nontemporal_load(&src[(size_t)kk * ldw]);
    }
    LDS_WAIT(); asm volatile("" ::: "memory");
    const int c = lane & 7;
#pragma unroll
    for (int j = 0; j < 8; ++j) { const int n = (lane >> 3) + 8 * j; const LAS float* s = scr + (8 * c) * 65 + n;
        v4u o; o.x = pk2(s[0 * 65], s[1 * 65]); o.y = pk2(s[2 * 65], s[3 * 65]); o.z = pk2(s[4 * 65], s[5 * 65]); o.w = pk2(s[6 * 65], s[7 * 65]);
        *(v4u*)(WT + (size_t)(p0 + n) * K + k0 + 8 * c) = o; }
    LDS_WAIT(); asm volatile("" ::: "memory");
}

__device__ __forceinline__ void transpose_item_f8(const float* W, size_t ldw, int srccol, unsigned char* WT, int KB, int p0, int k0, LAS float* scr, int lane, float scale) {
    const float* src = W + (size_t)k0 * ldw + srccol;
#pragma unroll 16
    for (int kk = 0; kk < 64; ++kk) scr[kk * 65 + lane] = __builtin_nontemporal_load(&src[(size_t)kk * ldw]);
    LDS_WAIT(); asm volatile("" ::: "memory");
    const int c = lane & 3;
#pragma unroll
    for (int j = 0; j < 4; ++j) { const int n = (lane >> 2) + 16 * j; const LAS float* t = scr + (16 * c) * 65 + n;
        v4u o;
        o.x = pg8::cvt4_fp8(t[0 * 65] * scale, t[1 * 65] * scale, t[2 * 65] * scale, t[3 * 65] * scale);
        o.y = pg8::cvt4_fp8(t[4 * 65] * scale, t[5 * 65] * scale, t[6 * 65] * scale, t[7 * 65] * scale);
        o.z = pg8::cvt4_fp8(t[8 * 65] * scale, t[9 * 65] * scale, t[10 * 65] * scale, t[11 * 65] * scale);
        o.w = pg8::cvt4_fp8(t[12 * 65] * scale, t[13 * 65] * scale, t[14 * 65] * scale, t[15 * 65] * scale);
        __builtin_nontemporal_store(o, (v4u*)(WT + (size_t)(p0 + n) * KB + k0 + 16 * c)); }
    LDS_WAIT(); asm volatile("" ::: "memory");
}

__device__ __forceinline__ float row_rstd(const f32x4 (&v)[4]) {
    float s = 0.f;
#pragma unroll
    for (int j = 0; j < 4; ++j) s += (v[j].x * v[j].x + v[j].y * v[j].y) + (v[j].z * v[j].z + v[j].w * v[j].w);
    return __builtin_amdgcn_rsqf(wave_sum(s) * (1.0f / DM) + RMS_EPS);
}
__device__ __forceinline__ void store_row_bf16(bf16* orow, const f32x4 (&v)[4], int lane) {
    v2u* o8 = (v2u*)orow + lane;
#pragma unroll
    for (int j = 0; j < 4; ++j) { v2u w; w.x = pk2(v[j].x, v[j].y); w.y = pk2(v[j].z, v[j].w); o8[64 * j] = w; }
}


__device__ __forceinline__ void acc_fp8x4(f32x4& v, unsigned w) {
    typedef float f32x2 __attribute__((ext_vector_type(2)));
    const f32x2 lo = __builtin_amdgcn_cvt_pk_f32_fp8((int)w, false), hi = __builtin_amdgcn_cvt_pk_f32_fp8((int)w, true);
    v.x += lo.x * YE_INV; v.y += lo.y * YE_INV; v.z += hi.x * YE_INV; v.w += hi.y * YE_INV;
}
__device__ __forceinline__ void load_row_bf16(f32x4 (&v)[4], const bf16* row, int lane) {
    const v2u* r8 = (const v2u*)row + lane;
#pragma unroll
    for (int j = 0; j < 4; ++j) { const v2u w = r8[64 * j]; v[j].x = bflo(w.x); v[j].y = bfhi(w.x); v[j].z = bflo(w.y); v[j].w = bfhi(w.y); }
}
__device__ __forceinline__ void add_expert_rows(f32x4 (&v)[4], int sl, unsigned mask, int b, const unsigned char* YE, int lane) {
    while (mask) {
        unsigned w[4][4]; bool ok[4];
#pragma unroll
        for (int k = 0; k < 4; ++k) {
            ok[k] = mask != 0u;
            if (ok[k]) { const int e = __builtin_ctz(mask); mask &= mask - 1u; const int c = __builtin_amdgcn_readlane(sl, e);
                const unsigned* yr = (const unsigned*)(YE + ((size_t)((e * 32 + b) * 256 + c)) * DM) + lane;
#pragma unroll
                for (int j = 0; j < 4; ++j) w[k][j] = yr[64 * j]; }
        }
#pragma unroll
        for (int k = 0; k < 4; ++k)
            if (ok[k]) {
#pragma unroll
                for (int j = 0; j < 4; ++j) acc_fp8x4(v[j], w[k][j]); }
    }
}

__device__ __forceinline__ void load_combine2(f32x4 (&va)[4], f32x4 (&vb)[4], const bf16* xa, const bf16* xb, int sla, int slb, int ba, int bb, const unsigned char* YE, int lane) {
    unsigned ma = (unsigned)__ballot(sla >= 0) & 0xffffu, mb = (unsigned)__ballot(slb >= 0) & 0xffffu;
#pragma unroll
    for (int j = 0; j < 4; ++j) { va[j] = (f32x4){0.f, 0.f, 0.f, 0.f}; vb[j] = va[j]; }
    v2u xra[4], xrb[4];
#pragma unroll
    for (int j = 0; j < 4; ++j) { xra[j] = ((const v2u*)xa + lane)[64 * j]; xrb[j] = ((const v2u*)xb + lane)[64 * j]; }
    unsigned wa[3][4], wb[3][4]; bool oa[3], ob[3];
#pragma unroll
    for (int k = 0; k < 3; ++k) { oa[k] = ma != 0u;
        if (oa[k]) { const int e = __builtin_ctz(ma); ma &= ma - 1u; const int c = __builtin_amdgcn_readlane(sla, e); const unsigned* yr = (const unsigned*)(YE + ((size_t)((e * 32 + ba) * 256 + c)) * DM) + lane;
#pragma unroll
            for (int j = 0; j < 4; ++j) wa[k][j] = yr[64 * j]; } }
#pragma unroll
    for (int k = 0; k < 3; ++k) { ob[k] = mb != 0u;
        if (ob[k]) { const int e = __builtin_ctz(mb); mb &= mb - 1u; const int c = __builtin_amdgcn_readlane(slb, e); const unsigned* yr = (const unsigned*)(YE + ((size_t)((e * 32 + bb) * 256 + c)) * DM) + lane;
#pragma unroll
            for (int j = 0; j < 4; ++j) wb[k][j] = yr[64 * j]; } }
#pragma unroll
    for (int j = 0; j < 4; ++j) { va[j].x = bflo(xra[j].x); va[j].y = bfhi(xra[j].x); va[j].z = bflo(xra[j].y); va[j].w = bfhi(xra[j].y);
                                  vb[j].x = bflo(xrb[j].x); vb[j].y = bfhi(xrb[j].x); vb[j].z = bflo(xrb[j].y); vb[j].w = bfhi(xrb[j].y); }
#pragma unroll
    for (int k = 0; k < 3; ++k) if (oa[k]) {
#pragma unroll
        for (int j = 0; j < 4; ++j) acc_fp8x4(va[j], wa[k][j]); }
#pragma unroll
    for (int k = 0; k < 3; ++k) if (ob[k]) {
#pragma unroll
        for (int j = 0; j < 4; ++j) acc_fp8x4(vb[j], wb[k][j]); }
    if (ma) add_expert_rows(va, sla, ma, ba, YE, lane);
    if (mb) add_expert_rows(vb, slb, mb, bb, YE, lane);
}


#define XB_TMO      128
#define XB_XCNT(j)  (256  + 64 * (j))
#define XB_XSUB(j)  (1280 + 64 * (j))
#define XB_XGEN(j)  (2304 + 64 * (j))
#define XB_TOP      3328
#define XB_TOPGEN   3392
#define XCD_BAR_WORDS 3456
#define XB_SPIN_CAP (1u << 18)

__device__ __forceinline__ unsigned xb_ld(unsigned* p)              { return __hip_atomic_load(p, __ATOMIC_RELAXED, __HIP_MEMORY_SCOPE_AGENT); }
__device__ __forceinline__ unsigned xb_add(unsigned* p, unsigned v) { return __hip_atomic_fetch_add(p, v, __ATOMIC_RELAXED, __HIP_MEMORY_SCOPE_AGENT); }
__device__ __forceinline__ unsigned xb_xcc_id() { return (unsigned)__builtin_amdgcn_s_getreg((3 << 11) | 20) & 0xFu; }
#define XB_SPIN(cond, bar) do { unsigned _sp = 0; while (cond) { __builtin_amdgcn_s_sleep(1); \
    if ((++_sp & 255u) == 0u) { if (xb_ld(&(bar)[XB_TMO])) break; if (_sp > XB_SPIN_CAP) { atomicAdd(&(bar)[XB_TMO], 1u); break; } } } } while (0)

struct XcdBarrier {
    unsigned* bar; unsigned x;
    volatile LAS unsigned* st;
};

__device__ __forceinline__ XcdBarrier xcd_barrier_post(unsigned* bar, volatile LAS unsigned* st) {
    XcdBarrier b; b.bar = bar; b.x = xb_xcc_id(); b.st = st;
    if (threadIdx.x == 0) st[2] = xb_add(&bar[XB_XCNT(b.x)], 1u);
    return b;
}
__device__ __forceinline__ void xcd_barrier_complete(unsigned* bar, unsigned x, unsigned& nloc, unsigned& nx, unsigned& even) {
    const unsigned G = gridDim.x * gridDim.y * gridDim.z;
    unsigned sum, cnt, mine, sp = 0u, c32;
    for (;;) {
        sum = 0u; cnt = 0u; mine = 0u; c32 = 0u;
#pragma unroll
        for (unsigned j = 0; j < 16; ++j) { const unsigned c = xb_ld(&bar[XB_XCNT(j)]); sum += c; cnt += (c > 0u) ? 1u : 0u; c32 += (j < 8u && c == 32u) ? 1u : 0u; mine = (j == x) ? c : mine; }
        if (sum == G) break;
        __builtin_amdgcn_s_sleep(1);
        if ((++sp & 255u) == 0u) { if (xb_ld(&bar[XB_TMO])) break; if (sp > XB_SPIN_CAP) { atomicAdd(&bar[XB_TMO], 1u); break; } }
    }
    nloc = mine > 0u ? mine : 1u; nx = cnt > 0u ? cnt : 1u;
    even = (sum == G && G == 256u && c32 == 8u) ? 1u : 0u;
}

__device__ __forceinline__ void xcd_barrier(const XcdBarrier& b, bool local_only = false) {
    asm volatile("s_waitcnt vmcnt(0)" ::: "memory");
    __syncthreads();
    if (threadIdx.x == 0) {
        size_t zb_ = 0; asm volatile("" : "+s"(zb_)); unsigned* bar = b.bar + zb_; unsigned bx_ = b.x; asm volatile("" : "+s"(bx_));
        __builtin_amdgcn_s_waitcnt(0);
        unsigned nloc = b.st[0], nx = b.st[1];
        const unsigned old = xb_add(&bar[XB_XSUB(bx_)], 1u);
        const unsigned gen = old / nloc;
        if (old + 1u == (gen + 1u) * nloc) {
            __builtin_amdgcn_fence(__ATOMIC_RELEASE, "agent");
            asm volatile("s_waitcnt vmcnt(0)" ::: "memory");
            if (!local_only) {
            const unsigned og = xb_add(&bar[XB_TOP], 1u);
            const unsigned tg = og / nx;
            if (og + 1u == (tg + 1u) * nx) xb_add(&bar[XB_TOPGEN], 1u);
            else XB_SPIN(xb_ld(&bar[XB_TOPGEN]) == tg, bar);
            }
            __builtin_amdgcn_fence(__ATOMIC_ACQUIRE, "agent");
            xb_add(&bar[XB_XGEN(bx_)], 1u);
            asm volatile("s_waitcnt vmcnt(0)" ::: "memory");
        } else {
            XB_SPIN(xb_ld(&bar[XB_XGEN(bx_)]) == gen, bar);
            __builtin_amdgcn_fence(__ATOMIC_ACQUIRE, "agent");
            asm volatile("s_waitcnt vmcnt(0)" ::: "memory");
        }
    }
    __syncthreads();
}


__global__ void __launch_bounds__(NWAVES * 64, 2) mk_fwd(Args args) {
    extern __shared__ __attribute__((aligned(16))) unsigned char lds[];
    LAS unsigned char* ldsl = (LAS unsigned char*)lds;
    const int G = gridDim.x;
    const int wave0 = __builtin_amdgcn_readfirstlane((int)threadIdx.x >> 6);
    const int NGW = G * NWAVES;
#define PHASE_IDS() const int tid = fresh_tid(wave0), lane = tid & 63, wave = __builtin_amdgcn_readfirstlane(tid >> 6), gw = vcu * NWAVES + wave; (void)gw; (void)lane; (void)tid; size_t zero_ = 0; asm volatile("" : "+s"(zero_)); unsigned char* ws = args.ws + zero_; float* XR = args.out + zero_; (void)XR
    unsigned* ctl = (unsigned*)(args.ws + WS_CTL);
#define tab ((float*)(ws + WS_TAB))
#define gperm ((float*)(ws + WS_MISC))
#define AFF ((float*)(ws + WS_AFF))
#define GATE ((float*)(ws + WS_GATE))
#define SLOT ((short*)(ws + WS_SLOT))
#define TOK ((int*)(ws + WS_TOK))
#define H ((bf16*)(ws + WS_H))
#define QKV ((bf16*)(ws + WS_BIG))
#define ATT ((bf16*)(ws + WS_ATT))
#define HID8 (ws + WS_HID)
#define XE ((bf16*)(ws + WS_XE))
#define XE8 (ws + WS_XE)
#define H8 (ws + WS_H8)
#define XB ((bf16*)(ws + WS_XB))
#define RSTD ((float*)(ws + WS_MISC + 65536))
    for (int u = threadIdx.x; u < (LDS_BYTES - LDSCTL_OFF) / 4; u += NWAVES * 64) ((LAS unsigned*)(ldsl + LDSCTL_OFF))[u] = 0u;
    __syncthreads();
    volatile LAS unsigned* MISC = (volatile LAS unsigned*)(ldsl + MISC_OFF);
    XcdBarrier bar = xcd_barrier_post(ctl + CW_BAR, MISC + 8);
    if (threadIdx.x == 0) { unsigned nloc_, nx_, even_; xcd_barrier_complete(bar.bar, bar.x, nloc_, nx_, even_); MISC[8] = nloc_; MISC[9] = nx_; MISC[11] = even_; }
    __syncthreads();
    const int gmode = __builtin_amdgcn_readfirstlane((int)MISC[11]);
    const int bx = gmode ? __builtin_amdgcn_readfirstlane((int)MISC[10]) * 8 + (int)bar.x : (int)blockIdx.x;
    const int vcu = (G % 8 == 0) ? (bx % 8) * (G / 8) + bx / 8 : bx;
#define PHASE_ON() true
    if (PROBE_TYPE >= 0 && blockIdx.x == 0 && threadIdx.x == 0) __hip_atomic_store(ctl + 2049, (unsigned)__builtin_amdgcn_s_memrealtime(), __ATOMIC_RELAXED, __HIP_MEMORY_SCOPE_AGENT);
#ifndef EN_P0
#define EN_P0 1
#endif
#ifndef EN_N1
#define EN_N1 1
#endif
#ifndef EN_G1
#define EN_G1 1
#endif
#ifndef EN_AT
#define EN_AT 1
#endif
#ifndef EN_ATA
#define EN_ATA 1
#endif
#ifndef EN_ATB
#define EN_ATB 1
#endif
#ifndef EN_G2
#define EN_G2 1
#endif
#ifndef EN_N2
#define EN_N2 1
#endif
#ifndef EN_TK
#define EN_TK 1
#endif
#ifndef EN_G3
#define EN_G3 1
#endif
#ifndef EN_G4
#define EN_G4 1
#endif
#ifndef EN_FIN
#define EN_FIN 1
#endif
#define PHASE_END(KIND) do { xcd_barrier(bar, (KIND) != 0 && gmode != 0); if (PROBE_TYPE >= 0 && blockIdx.x == 0 && threadIdx.x == 0) { const unsigned t_ = (unsigned)__builtin_amdgcn_s_memrealtime(); \
    const unsigned p_ = __hip_atomic_load(ctl + 2049, __ATOMIC_RELAXED, __HIP_MEMORY_SCOPE_AGENT); __hip_atomic_store(ctl + 2049, t_, __ATOMIC_RELAXED, __HIP_MEMORY_SCOPE_AGENT); \
    if ((KIND) == PROBE_TYPE) __hip_atomic_fetch_add(ctl + 2048, t_ - p_, __ATOMIC_RELAXED, __HIP_MEMORY_SCOPE_AGENT); } } while (0)

    if (EN_P0 && PHASE_ON()) {
            PHASE_IDS();
        for (int i = gw * 64 + lane; i < 2 * SEQ * 32; i += NGW * 64) {
            const int which = i >> 16, s = (i >> 5) & 2047, f = i & 31; float ang;
            if (which == 0) ang = (float)s * exp2f(-(float)f * (13.287712379549449f / 32.0f));
            else ang = (float)(f < 16 ? (s >> 6) : (s & 63)) * exp2f(-(float)(f & 15) * (13.287712379549449f / 16.0f));
            tab[which * 131072 + s * 32 + f] = cosf(ang); tab[which * 131072 + 65536 + s * 32 + f] = sinf(ang);
        }
        if (gw == 0) { gperm[lane] = args.qn[1][dmap_axial(lane)]; gperm[64 + lane] = args.kn[1][dmap_axial(lane)]; }
        LAS float* scr = (LAS float*)(ldsl + wave * 16640);
        {
            constexpr int IT_A = 16 * 48 + 256, IT_B = 16 * 24 + 256, IT_ALL = 2 * IT_A + 2 * IT_B;
            for (int it = gw; it < IT_ALL; it += NGW) {
                int l, r = it;
                if (r < IT_A) l = 0; else { r -= IT_A; if (r < IT_B) l = 1; else { r -= IT_B; if (r < IT_B) l = 2; else { r -= IT_B; l = 3; } } }
                const int m = l % 3, n1 = (m == 0) ? 3072 : 1536, nin = 16 * (n1 / 64);
                bf16* wt = (bf16*)(ws + WS_WATT + (size_t)l * WATT_STRIDE);
                if (r < nin) { const int kb = r / (n1 / 64), pb = r % (n1 / 64), p = pb * 64 + lane;
                    const int pn = p >> 8, bj = (p >> 7) & 1, wc = (p >> 5) & 3, i = p & 31, hd = 4 * pn + wc, u = 32 * bj + i;
                    const int d = (m == 1 && hd < 20) ? dmap_axial(u) : u;
                    transpose_item(args.w_in[l], (size_t)n1, 64 * hd + d, wt, DM, pb * 64, kb * 64, scr, lane, args.attn_g + l * DM);
                } else { r -= nin; const int kb = r / 16, pb = r % 16;
                    transpose_item(args.w_o[l], (size_t)DM, pb * 64 + lane, (bf16*)((unsigned char*)wt + WATT_O), DM, pb * 64, kb * 64, scr, lane); }
            }
        }
        for (int it = gw; it < DEPTH * NE * 1536; it += NGW) {
            const int le = it / 1536, r = it % 1536, l = le >> 4, e = le & 15;
            unsigned char* wgu = ws + WS_WMOE + (size_t)l * WMOE_STRIDE + (size_t)e * 4096 * DM;
            unsigned char* wd = ws + WS_WMOE + (size_t)l * WMOE_STRIDE + WMOE_D + (size_t)e * DM * FF;
            if (r < 1024) { const int kb = r >> 6, pb = r & 63, bjj = (pb >> 1) & 1;
                const float* srcm = (bjj ? args.w_up : args.w_gate) + (size_t)le * DM * FF;
                transpose_item_f8(srcm, (size_t)FF, 128 * (pb >> 2) + 64 * (pb & 1) + lane, wgu, DM, pb * 64, kb * 64, scr, lane, pg8::W8_SCALE);
            } else { const int r2 = r - 1024, kb = r2 >> 4, pb = r2 & 15;
                transpose_item_f8(args.w_down + (size_t)le * FF * DM, (size_t)DM, 256 * (pb >> 2) + 64 * (2 * (pb & 1) + (lane >> 5)) + 32 * ((pb >> 1) & 1) + (lane & 31), wd, FF, pb * 64, kb * 64, scr, lane, pg8::W8_SCALE); }
        }
        {
            f32x4 g[4];
#pragma unroll
            for (int j = 0; j < 4; ++j) g[j] = ((const f32x4*)args.attn_g)[lane + 64 * j];
            for (int m = gw; m < NTOK; m += NGW) {
                const f32x4* xr = (const f32x4*)(args.x + (size_t)m * DM) + lane; f32x4 v[4];
#pragma unroll
                for (int j = 0; j < 4; ++j) v[j] = __builtin_nontemporal_load(&xr[64 * j]);
                store_row_bf16(XB + (size_t)m * DM, v, lane);
                const float rstd = row_rstd(v);
                if (lane == 0) RSTD[m] = rstd;
            }
        }
    }
    PHASE_END(0);

    for (int layer = 0; layer < DEPTH; ++layer) {
        const int mix = layer % 3;
        const int n1 = (mix == 0) ? 3072 : 1536;
#define Win_t ((const bf16*)(ws + WS_WATT + (size_t)layer * WATT_STRIDE))
#define Wo_t ((const bf16*)(ws + WS_WATT + (size_t)layer * WATT_STRIDE + WATT_O))
#define Wgu8 (ws + WS_WMOE + (size_t)layer * WMOE_STRIDE)
#define Wd8 (ws + WS_WMOE + (size_t)layer * WMOE_STRIDE + WMOE_D)

        if (layer > 0) {
            if (EN_N1 && PHASE_ON()) {
            PHASE_IDS();
                f32x4 g[4];
#pragma unroll
                for (int j = 0; j < 4; ++j) g[j] = ((const f32x4*)(args.attn_g + layer * DM))[lane + 64 * j];
              for (int rbk = vcu; rbk < NTOK / 256; rbk += G) {
                const int mbeg = rbk * 256 + wave, mend = rbk * 256 + 256;
                int sla = (lane < 16) ? (int)SLOT[(size_t)mbeg * 16 + lane] : -1, slb = (lane < 16) ? (int)SLOT[(size_t)(mbeg + 8) * 16 + lane] : -1;
                for (int m = mbeg; m < mend; m += 16) {
                    const int m2 = m + 8;
                    const int mn = m + 16; int sna = -1, snb = -1;
                    if (mn < mend) { sna = (lane < 16) ? (int)SLOT[(size_t)mn * 16 + lane] : -1; snb = (lane < 16) ? (int)SLOT[(size_t)(mn + 8) * 16 + lane] : -1; }
                    f32x4 va[4], vb[4];
                    load_combine2(va, vb, XB + (size_t)m * DM, XB + (size_t)m2 * DM, sla, slb, m >> 11, m2 >> 11, XE8, lane);
                    store_row_bf16(XB + (size_t)m * DM, va, lane);
                    const float ra = row_rstd(va);
                    if (lane == 0) RSTD[m] = ra;
                    if (m2 != m) {
                        store_row_bf16(XB + (size_t)m2 * DM, vb, lane);
                        const float rb = row_rstd(vb);
                        if (lane == 0) RSTD[m2] = rb;
                    }
                    sla = sna; slb = snb;
                }
              }
            }
            PHASE_END(1);
        }

        if (EN_G1 && PHASE_ON()) {
            PHASE_IDS();
              pg8::Gemm g{XB, Win_t, NTOK, n1, DM}; pg8::StaticOrder S; S.init(NTOK, n1, G, bx);
            const float* tc = tab + (mix == 1 ? 131072 : 0);
            LAS float* gl = (LAS float*)(ldsl + RING_BYTES);
            if (mix == 1 && tid < 128) gl[tid] = gperm[tid];
            __syncthreads();
            pg8::EpiQKV E{QKV, 3072  , tc, tc + 65536, (mix == 0) ? 8 : 5, 4, (mix == 1) ? gl : nullptr, (mix == 1) ? gl + 64 : nullptr, QSCALE, RSTD};
            pg8::gemm_phase<pg8::EpiQKV, pg8::StaticOrder, true, true>(ldsl, g, S, E, wave0);
        }
        PHASE_END(2);

        if (EN_AT && PHASE_ON()) {
            PHASE_IDS();
          for (int rb = vcu; rb < NTOK / 256; rb += G) {
            const int b = rb >> 3, qb = rb & 7;
            const int tid = fresh_tid(wave0), lane = tid & 63, wave = __builtin_amdgcn_readfirstlane(tid >> 6); (void)lane; (void)wave; (void)tid; size_t zs_ = 0; asm volatile("" : "+s"(zs_)); unsigned char* ws = args.ws + zs_;
            if (EN_ATA && mix == 0) {
                const int jl = layer / 3;
                const float lambda_init = (layer == 0) ? 0.2f : 0.55605820416f;
                const float s1 = wave_sum(args.lq1[layer][lane] * args.lk1[layer][lane]), s2 = wave_sum(args.lq2[layer][lane] * args.lk2[layer][lane]);
                const float lam = __uint_as_float(__builtin_amdgcn_readfirstlane(__float_as_uint(__expf(s1) - __expf(s2) + lambda_init))); (void)jl;
                const float* subg = args.subln[layer];
                LAS unsigned* stash = (LAS unsigned*)(ldsl + 75776) + tid;
                for (int h = 0; h < 8; ++h) {
                    const bf16* base = QKV + (size_t)(b * SEQ) * 3072;
                    att::f32x16 o[4];
#pragma unroll 1
                    for (int c = 0; c < 2; ++c) {
                        __syncthreads();
                        ab2::attn_unit128<8, 3072>(o, (const ab2::bf16*)(base + (size_t)(qb * 256) * 3072 + 64 * (2 * h + c)), (const ab2::bf16*)(base + 1024 + 64 * (2 * h + c)), (const ab2::bf16*)(base + 2048 + 128 * h), SEQ / 64, (char*)lds, wave0);
                        if (c == 0) {
#pragma unroll
                            for (int d = 0; d < 4; ++d)
#pragma unroll
                                for (int q = 0; q < 8; ++q) stash[(d * 8 + q) * 512] = att::cvtpk(o[d][2 * q], o[d][2 * q + 1]);
                        }
                    }
                    float ss[16], gs[4];
#pragma unroll
                    for (int d = 0; d < 4; ++d) gs[d] = subg[32 * d + (lane & 31)] * (1.0f - lambda_init);
#pragma unroll
                    for (int r = 0; r < 16; ++r) ss[r] = 0.f;
#pragma unroll
                    for (int d = 0; d < 4; ++d)
#pragma unroll
                        for (int q = 0; q < 8; ++q) { const unsigned w = stash[(d * 8 + q) * 512];
                            const float a = bflo(w) - lam * o[d][2 * q], bq = bfhi(w) - lam * o[d][2 * q + 1];
                            o[d][2 * q] = a; o[d][2 * q + 1] = bq; ss[2 * q] += a * a; ss[2 * q + 1] += bq * bq; }
#pragma unroll
                    for (int r = 0; r < 16; ++r) { const float s = sum32(ss[r]);
                        const float rstd = __builtin_amdgcn_rsqf(s * (1.0f / 128.0f) + RMS_EPS);
#pragma unroll
                        for (int d = 0; d < 4; ++d) o[d][r] *= rstd * gs[d]; }
                    {
                        const int t2 = fresh_tid(wave0), l2 = t2 & 63, w2 = __builtin_amdgcn_readfirstlane(t2 >> 6);
                        LAS unsigned char* stg = ldsl + 75776 + w2 * 256;
                        att::stage_o<4>(o, stg, 2048, l2);
                        asm volatile("s_waitcnt lgkmcnt(0)" ::: "memory");
                        const LAS unsigned char* sp = stg + (l2 >> 4) * 2048 + (l2 & 15) * 16;
                        bf16* op = ATT + (size_t)(b * SEQ + qb * 256 + w2 * 32 + (l2 >> 4)) * DM + 128 * h + (l2 & 15) * 8;
#pragma unroll
                        for (int i = 0; i < 8; ++i) { const v4u v = *(const LAS v4u*)(sp + i * 8192); *(v4u*)(op + (size_t)i * 4 * DM) = v; }
                        asm volatile("s_waitcnt lgkmcnt(0)" ::: "memory");
                    }
                }
            } else if (EN_ATB && mix == 1) {
                for (int hq = 0; hq < 16; ++hq) { const int kvh = hq >> 2;
                    const bf16* base = QKV + (size_t)(b * SEQ) * 3072;
                    att::f32x16 o[2];
                    __syncthreads();
                    ab2::attn_unit<8, 3072, 1024, false>((const ab2::bf16*)(base + (size_t)(qb * 256) * 3072 + 64 * hq), (const ab2::bf16*)(base + 1024 + 64 * kvh), (const ab2::bf16*)(base + 1280 + 64 * kvh),
                                                         (ab2::bf16*)(ATT + (size_t)(b * SEQ + qb * 256) * DM + 64 * hq), SEQ / 64, 0, 0, -__builtin_inff(), (char*)lds, wave0);
                }
            } else if (EN_ATB) {
                for (int hq = 0; hq < 16; ++hq) { const int kvh = hq >> 2;
                    const bf16* base = QKV + (size_t)(b * SEQ) * 3072;
                    att::f32x16 o[2];
                    __syncthreads();
                    const int klo = (qb * 256 - 128) < 0 ? 0 : qb * 256 - 128, khi = (qb * 256 + 384) > SEQ ? SEQ : qb * 256 + 384;
                    ab2::attn_unit<8, 3072, 1024, true>((const ab2::bf16*)(base + (size_t)(qb * 256) * 3072 + 64 * hq), (const ab2::bf16*)(base + (size_t)klo * 3072 + 1024 + 64 * kvh), (const ab2::bf16*)(base + (size_t)klo * 3072 + 1280 + 64 * kvh),
                                                        (ab2::bf16*)(ATT + (size_t)(b * SEQ + qb * 256) * DM + 64 * hq), (khi - klo) / 64, qb * 256, klo, args.sinks[layer][hq] * 1.4426950408889634f, (char*)lds, wave0);
                }
            }
          }
        }
        PHASE_END(3 + mix);

        if (EN_G2 && PHASE_ON()) {
            PHASE_IDS();
            pg8::Gemm g{ATT, Wo_t, NTOK, DM, DM}; pg8::StaticOrder S; S.init(NTOK, DM, G, bx);
            pg8::EpiResBf16 E{XB, DM};
            pg8::gemm_phase<pg8::EpiResBf16, pg8::StaticOrder, true, true>(ldsl, g, S, E, wave0);
        }
        PHASE_END(6);

        if (EN_N2 && PHASE_ON()) {
            PHASE_IDS();
            LAS float* wr = (LAS float*)ldsl;
            const float* wsrc = args.w_router + (size_t)layer * DM * NE;
            for (int i4 = tid; i4 < DM * NE / 4; i4 += NWAVES * 64) { const f32x4 w = ((const f32x4*)wsrc)[i4]; const int col = i4 >> 2, e0 = (i4 & 3) * 4;
                wr[(e0 + 0) * DM + col] = w.x; wr[(e0 + 1) * DM + col] = w.y; wr[(e0 + 2) * DM + col] = w.z; wr[(e0 + 3) * DM + col] = w.w; }
            __syncthreads();
            f32x4 g[4];
#pragma unroll
            for (int j = 0; j < 4; ++j) g[j] = ((const f32x4*)(args.ffn_g + layer * DM))[lane + 64 * j];
            const bool hb3 = (lane & 8) != 0, hb2 = (lane & 4) != 0, hb1 = (lane & 2) != 0, hb0 = (lane & 1) != 0;
            for (int rbk = vcu; rbk < NTOK / 256; rbk += G)
            for (int m0 = rbk * 256 + wave * 4; m0 < rbk * 256 + 256; m0 += NWAVES * 4) {
                f32x4 v[4][4];
#pragma unroll
                for (int t = 0; t < 4; ++t) load_row_bf16(v[t], XB + (size_t)(m0 + t) * DM, lane);
#pragma unroll
                for (int t = 0; t < 4; ++t) { const float rstd = row_rstd(v[t]); unsigned* o4 = (unsigned*)(H8 + (size_t)(m0 + t) * DM) + lane;
#pragma unroll
                    for (int j = 0; j < 4; ++j) { v[t][j] = v[t][j] * rstd * g[j]; o4[64 * j] = pg8::cvt4_fp8(v[t][j].x, v[t][j].y, v[t][j].z, v[t][j].w); } }
                typedef float f32x2 __attribute__((ext_vector_type(2)));
                f32x2 vp[2][4][4];
#pragma unroll
                for (int p = 0; p < 2; ++p)
#pragma unroll
                    for (int j = 0; j < 4; ++j)
#pragma unroll
                        for (int c = 0; c < 4; ++c) vp[p][j][c] = (f32x2){v[2 * p][j][c], v[2 * p + 1][j][c]};
                float acc[4][16];
#pragma unroll
                for (int e = 0; e < 16; ++e) {
                    f32x2 a2[2] = {(f32x2){0.f, 0.f}, (f32x2){0.f, 0.f}};
#pragma unroll
                    for (int j = 0; j < 4; ++j) { const f32x4 w = *(const LAS f32x4*)(wr + e * DM + 256 * j + 4 * lane);
#pragma unroll
                        for (int p = 0; p < 2; ++p)
#pragma unroll
                            for (int c = 0; c < 4; ++c) a2[p] = __builtin_elementwise_fma(vp[p][j][c], (f32x2){w[c], w[c]}, a2[p]); }
                    acc[0][e] = a2[0].x; acc[1][e] = a2[0].y; acc[2][e] = a2[1].x; acc[3][e] = a2[1].y;
                    if (e & 1) __builtin_amdgcn_sched_barrier(0);
                }
                float a8[4][8], b4[4][4], c2[4][2], d1[4], e2[2];
#pragma unroll
                for (int t = 0; t < 4; ++t)
#pragma unroll
                    for (int e = 0; e < 8; ++e) { auto r = __builtin_amdgcn_permlane32_swap(__float_as_uint(acc[t][e]), __float_as_uint(acc[t][e + 8]), false, false); a8[t][e] = __uint_as_float(r[0]) + __uint_as_float(r[1]); }
#pragma unroll
                for (int t = 0; t < 4; ++t)
#pragma unroll
                    for (int e = 0; e < 4; ++e) { auto r = __builtin_amdgcn_permlane16_swap(__float_as_uint(a8[t][e]), __float_as_uint(a8[t][e + 4]), false, false); b4[t][e] = __uint_as_float(r[0]) + __uint_as_float(r[1]); }
#pragma unroll
                for (int t = 0; t < 4; ++t)
#pragma unroll
                    for (int e = 0; e < 2; ++e) { const float keep = hb3 ? b4[t][e + 2] : b4[t][e], send = hb3 ? b4[t][e] : b4[t][e + 2]; c2[t][e] = keep + dpp_mirror(send); }
#pragma unroll
                for (int t = 0; t < 4; ++t) { const float keep = hb2 ? c2[t][1] : c2[t][0], send = hb2 ? c2[t][0] : c2[t][1]; d1[t] = keep + dpp_hmirror(send); }
#pragma unroll
                for (int t = 0; t < 2; ++t) { const float keep = hb1 ? d1[t + 2] : d1[t], send = hb1 ? d1[t] : d1[t + 2]; e2[t] = keep + dpp_xor2(send); }
                const float lg = (hb0 ? e2[1] : e2[0]) + dpp_xor1(hb0 ? e2[0] : e2[1]);
                float mx = fmaxf(lg, dpp_ror4(lg)); mx = fmaxf(mx, dpp_ror8(mx));
                { auto r = __builtin_amdgcn_permlane16_swap(__float_as_uint(mx), __float_as_uint(mx), false, false); mx = fmaxf(__uint_as_float(r[0]), __uint_as_float(r[1])); }
                { auto r = __builtin_amdgcn_permlane32_swap(__float_as_uint(mx), __float_as_uint(mx), false, false); mx = fmaxf(__uint_as_float(r[0]), __uint_as_float(r[1])); }
                const float p = __expf(lg - mx);
                float sm = p + dpp_ror4(p); sm += dpp_ror8(sm); sm = sum_swap32(sum_swap16(sm));
                AFF[((size_t)(m0 >> 11) * 16 + (lane >> 2)) * SEQ + (m0 & 2047) + (lane & 3)] = p / sm;
            }
            __syncthreads();
        }
        PHASE_END(7);

        if (EN_TK && PHASE_ON()) {
            PHASE_IDS();
            LAS unsigned* red = (LAS unsigned*)ldsl;
            for (int pi = vcu; pi < NTOK / 256; pi += G)
            for (int ee = 0; ee < 2; ++ee) {
                const int b = pi >> 3, e = 2 * (pi & 7) + ee, pair = b * 16 + e;
                const f32x4 av = ((const f32x4*)(AFF + (size_t)pair * SEQ))[tid];
                const unsigned u0 = __float_as_uint(av.x), u1 = __float_as_uint(av.y), u2 = __float_as_uint(av.z), u3 = __float_as_uint(av.w);
                unsigned prefix = 0u;
                for (int bit = 30; bit >= 0; --bit) {
                    const unsigned cand = prefix | (1u << bit);
                    const unsigned cw = (unsigned)__popcll(__ballot(u0 >= cand)) + (unsigned)__popcll(__ballot(u1 >= cand)) + (unsigned)__popcll(__ballot(u2 >= cand)) + (unsigned)__popcll(__ballot(u3 >= cand));
                    LAS unsigned* rb = red + (bit & 1) * 8;
                    if (lane == 0) rb[wave] = cw;
                    __syncthreads();
                    unsigned tot = 0;
#pragma unroll
                    for (int w = 0; w < 8; ++w) tot += rb[w];
                    if (tot >= (unsigned)CAP) prefix = cand;
                }
                const unsigned T = prefix;
                const unsigned g0 = u0 > T, g1 = u1 > T, g2 = u2 > T, g3 = u3 > T, q0 = u0 == T, q1 = u1 == T, q2 = u2 == T, q3 = u3 == T;
                const unsigned long long bg0 = __ballot(g0), bg1 = __ballot(g1), bg2 = __ballot(g2), bg3 = __ballot(g3), bq0 = __ballot(q0), bq1 = __ballot(q1), bq2 = __ballot(q2), bq3 = __ballot(q3);
#define MBC(m) __builtin_amdgcn_mbcnt_hi((unsigned)((m) >> 32), __builtin_amdgcn_mbcnt_lo((unsigned)(m), 0u))
                const unsigned pre = (MBC(bg0) + MBC(bg1) + MBC(bg2) + MBC(bg3)) | ((MBC(bq0) + MBC(bq1) + MBC(bq2) + MBC(bq3)) << 16);
#undef MBC
                const unsigned wtot = (unsigned)(__popcll(bg0) + __popcll(bg1) + __popcll(bg2) + __popcll(bg3)) | ((unsigned)(__popcll(bq0) + __popcll(bq1) + __popcll(bq2) + __popcll(bq3)) << 16);
                LAS unsigned* tot8 = red + 16;
                __syncthreads();
                if (lane == 0) tot8[wave] = wtot;
                __syncthreads();
                unsigned woff = 0, all = 0;
#pragma unroll
                for (int w = 0; w < 8; ++w) { const unsigned t = tot8[w]; all += t; woff += (w < wave) ? t : 0u; }
                const unsigned excl = pre + woff;
                int bg = (int)(excl & 0xffffu), be = (int)(excl >> 16); const int ngt = (int)(all & 0xffffu), need = CAP - ngt;
                const size_t rowbase = (size_t)(e * 32 + b) * 256;
                int sl[4]; const unsigned gg[4] = {g0, g1, g2, g3}, qq[4] = {q0, q1, q2, q3}; const float vv[4] = {av.x, av.y, av.z, av.w};
#pragma unroll
                for (int q = 0; q < 4; ++q) { int s = -1;
                    if (gg[q]) s = bg++; else if (qq[q]) { const int r = be++; s = (r < need) ? ngt + r : -1; }
                    sl[q] = s;
                    if (s >= 0) { TOK[rowbase + s] = b * SEQ + 4 * tid + q; GATE[rowbase + s] = vv[q]; }
                    SLOT[((size_t)(b * SEQ + 4 * tid + q)) * 16 + e] = (short)s; }
                __syncthreads();
            }
        }
        PHASE_END(8);

        if (EN_G3 && PHASE_ON()) {
            PHASE_IDS();
              pg8::Gemm g{(const pg8::bf16_t*)H8, (const pg8::bf16_t*)Wgu8, NROWS_E, NE * 4096, DM, TOK}; pg8::GroupedOrder<16> S; S.init(G, bx);
            pg8::EpiSwiGLU8 E{HID8, FF};
            pg8::gemm_phase<pg8::EpiSwiGLU8, pg8::GroupedOrder<16>, true, true, true, true>(ldsl, g, S, E, wave0);
        }
        PHASE_END(9);

        if (EN_G4 && PHASE_ON()) {
            PHASE_IDS();
            pg8::Gemm g{(const pg8::bf16_t*)HID8, (const pg8::bf16_t*)Wd8, NROWS_E, NE * DM, FF, nullptr, GATE}; pg8::GroupedOrder<4> S; S.init(G, bx);
            pg8::EpiDown E{XE8, DM, (const LAS float*)(ldsl + pg8::STAGE_BYTES + 9216), YE_SCALE};
            pg8::gemm_phase<pg8::EpiDown, pg8::GroupedOrder<4>, true, true, true, false, true>(ldsl, g, S, E, wave0);
        }
        PHASE_END(10);
    }

    if (EN_FIN && PHASE_ON()) {
            PHASE_IDS();
        f32x4 g[4];
#pragma unroll
        for (int j = 0; j < 4; ++j) g[j] = ((const f32x4*)args.final_g)[lane + 64 * j];
        const float pscale_ = (PROBE_TYPE >= 0) ? 1.0f + (float)__hip_atomic_load(ctl + 2048, __ATOMIC_RELAXED, __HIP_MEMORY_SCOPE_AGENT) * 5e-6f : 1.0f;
      for (int rbk = vcu; rbk < NTOK / 256; rbk += G) {
        const int mbeg = rbk * 256 + wave, mend = rbk * 256 + 256;
        int sla = (lane < 16) ? (int)SLOT[(size_t)mbeg * 16 + lane] : -1, slb = (lane < 16) ? (int)SLOT[(size_t)(mbeg + 8) * 16 + lane] : -1;
        for (int m = mbeg; m < mend; m += 16) {
            const int m2 = m + 8;
            const int mn = m + 16; int sna = -1, snb = -1;
            if (mn < mend) { sna = (lane < 16) ? (int)SLOT[(size_t)mn * 16 + lane] : -1; snb = (lane < 16) ? (int)SLOT[(size_t)(mn + 8) * 16 + lane] : -1; }
            f32x4* xa = (f32x4*)(XR + (size_t)m * DM) + lane; f32x4* xb = (f32x4*)(XR + (size_t)m2 * DM) + lane; f32x4 va[4], vb[4];
            load_combine2(va, vb, XB + (size_t)m * DM, XB + (size_t)m2 * DM, sla, slb, m >> 11, m2 >> 11, XE8, lane);
            const float ra = row_rstd(va);
#pragma unroll
            for (int j = 0; j < 4; ++j) xa[64 * j] = va[j] * ra * g[j] * pscale_;
            if (m2 != m) {
                const float rb = row_rstd(vb);
#pragma unroll
                for (int j = 0; j < 4; ++j) xb[64 * j] = vb[j] * rb * g[j] * pscale_;
            }
            sla = sna; slb = snb;
        }
      }
    }
#undef PHASE_ON
#undef PHASE_END
}

extern "C" void kernel_launch(void* const* d_in, const int* in_sizes, int n_in, void* d_out, int out_size, void* d_ws, size_t ws_size, hipStream_t stream) {
    static int grid = 0;
    if (grid == 0) {
        if (n_in != 22 || in_sizes[0] != NTOK * DM || out_size != NTOK * DM || ws_size < WS_END) {
            fprintf(stderr, "kernel_launch: shape/workspace mismatch (n_in %d, in0 %d, out %d, ws %zu < %zu)\n", n_in, n_in > 0 ? in_sizes[0] : -1, out_size, ws_size, (size_t)WS_END); grid = -1; return; }
        int dev = 0, cus = 0;
        if (hipGetDevice(&dev) != hipSuccess || hipDeviceGetAttribute(&cus, hipDeviceAttributeMultiprocessorCount, dev) != hipSuccess) { grid = -1; return; }
        if (hipFuncSetAttribute((const void*)mk_fwd, hipFuncAttributeMaxDynamicSharedMemorySize, LDS_BYTES) != hipSuccess) { fprintf(stderr, "kernel_launch: hipFuncSetAttribute failed\n"); grid = -1; return; }
        int per_cu = 0;
        if (hipOccupancyMaxActiveBlocksPerMultiprocessor(&per_cu, (const void*)mk_fwd, NWAVES * 64, LDS_BYTES) != hipSuccess || per_cu < 1) fprintf(stderr, "kernel_launch: occupancy query says %d\n", per_cu);
        (void)hipGetLastError();
        grid = cus;
    }
    if (grid < 0) return;
    (void)hipMemsetAsync((char*)d_ws + WS_CTL, 0, CTL_ZERO_BYTES, stream);
    Args a{};
    const float* const* in = (const float* const*)d_in;
    a.x = in[0]; a.attn_g = in[1]; a.ffn_g = in[2]; a.final_g = in[3];
    for (int l = 0; l < 4; ++l) {
        const int m = l % 3, j = l / 3;
        a.w_in[l] = m == 0 ? in[4] + (size_t)j * DM * 3072 : (m == 1 ? in[11] + (size_t)j * DM * 1536 : in[15] + (size_t)j * DM * 1536);
        a.w_o[l] = m == 0 ? in[5] + (size_t)j * DM * DM : (m == 1 ? in[12] + (size_t)j * DM * DM : in[16] + (size_t)j * DM * DM);
        a.lq1[l] = in[6] + j * 64; a.lk1[l] = in[7] + j * 64; a.lq2[l] = in[8] + j * 64; a.lk2[l] = in[9] + j * 64; a.subln[l] = in[10] + j * 128;
        a.qn[l] = in[13]; a.kn[l] = in[14]; a.sinks[l] = in[17];
        if (m != 0) { a.lq1[l] = in[6]; a.lk1[l] = in[7]; a.lq2[l] = in[8]; a.lk2[l] = in[9]; a.subln[l] = in[10]; }
    }
    a.w_router = in[18]; a.w_gate = in[19]; a.w_up = in[20]; a.w_down = in[21];
    a.out = (float*)d_out; a.ws = (unsigned char*)d_ws;
    hipLaunchKernelGGL(mk_fwd, dim3(grid), dim3(NWAVES * 64), LDS_BYTES, stream, a);
    const hipError_t le = hipPeekAtLastError();
    if (le != hipSuccess) fprintf(stderr, "kernel_launch: launch failed: %s\n", hipGetErrorName(le));
}
```

```cpp
#include <hip/hip_runtime.h>
#include <cstdio>
#include <cstdint>
#include <hip/hip_bf16.h>
#ifndef PROBE_TYPE
#define PROBE_TYPE (-1)
#endif
__device__ __forceinline__ int fresh_lane() { unsigned ones = ~0u; asm volatile("" : "+s"(ones)); return (int)__builtin_amdgcn_mbcnt_hi(ones, __builtin_amdgcn_mbcnt_lo(ones, 0u)); }
__device__ __forceinline__ int fresh_tid(int wv) { asm volatile("" : "+s"(wv)); return (wv << 6) | fresh_lane(); }
__device__ __forceinline__ float dpp_xor1(float v) { return __uint_as_float((unsigned)__builtin_amdgcn_update_dpp(0, (int)__float_as_uint(v), 0xB1, 0xF, 0xF, true)); }
__device__ __forceinline__ float dpp_xor2(float v) { return __uint_as_float((unsigned)__builtin_amdgcn_update_dpp(0, (int)__float_as_uint(v), 0x4E, 0xF, 0xF, true)); }
__device__ __forceinline__ float dpp_hmirror(float v) { return __uint_as_float((unsigned)__builtin_amdgcn_update_dpp(0, (int)__float_as_uint(v), 0x141, 0xF, 0xF, true)); }
__device__ __forceinline__ float dpp_mirror(float v) { return __uint_as_float((unsigned)__builtin_amdgcn_update_dpp(0, (int)__float_as_uint(v), 0x140, 0xF, 0xF, true)); }
__device__ __forceinline__ float dpp_ror4(float v) { return __uint_as_float((unsigned)__builtin_amdgcn_update_dpp(0, (int)__float_as_uint(v), 0x124, 0xF, 0xF, true)); }
__device__ __forceinline__ float dpp_ror8(float v) { return __uint_as_float((unsigned)__builtin_amdgcn_update_dpp(0, (int)__float_as_uint(v), 0x128, 0xF, 0xF, true)); }
__device__ __forceinline__ float sum_swap16(float v) { auto r = __builtin_amdgcn_permlane16_swap(__float_as_uint(v), __float_as_uint(v), false, false); return __uint_as_float(r[0]) + __uint_as_float(r[1]); }
__device__ __forceinline__ float sum_swap32(float v) { auto r = __builtin_amdgcn_permlane32_swap(__float_as_uint(v), __float_as_uint(v), false, false); return __uint_as_float(r[0]) + __uint_as_float(r[1]); }
__device__ __forceinline__ float sum16(float v) { v += dpp_xor1(v); v += dpp_xor2(v); v += dpp_hmirror(v); v += dpp_mirror(v); return v; }
__device__ __forceinline__ float sum32(float v) { return sum_swap16(sum16(v)); }
__device__ __forceinline__ float sum64(float v) { return sum_swap32(sum32(v)); }
namespace pg8 {
#define PG8_LAS __attribute__((address_space(3)))
typedef unsigned short bf16_t;
typedef short bf16x8 __attribute__((ext_vector_type(8)));
typedef float f32x4 __attribute__((ext_vector_type(4)));
typedef unsigned u32x4 __attribute__((ext_vector_type(4)));
constexpr int BM = 256, BK = 64, HALF = 128, HTB = HALF * BK * 2  , STAGE_BYTES = 8 * HTB, NXCD = 8, WGM = 8;

__host__ __device__ __forceinline__ int lds_byte(int r, int c) { const int st = (r >> 4) * 2 + (c >> 5), rr = r & 15, cc = c & 31, ob = rr * 64 + cc * 2; return st * 1024 + (ob ^ (((ob >> 9) & 1) << 5)); }
__host__ __device__ __forceinline__ void stage_rc(int b, int& R, int& C) { const int st = b / 1024, sb = b % 1024, swz = sb ^ (((sb >> 9) & 1) << 5); R = (st >> 1) * 16 + swz / 64; C = (st & 1) * 32 + (swz % 64) / 2; }
__host__ __device__ __forceinline__ int perm32(int rho) { const int n = rho >> 4, i = rho & 15; return 8 * (i >> 2) + 4 * n + (i & 3); }

struct Unit { int pm, pn, par; };
struct Gemm { const bf16_t* A; const bf16_t* Bt; int M, N, K; const int* tok = nullptr; const float* rowv = nullptr; };

struct StaticOrder {
    int nM, nN, nwg, G, c;
    __host__ __device__ void init(int M, int N, int G_, int c_) { nM = M / BM; nN = N / BM; nwg = nM * nN; G = G_; c = c_; }
    __host__ __device__ bool next(int i, Unit& u) const {
        const long L = (long)i * G + c; if (L >= nwg) return false;
        int wgid = (int)L; { const int q = nwg / NXCD, r = nwg % NXCD, xcd = wgid % NXCD, off = wgid / NXCD; wgid = (xcd < r ? xcd * (q + 1) : r * (q + 1) + (xcd - r) * q) + off; }
        const int nig = WGM * nN, gid = wgid / nig, fm = gid * WGM, gsz = (nM - fm) < WGM ? (nM - fm) : WGM;
        u.pm = fm + ((wgid % nig) % gsz); u.pn = (wgid % nig) / gsz; return true;
    }
    __device__ __forceinline__ void a_ready(const Unit&) const {}
    __device__ __forceinline__ void done(const Unit&) const {}
};


template <int NNL> struct GroupedOrder {
    int G, c, nunits;
    __device__ void init(int G_, int c_) { G = G_; c = c_; nunits = 16 * 32 * NNL; }
    __device__ bool next(int i, Unit& u) const {
        const int L = i * G + c; if (L >= nunits) return false;
        if (G == 256) {
            const int x = c & 7, j = c >> 3;
            if (NNL == 16) { const int e = i >> 1, hh = i & 1; u.pm = e * 32 + 4 * x + (j & 3); u.pn = e * 16 + 8 * hh + (j >> 2); }
            else { const int e = 2 * i + (j >> 4); u.pm = e * 32 + 4 * x + (j & 3); u.pn = e * NNL + ((j >> 2) & 3); }
        } else { const int pmg = L / NNL; u.pm = pmg; u.pn = (pmg >> 5) * NNL + (L % NNL); }
        return true;
    }
    __device__ __forceinline__ void a_ready(const Unit&) const {}
    __device__ __forceinline__ void done(const Unit&) const {}
};

__device__ __forceinline__ unsigned cvt_pk_bf16(float lo, float hi) { unsigned r; asm volatile("v_cvt_pk_bf16_f32 %0, %1, %2" : "=v"(r) : "v"(lo), "v"(hi)); return r; }

struct EpiQKV {
    static constexpr bool PERM = true, AFTER_DRAIN = false;
    bf16_t* O; int ldc; const float* tcos; const float* tsin; int nrope, nq; const PG8_LAS float* qg; const PG8_LAS float* kg; float qscale; const float* rstd;
    __device__ __forceinline__ void operator()(const f32x4 (&acc)[2][2][4][2], const Unit& u, int wr, int wc, int fr, int fq) const {
        const int row0 = u.pm * BM + wr * 64 + fr, col0 = u.pn * BM + wc * 64 + 8 * fq;
        const bool rope = u.pn < nrope; const float sc = (u.pn < nq) ? qscale : 1.0f;
        const PG8_LAS float* gp = (u.pn < nq) ? qg : kg;
        float rs[2][4];
#pragma unroll
        for (int ai = 0; ai < 2; ++ai)
#pragma unroll
            for (int m = 0; m < 4; ++m) rs[ai][m] = rstd[row0 + ai * HALF + m * 16];
        f32x4 gv[2][2];
        if (rope && gp) {
#pragma unroll
            for (int bj = 0; bj < 2; ++bj)
#pragma unroll
                for (int n = 0; n < 2; ++n) gv[bj][n] = *(const PG8_LAS f32x4*)(gp + 32 * bj + 8 * fq + 4 * n);
        }
#pragma unroll
        for (int ai = 0; ai < 2; ++ai)
#pragma unroll
            for (int m = 0; m < 4; ++m) {
                const int row = row0 + ai * HALF + m * 16;
                f32x4 v[2][2];
#pragma unroll
                for (int bj = 0; bj < 2; ++bj)
#pragma unroll
                    for (int n = 0; n < 2; ++n) v[bj][n] = acc[ai][bj][m][n] * rs[ai][m];
                if (rope) {
                    if (gp) {
                        float ss = 0.f;
#pragma unroll
                        for (int bj = 0; bj < 2; ++bj)
#pragma unroll
                            for (int n = 0; n < 2; ++n) ss += (v[bj][n][0] * v[bj][n][0] + v[bj][n][1] * v[bj][n][1]) + (v[bj][n][2] * v[bj][n][2] + v[bj][n][3] * v[bj][n][3]);
                        ss = sum_swap32(sum_swap16(ss));
                        const float rstd = __builtin_amdgcn_rsqf(ss * (1.0f / 64.0f) + 1e-6f);
#pragma unroll
                        for (int bj = 0; bj < 2; ++bj)
#pragma unroll
                            for (int n = 0; n < 2; ++n) v[bj][n] = v[bj][n] * rstd * gv[bj][n];
                    }
                    const int s = row & 2047;
#pragma unroll
                    for (int n = 0; n < 2; ++n) {
                        const f32x4 c = *(const f32x4*)(tcos + s * 32 + 8 * fq + 4 * n), sn = *(const f32x4*)(tsin + s * 32 + 8 * fq + 4 * n);
                        const f32x4 x1 = v[0][n], x2 = v[1][n];
                        v[0][n] = x1 * c - x2 * sn; v[1][n] = x2 * c + x1 * sn;
                    }
                }
                bf16_t* rowp = O + (size_t)row * ldc + col0;
#pragma unroll
                for (int bj = 0; bj < 2; ++bj) { const f32x4 v0 = v[bj][0] * sc, v1 = v[bj][1] * sc;
                    u32x4 w; w.x = cvt_pk_bf16(v0[0], v0[1]); w.y = cvt_pk_bf16(v0[2], v0[3]); w.z = cvt_pk_bf16(v1[0], v1[1]); w.w = cvt_pk_bf16(v1[2], v1[3]);
                    *(u32x4*)(rowp + bj * 32) = w; }
            }
    }
};
struct EpiResBf16 {
    static constexpr bool PERM = true, AFTER_DRAIN = false;
    bf16_t* X; int ldc;
    __device__ __forceinline__ void operator()(const f32x4 (&acc)[2][2][4][2], const Unit& u, int wr, int wc, int fr, int fq) const {
        const int row0 = u.pm * BM + wr * 64 + fr, col0 = u.pn * BM + wc * 32 + 8 * fq;
        u32x4 ball[2][4][2];
#pragma unroll
        for (int ai = 0; ai < 2; ++ai)
#pragma unroll
            for (int m = 0; m < 4; ++m)
#pragma unroll
                for (int bj = 0; bj < 2; ++bj) ball[ai][m][bj] = *(const u32x4*)(X + (size_t)(row0 + ai * HALF + m * 16) * ldc + col0 + bj * HALF);
        asm volatile("" ::: "memory");
#pragma unroll
        for (int ai = 0; ai < 2; ++ai)
#pragma unroll
            for (int m = 0; m < 4; ++m) { bf16_t* rowp = X + (size_t)(row0 + ai * HALF + m * 16) * ldc + col0;
#pragma unroll
                for (int bj = 0; bj < 2; ++bj) { const f32x4 a0 = acc[ai][bj][m][0], a1 = acc[ai][bj][m][1]; const u32x4 x = ball[ai][m][bj];
                    u32x4 w;
                    w.x = cvt_pk_bf16(a0[0] + __uint_as_float(x.x << 16), a0[1] + __uint_as_float(x.x & 0xffff0000u));
                    w.y = cvt_pk_bf16(a0[2] + __uint_as_float(x.y << 16), a0[3] + __uint_as_float(x.y & 0xffff0000u));
                    w.z = cvt_pk_bf16(a1[0] + __uint_as_float(x.z << 16), a1[1] + __uint_as_float(x.z & 0xffff0000u));
                    w.w = cvt_pk_bf16(a1[2] + __uint_as_float(x.w << 16), a1[3] + __uint_as_float(x.w & 0xffff0000u));
                    *(u32x4*)(rowp + bj * HALF) = w; }
            }
    }
};
struct EpiSwiGLU {
    static constexpr bool PERM = true, AFTER_DRAIN = false;
    bf16_t* O; int ldc;
    __device__ __forceinline__ void operator()(const f32x4 (&acc)[2][2][4][2], const Unit& u, int wr, int wc, int fr, int fq) const {
        const int row0 = u.pm * BM + wr * 64 + fr, col0 = (u.pn & 15) * HALF + wc * 32 + 8 * fq;
#pragma unroll
        for (int ai = 0; ai < 2; ++ai)
#pragma unroll
            for (int m = 0; m < 4; ++m) { bf16_t* rowp = O + (size_t)(row0 + ai * HALF + m * 16) * ldc + col0;
                f32x4 h[2];
#pragma unroll
                for (int n = 0; n < 2; ++n) { const f32x4 g = acc[ai][0][m][n], up = acc[ai][1][m][n];
#pragma unroll
                    for (int j = 0; j < 4; ++j) { const float e = __builtin_amdgcn_exp2f(g[j] * -1.4426950408889634f); h[n][j] = g[j] * __builtin_amdgcn_rcpf(1.0f + e) * up[j]; } }
                u32x4 w; w.x = cvt_pk_bf16(h[0][0], h[0][1]); w.y = cvt_pk_bf16(h[0][2], h[0][3]); w.z = cvt_pk_bf16(h[1][0], h[1][1]); w.w = cvt_pk_bf16(h[1][2], h[1][3]);
                *(u32x4*)rowp = w; }
    }
};
__device__ __forceinline__ unsigned cvt4_fp8(float a, float b, float c, float d) { int r = __builtin_amdgcn_cvt_pk_fp8_f32(a, b, 0, false); r = __builtin_amdgcn_cvt_pk_fp8_f32(c, d, r, true); return (unsigned)r; }
constexpr float W8_SCALE = 32.0f, W8_INV = 1.0f / 32.0f;
struct EpiSwiGLU8 {
    static constexpr bool PERM = true, AFTER_DRAIN = false;
    unsigned char* O; int ldc;
    __device__ __forceinline__ void operator()(const f32x4 (&acc)[2][2][4][2], const Unit& u, int wr, int wc, int fr, int fq) const {
        const int row0 = u.pm * BM + wr * 64 + fr + 16 * (fq & 1), col0 = (u.pn & 15) * HALF + wc * 32 + 16 * (fq >> 1);
        typedef unsigned u32x2 __attribute__((ext_vector_type(2)));
#pragma unroll
        for (int ai = 0; ai < 2; ++ai)
#pragma unroll
            for (int mp = 0; mp < 4; mp += 2) { unsigned char* rowp = O + (size_t)(row0 + ai * HALF + mp * 16) * ldc + col0;
                u32x2 w[2];
#pragma unroll
                for (int k = 0; k < 2; ++k) { const int m = mp + k;
                    f32x4 h[2];
#pragma unroll
                    for (int n = 0; n < 2; ++n) { const f32x4 g = acc[ai][0][m][n], up = acc[ai][1][m][n];
                        const f32x4 t = g * -1.4426950408889634f, gu = g * up;
                        f32x4 e; e[0] = __builtin_amdgcn_exp2f(t[0]); e[1] = __builtin_amdgcn_exp2f(t[1]); e[2] = __builtin_amdgcn_exp2f(t[2]); e[3] = __builtin_amdgcn_exp2f(t[3]);
                        const f32x4 d = e + 1.0f;
                        f32x4 r; r[0] = __builtin_amdgcn_rcpf(d[0]); r[1] = __builtin_amdgcn_rcpf(d[1]); r[2] = __builtin_amdgcn_rcpf(d[2]); r[3] = __builtin_amdgcn_rcpf(d[3]);
                        h[n] = gu * r; }
                    w[k].x = cvt4_fp8(h[0][0], h[0][1], h[0][2], h[0][3]); w[k].y = cvt4_fp8(h[1][0], h[1][1], h[1][2], h[1][3]); }
                const auto sx = __builtin_amdgcn_permlane16_swap(w[0].x, w[1].x, false, false), sy = __builtin_amdgcn_permlane16_swap(w[0].y, w[1].y, false, false);
                u32x4 o; o.x = sx[0]; o.y = sy[0]; o.z = sx[1]; o.w = sy[1];
                *(u32x4*)rowp = o; }
    }
};
struct EpiDown {
    static constexpr bool PERM = true, AFTER_DRAIN = false;
    unsigned char* O; int ldc; const PG8_LAS float* gate; float osc;
    __device__ __forceinline__ void operator()(const f32x4 (&acc)[2][2][4][2], const Unit& u, int wr, int wc, int fr, int fq) const {
        const int row0 = u.pm * BM + wr * 64 + fr, col0 = (u.pn & 3) * BM + wc * 64 + 16 * (fq >> 1) + 32 * (fq & 1);
        typedef unsigned u32x2 __attribute__((ext_vector_type(2)));
#pragma unroll
        for (int ai = 0; ai < 2; ++ai)
#pragma unroll
            for (int m = 0; m < 4; ++m) { const int row = row0 + ai * HALF + m * 16; const float gt = gate[u.par * 512 + (row & 255)] * osc; unsigned char* rowp = O + (size_t)row * ldc + col0;
                u32x2 w[2];
#pragma unroll
                for (int bj = 0; bj < 2; ++bj) { const f32x4 v0 = acc[ai][bj][m][0] * gt, v1 = acc[ai][bj][m][1] * gt;
                    w[bj].x = cvt4_fp8(v0[0], v0[1], v0[2], v0[3]); w[bj].y = cvt4_fp8(v1[0], v1[1], v1[2], v1[3]); }
                const auto sx = __builtin_amdgcn_permlane16_swap(w[0].x, w[1].x, false, false), sy = __builtin_amdgcn_permlane16_swap(w[0].y, w[1].y, false, false);
                u32x4 o; o.x = sx[0]; o.y = sy[0]; o.z = sx[1]; o.w = sy[1];
                *(u32x4*)rowp = o; }
    }
};


__device__ __forceinline__ void glds16s(const char* gbase, unsigned voff, unsigned lds_dst) {
    unsigned keep; const unsigned dst = __builtin_amdgcn_readfirstlane(lds_dst);
    asm volatile("s_mov_b32 %0, m0\n\ts_mov_b32 m0, %3\n\ts_nop 0\n\tglobal_load_lds_dwordx4 %1, %2\n\ts_mov_b32 m0, %0" : "=&s"(keep) : "v"(voff), "s"(gbase), "s"(dst) : "memory");
}
__device__ __forceinline__ void glds4s(const char* gbase, unsigned voff, unsigned lds_dst) {
    unsigned keep; const unsigned dst = __builtin_amdgcn_readfirstlane(lds_dst);
    asm volatile("s_mov_b32 %0, m0\n\ts_mov_b32 m0, %3\n\ts_nop 0\n\tglobal_load_lds_dword %1, %2\n\ts_mov_b32 m0, %0" : "=&s"(keep) : "v"(voff), "s"(gbase), "s"(dst) : "memory");
}
typedef int i32x4 __attribute__((ext_vector_type(4)));
typedef int i32x8 __attribute__((ext_vector_type(8)));
template <class Epi, class Sched, bool ALIGN_EPI = false, bool SP2 = false, bool F8 = false, bool GATHER = false, bool ROWV = false>
__device__ __forceinline__ void gemm_phase(PG8_LAS unsigned char* lds, const Gemm g, const Sched& S, const Epi& E, int wv) {
    const int tid = fresh_tid(wv), wid = __builtin_amdgcn_readfirstlane(tid >> 6), lane = tid & 63, wr = wid >> 2, wc = wid & 3, fr = lane & 15, fq = lane >> 4;
    const int K = F8 ? g.K / 2 : g.K, nt = K / BK;
    unsigned voffA[2], voffB[2];
#pragma unroll
    for (int i = 0; i < 2; ++i) { int R, C; stage_rc(tid * 16 + i * 8192, R, C); const int Rb = Epi::PERM ? ((R & ~31) + perm32(R & 31)) : R;
        voffA[i] = (unsigned)(R * K + C) * 2u; voffB[i] = (unsigned)(Rb * K + C) * 2u; }
    const size_t kstep = (size_t)(BK * 2);
    const size_t hstep = (size_t)HALF * K * 2;
    const size_t tstep = 2 * hstep;
    static_assert(!GATHER || SP2, "GATHER is written for the SP2 K-loop");
    static_assert(!ROWV || (SP2 && !GATHER), "ROWV is written for the SP2 K-loop without GATHER");
    const size_t hstepA = GATHER ? 0 : hstep, tstepA = GATHER ? 0 : tstep;
    const unsigned rowb = (unsigned)K * 2u;
    const unsigned ldsw = (unsigned)wid * 1024u;
    const int aoff = lds_byte(wr * 64 + fr, fq * 8), boff = lds_byte(wc * 32 + fr, fq * 8);
#define PG8_SA(b, h) (((b) * 2 + (h)) * HTB)
#define PG8_SB(b, h) ((4 + (b) * 2 + (h)) * HTB)
    int sc8 = 0x7f7f7a7a; asm volatile("" : "+v"(sc8));
    const unsigned ldsb = (unsigned)(uintptr_t)lds;
#define PG8_STAGE(bufoff, gbase, voff) do { _Pragma("unroll") for (int _i = 0; _i < 2; ++_i) \
        glds16s((const char*)(gbase), (voff)[_i], ldsb + (unsigned)(bufoff) + ldsw + (unsigned)(_i * 8192)); } while (0)
#define PG8_LDA(dst, b, h) do { _Pragma("unroll") for (int m = 0; m < 4; ++m) _Pragma("unroll") for (int k = 0; k < 2; ++k) dst[m][k] = *(const PG8_LAS bf16x8*)(lds + PG8_SA(b, h) + aoff + m * 2048 + k * 1024); } while (0)
#define PG8_LDB(dst, b, h) do { _Pragma("unroll") for (int n = 0; n < 2; ++n) _Pragma("unroll") for (int k = 0; k < 2; ++k) dst[n][k] = *(const PG8_LAS bf16x8*)(lds + PG8_SB(b, h) + boff + n * 2048 + k * 1024); } while (0)
#define PG8_CAT(x) __builtin_shufflevector(__builtin_bit_cast(i32x4, (x)[0]), __builtin_bit_cast(i32x4, (x)[1]), 0, 1, 2, 3, 4, 5, 6, 7)
#define PG8_MMA(ai, bj, At, Bt) do { __builtin_amdgcn_s_setprio(1); _Pragma("unroll") for (int m = 0; m < 4; ++m) _Pragma("unroll") for (int n = 0; n < 2; ++n) { \
        if constexpr (F8) acc[ai][bj][m][n] = __builtin_amdgcn_mfma_scale_f32_16x16x128_f8f6f4(PG8_CAT(Bt[n]), PG8_CAT(At[m]), acc[ai][bj][m][n], 0, 0, 0, sc8, 2, sc8); \
        else { _Pragma("unroll") for (int k = 0; k < 2; ++k) acc[ai][bj][m][n] = __builtin_amdgcn_mfma_f32_16x16x32_bf16(Bt[n][k], At[m][k], acc[ai][bj][m][n], 0, 0, 0); } } __builtin_amdgcn_s_setprio(0); } while (0)
#define PG8_WAIT_V(n) asm volatile("s_waitcnt vmcnt(" #n ")" ::: "memory")
#define PG8_WAIT_L(n) asm volatile("s_waitcnt lgkmcnt(" #n ")" ::: "memory")
#define PG8_BAR __builtin_amdgcn_s_barrier()
#define PG8_SCHED __builtin_amdgcn_sched_barrier(0)
    Unit cur, nxt; int ui = 0;
    if (!S.next(0, cur)) return;
    f32x4 acc[2][2][4][2];
    float zacc_ = 0.f; asm volatile("" : "+v"(zacc_));
#pragma unroll
    for (int a = 0; a < 2; ++a)
#pragma unroll
        for (int b = 0; b < 2; ++b)
#pragma unroll
            for (int m = 0; m < 4; ++m)
#pragma unroll
                for (int n = 0; n < 2; ++n) acc[a][b][m][n] = (f32x4){zacc_, zacc_, zacc_, zacc_};
    bf16x8 At[4][2], B0[2][2], B1[2][2];
    const char* cA = (const char*)g.A + (size_t)cur.pm * tstepA; const char* cB = (const char*)g.Bt + (size_t)cur.pn * tstep;
    S.a_ready(cur);
    unsigned cv[2][2], sv[2][2];
    const PG8_LAS unsigned* tokl = (const PG8_LAS unsigned*)(lds + STAGE_BYTES + 1024) + wid * 256 + lane;
    if constexpr (GATHER) {
#pragma unroll
        for (int h = 0; h < 2; ++h)
#pragma unroll
            for (int i = 0; i < 2; ++i) { cv[h][i] = (unsigned)g.tok[cur.pm * BM + h * HALF + (int)(voffA[i] / rowb)] * rowb + (voffA[i] & (rowb - 1u)); sv[h][i] = cv[h][i]; }
    }
#define PG8_STAGEA(bufoff, gbase, h, nx) do { unsigned v0_, v1_; if constexpr (GATHER) { v0_ = (nx) ? sv[h][0] : cv[h][0]; v1_ = (nx) ? sv[h][1] : cv[h][1]; } else { v0_ = voffA[0]; v1_ = voffA[1]; } \
        glds16s((const char*)(gbase), v0_, ldsb + (unsigned)(bufoff) + ldsw); glds16s((const char*)(gbase), v1_, ldsb + (unsigned)(bufoff) + ldsw + 8192u); } while (0)
    if constexpr (SP2) {
        PG8_STAGE(PG8_SB(0, 0), cB, voffB); PG8_STAGE(PG8_SB(0, 1), cB + hstep, voffB); PG8_STAGEA(PG8_SA(0, 0), cA, 0, false); PG8_STAGEA(PG8_SA(0, 1), cA + hstepA, 1, false);
        if (wr == 1) PG8_BAR;
        PG8_WAIT_V(2); PG8_BAR;
        PG8_STAGE(PG8_SB(1, 0), cB + kstep, voffB); PG8_STAGEA(PG8_SA(1, 0), cA + kstep, 0, false); PG8_STAGE(PG8_SB(1, 1), cB + hstep + kstep, voffB);
        PG8_WAIT_V(6); PG8_BAR;
    } else {
        PG8_STAGE(PG8_SB(0, 0), cB, voffB); PG8_STAGE(PG8_SA(0, 0), cA, voffA); PG8_STAGE(PG8_SB(0, 1), cB + hstep, voffB); PG8_STAGE(PG8_SA(0, 1), cA + hstep, voffA);
        if (wr == 1) PG8_BAR;
        PG8_WAIT_V(4); PG8_BAR;
        PG8_STAGE(PG8_SB(1, 0), cB + kstep, voffB); PG8_STAGE(PG8_SA(1, 0), cA + kstep, voffA); PG8_STAGE(PG8_SB(1, 1), cB + hstep + kstep, voffB);
        PG8_WAIT_V(6); PG8_BAR;
    }
    for (;;) {
        const bool has_next = S.next(ui + 1, nxt);
        const char* nA = has_next ? (const char*)g.A + (size_t)nxt.pm * tstepA : cA; const char* nB = has_next ? (const char*)g.Bt + (size_t)nxt.pn * tstep : cB;
#pragma unroll 1
        for (int t = 0; t < nt; t += 2) {
            const bool last = (t == nt - 2);
            const char* a1 = cA + (size_t)(t + 1) * kstep;
            const char* a2 = last ? nA : cA + (size_t)(t + 2) * kstep; const char* b2 = last ? nB : cB + (size_t)(t + 2) * kstep;
            const char* a3 = a2 + kstep; const char* b3 = b2 + kstep;
            if (last && has_next) S.a_ready(nxt);
            if constexpr (GATHER) {
                if (last && has_next) {
                    asm volatile("" ::: "memory");
#pragma unroll
                    for (int h = 0; h < 2; ++h)
#pragma unroll
                        for (int i = 0; i < 2; ++i) sv[h][i] = tokl[(h * 2 + i) * 64] * rowb + (voffA[i] & (rowb - 1u));
                    asm volatile("" : "+v"(sv[0][0]), "+v"(sv[0][1]), "+v"(sv[1][0]), "+v"(sv[1][1]) :: "memory");
                }
            }
            if constexpr (SP2) {
            PG8_LDB(B0, 0, 0); PG8_LDB(B1, 0, 1); PG8_SCHED; PG8_LDA(At, 0, 0);
            if (GATHER && t == 0 && has_next) {
#pragma unroll
                for (int h = 0; h < 2; ++h)
#pragma unroll
                    for (int i = 0; i < 2; ++i) glds4s((const char*)g.tok, (unsigned)(nxt.pm * BM + h * HALF + (int)(voffA[i] / rowb)) * 4u, ldsb + (unsigned)STAGE_BYTES + 1024u + (unsigned)wid * 1024u + (unsigned)(h * 2 + i) * 256u);
                PG8_STAGEA(PG8_SA(1, 1), a1 + hstepA, 1, false);
                PG8_WAIT_V(12);
            } else if (ROWV && t == 0) {
                glds4s((const char*)g.rowv, (unsigned)(cur.pm * BM + (wid & 3) * 64 + lane) * 4u, ldsb + (unsigned)STAGE_BYTES + 9216u + (unsigned)(ui & 1) * 2048u + (unsigned)wid * 256u);
                PG8_STAGEA(PG8_SA(1, 1), a1 + hstepA, 1, false);
                PG8_WAIT_V(9);
            } else {
                PG8_STAGEA(PG8_SA(1, 1), a1 + hstepA, 1, false);
                PG8_WAIT_V(8);
            }
            PG8_WAIT_L(0); PG8_BAR; PG8_MMA(0, 0, At, B0); PG8_MMA(0, 1, At, B1); PG8_BAR; PG8_SCHED;
            PG8_LDA(At, 0, 1); PG8_STAGE(PG8_SB(0, 0), b2, voffB); PG8_STAGE(PG8_SB(0, 1), b2 + hstep, voffB); PG8_STAGEA(PG8_SA(0, 0), a2, 0, true);
            PG8_WAIT_V(8); PG8_WAIT_L(0); PG8_BAR; PG8_MMA(1, 0, At, B0); PG8_MMA(1, 1, At, B1); PG8_BAR; PG8_SCHED;
            PG8_LDB(B0, 1, 0); PG8_LDB(B1, 1, 1); PG8_SCHED; PG8_LDA(At, 1, 0); PG8_STAGEA(PG8_SA(0, 1), a2 + hstepA, 1, true);
            PG8_WAIT_V(8); PG8_WAIT_L(0); PG8_BAR; PG8_MMA(0, 0, At, B0); PG8_MMA(0, 1, At, B1); PG8_BAR; PG8_SCHED;
            PG8_LDA(At, 1, 1); PG8_STAGE(PG8_SB(1, 0), b3, voffB); PG8_STAGE(PG8_SB(1, 1), b3 + hstep, voffB); PG8_STAGEA(PG8_SA(1, 0), a3, 0, true);
            PG8_WAIT_V(8); PG8_WAIT_L(0); PG8_BAR; PG8_MMA(1, 0, At, B0); PG8_MMA(1, 1, At, B1); PG8_BAR; PG8_SCHED;
            } else {
            PG8_LDB(B0, 0, 0); PG8_SCHED; PG8_LDA(At, 0, 0); PG8_STAGE(PG8_SA(1, 1), a1 + hstep, voffA);
            PG8_WAIT_L(8); PG8_BAR; PG8_WAIT_L(0); PG8_MMA(0, 0, At, B0); PG8_BAR; PG8_SCHED;
            PG8_LDB(B1, 0, 1); PG8_STAGE(PG8_SB(0, 0), b2, voffB);
            PG8_BAR; PG8_WAIT_L(0); PG8_MMA(0, 1, At, B1); PG8_BAR;
            PG8_LDA(At, 0, 1); PG8_STAGE(PG8_SA(0, 0), a2, voffA);
            PG8_BAR; PG8_WAIT_L(0); PG8_MMA(1, 0, At, B0); PG8_BAR; PG8_SCHED;
            PG8_STAGE(PG8_SB(0, 1), b2 + hstep, voffB);
            PG8_WAIT_V(6); PG8_BAR; PG8_MMA(1, 1, At, B1); PG8_BAR;
            PG8_LDB(B0, 1, 0); PG8_SCHED; PG8_LDA(At, 1, 0); PG8_STAGE(PG8_SA(0, 1), a2 + hstep, voffA);
            PG8_WAIT_L(8); PG8_BAR; PG8_WAIT_L(0); PG8_MMA(0, 0, At, B0); PG8_BAR; PG8_SCHED;
            PG8_LDB(B1, 1, 1); PG8_STAGE(PG8_SB(1, 0), b3, voffB);
            PG8_BAR; PG8_WAIT_L(0); PG8_MMA(0, 1, At, B1); PG8_BAR;
            PG8_LDA(At, 1, 1); PG8_STAGE(PG8_SA(1, 0), a3, voffA);
            PG8_BAR; PG8_WAIT_L(0); PG8_MMA(1, 0, At, B0); PG8_BAR; PG8_SCHED;
            PG8_STAGE(PG8_SB(1, 1), b3 + hstep, voffB);
            PG8_WAIT_V(6); PG8_BAR; PG8_MMA(1, 1, At, B1); PG8_BAR;
            }
        }
        if constexpr (ALIGN_EPI) { if (wr == 0) PG8_BAR; }
        cur.par = ui & 1;
        if constexpr (!Epi::AFTER_DRAIN) { const int l_ = fresh_lane(); E(acc, cur, wr, wc, l_ & 15, l_ >> 4); S.done(cur); }
        if (!has_next) break;
#pragma unroll
        for (int a = 0; a < 2; ++a)
#pragma unroll
            for (int b = 0; b < 2; ++b)
#pragma unroll
                for (int m = 0; m < 4; ++m)
#pragma unroll
                    for (int n = 0; n < 2; ++n) acc[a][b][m][n] = (f32x4){zacc_, zacc_, zacc_, zacc_};
        cur = nxt; cA = nA; cB = nB; ++ui;
        if constexpr (GATHER) { cv[0][0] = sv[0][0]; cv[0][1] = sv[0][1]; cv[1][0] = sv[1][0]; cv[1][1] = sv[1][1]; }
        if constexpr (ALIGN_EPI) { if (wr == 1) PG8_BAR; }
    }
    PG8_WAIT_V(0);
    if constexpr (!ALIGN_EPI) { if (wr == 0) PG8_BAR; }
    PG8_BAR;
    if constexpr (Epi::AFTER_DRAIN) { E.fused(acc, cur, wr, wc, fr, fq, lds, wid, lane); S.done(cur); }
#undef PG8_SA
#undef PG8_SB
#undef PG8_STAGEA
#undef PG8_STAGE
#undef PG8_LDA
#undef PG8_LDB
#undef PG8_MMA
#undef PG8_CAT
#undef PG8_WAIT_V
#undef PG8_WAIT_L
#undef PG8_BAR
#undef PG8_SCHED
}
}


namespace att {
using bf16 = unsigned short;
using bf16x8 = __attribute__((ext_vector_type(8))) short;
using s16x4  = __attribute__((ext_vector_type(4))) short;
using f32x16 = __attribute__((ext_vector_type(16))) float;
using u32x4  = __attribute__((ext_vector_type(4))) unsigned;
constexpr int KVBLK = 64;
constexpr float THR = 8.f;
constexpr int SHM_K = KVBLK * 64 * 2;
#define ATT_KSWZ(row, colB) ((row) * 128 + ((colB) ^ ((((row) >> 1) & 7) << 4)))
#define ATT_SBAR() __builtin_amdgcn_sched_barrier(0)
__device__ __forceinline__ int crow(int r, int hi) { return (r & 3) + 8 * (r >> 2) + 4 * hi; }
__device__ __forceinline__ unsigned cvtpk(float lo, float hi) { unsigned r; asm volatile("v_cvt_pk_bf16_f32 %0, %1, %2" : "=v"(r) : "v"(lo), "v"(hi)); return r; }

__device__ __forceinline__ void partialSM(f32x16& p0, f32x16& p1, float& m_reg, float& mn, float& alpha) {
  float pmax = p0[0];
#pragma unroll
  for (int r = 1; r < 16; ++r) pmax = fmaxf(pmax, p0[r]);
#pragma unroll
  for (int r = 0; r < 16; ++r) pmax = fmaxf(pmax, p1[r]);
  { auto rr = __builtin_amdgcn_permlane32_swap(__float_as_uint(pmax), __float_as_uint(pmax), false, false);
    pmax = fmaxf(__uint_as_float(rr[0]), __uint_as_float(rr[1])); }
  if (__builtin_expect(__all(pmax - m_reg <= THR), 1)) { mn = m_reg; alpha = 1.f; }
  else { mn = fmaxf(m_reg, pmax); alpha = __builtin_amdgcn_exp2f(m_reg - mn); m_reg = mn; }
#pragma unroll
  for (int r = 0; r < 16; ++r) p0[r] = p0[r] - mn;
#pragma unroll
  for (int r = 0; r < 16; ++r) p1[r] = p1[r] - mn;
#pragma unroll
  for (int r = 0; r < 16; ++r) p0[r] = __builtin_amdgcn_exp2f(p0[r]);
}
__device__ __forceinline__ void finishSM(f32x16& p0, f32x16& p1, float alpha, float& l_reg, bf16x8& pa0, bf16x8& pa1, bf16x8& pa2, bf16x8& pa3) {
#pragma unroll
  for (int r = 0; r < 16; ++r) p1[r] = __builtin_amdgcn_exp2f(p1[r]);
  typedef float f32x2 __attribute__((ext_vector_type(2)));
  f32x2 s2 = (f32x2){p0[0], p0[1]} + (f32x2){p1[0], p1[1]};
#pragma unroll
  for (int r = 2; r < 16; r += 2) s2 += (f32x2){p0[r], p0[r + 1]} + (f32x2){p1[r], p1[r + 1]};
  float ps = s2.x + s2.y;
  { auto rr = __builtin_amdgcn_permlane32_swap(__float_as_uint(ps), __float_as_uint(ps), false, false);
    ps = __uint_as_float(rr[0]) + __uint_as_float(rr[1]); }
  l_reg = l_reg * alpha + ps;
#define ATT_PK4(P, BASE, OUT) do { unsigned a0 = cvtpk(P[BASE + 0], P[BASE + 1]), a1 = cvtpk(P[BASE + 2], P[BASE + 3]);   \
    unsigned b0 = cvtpk(P[BASE + 4], P[BASE + 5]), b1 = cvtpk(P[BASE + 6], P[BASE + 7]);                              \
    auto r0 = __builtin_amdgcn_permlane32_swap(a0, b0, false, false); auto r1 = __builtin_amdgcn_permlane32_swap(a1, b1, false, false); \
    u32x4 w = {r0[0], r1[0], r0[1], r1[1]}; OUT = *reinterpret_cast<bf16x8*>(&w); } while (0)
  ATT_PK4(p0, 0, pa0); ATT_PK4(p0, 8, pa1); ATT_PK4(p1, 0, pa2); ATT_PK4(p1, 8, pa3);
#undef ATT_PK4
}
__device__ __forceinline__ void qkt(f32x16& p0, f32x16& p1, const char* Ks, const bf16x8* qr, int r32, int hi) {
  p0 = f32x16{}; p1 = f32x16{};
#pragma unroll
  for (int d0 = 0; d0 < 4; ++d0) { const int cb = (d0 * 16 + hi * 8) * 2;
    bf16x8 b0 = *reinterpret_cast<const bf16x8*>(Ks + ATT_KSWZ(r32, cb));
    bf16x8 b1 = *reinterpret_cast<const bf16x8*>(Ks + ATT_KSWZ(32 + r32, cb));
    p0 = __builtin_amdgcn_mfma_f32_32x32x16_bf16(b0, qr[d0], p0, 0, 0, 0);
    p1 = __builtin_amdgcn_mfma_f32_32x32x16_bf16(b1, qr[d0], p1, 0, 0, 0); }
}
__device__ __forceinline__ void qkt_fold(f32x16& p0, f32x16& p1, const char* Ks, const bf16x8* qr, const f32x16& negm, int r32, int hi) {
  { const bf16x8 b0 = *reinterpret_cast<const bf16x8*>(Ks + ATT_KSWZ(r32, hi * 16)), b1 = *reinterpret_cast<const bf16x8*>(Ks + ATT_KSWZ(32 + r32, hi * 16));
    p0 = __builtin_amdgcn_mfma_f32_32x32x16_bf16(b0, qr[0], negm, 0, 0, 0); p1 = __builtin_amdgcn_mfma_f32_32x32x16_bf16(b1, qr[0], negm, 0, 0, 0); }
#pragma unroll
  for (int d0 = 1; d0 < 4; ++d0) { const int cb = (d0 * 16 + hi * 8) * 2;
    bf16x8 b0 = *reinterpret_cast<const bf16x8*>(Ks + ATT_KSWZ(r32, cb));
    bf16x8 b1 = *reinterpret_cast<const bf16x8*>(Ks + ATT_KSWZ(32 + r32, cb));
    p0 = __builtin_amdgcn_mfma_f32_32x32x16_bf16(b0, qr[d0], p0, 0, 0, 0);
    p1 = __builtin_amdgcn_mfma_f32_32x32x16_bf16(b1, qr[d0], p1, 0, 0, 0); }
}
__device__ __forceinline__ float rowmax32(const f32x16& p0, const f32x16& p1) {
  float pmax = p0[0];
#pragma unroll
  for (int r = 1; r < 16; ++r) pmax = fmaxf(pmax, p0[r]);
#pragma unroll
  for (int r = 0; r < 16; ++r) pmax = fmaxf(pmax, p1[r]);
  auto rr = __builtin_amdgcn_permlane32_swap(__float_as_uint(pmax), __float_as_uint(pmax), false, false);
  return fmaxf(__uint_as_float(rr[0]), __uint_as_float(rr[1]));
}
__device__ __forceinline__ void partialSM_first(f32x16& p0, f32x16& p1, float& m_reg, float& alpha, f32x16& negm) {
  const float pmax = rowmax32(p0, p1); m_reg = pmax; alpha = 1.f;
#pragma unroll
  for (int r = 0; r < 16; ++r) { p0[r] -= pmax; p1[r] -= pmax; negm[r] = -pmax; }
#pragma unroll
  for (int r = 0; r < 16; ++r) p0[r] = __builtin_amdgcn_exp2f(p0[r]);
}
__device__ __forceinline__ void partialSM_fold(f32x16& p0, f32x16& p1, float& m_reg, float& alpha, f32x16& negm) {
  const float pmax = rowmax32(p0, p1);
  if (__builtin_expect(__all(pmax <= THR), 1)) alpha = 1.f;
  else { const float delta = fmaxf(pmax, 0.f); m_reg += delta; alpha = __builtin_amdgcn_exp2f(-delta); const float nm = -m_reg;
#pragma unroll
    for (int r = 0; r < 16; ++r) { p0[r] -= delta; p1[r] -= delta; negm[r] = nm; } }
#pragma unroll
  for (int r = 0; r < 16; ++r) p0[r] = __builtin_amdgcn_exp2f(p0[r]);
}
__device__ __forceinline__ void wmask(f32x16& p0, f32x16& p1, int dq  , int hi) {
  const float ninf = -__builtin_inff();
#pragma unroll
  for (int r = 0; r < 16; ++r) { const unsigned d = (unsigned)(dq + crow(r, hi)); p0[r] = d <= 256u ? p0[r] : ninf; const unsigned d1 = d + 32u; p1[r] = d1 <= 256u ? p1[r] : ninf; }
}
template <int NCB> __device__ __forceinline__ int v_st(int k, int c) { const int kk = (k & ~0xC) | ((k & 4) << 1) | ((k & 8) >> 1); return ((kk >> 3) * NCB + (c >> 5)) * 512 + ((kk & 7) * 32 + (c & 31)) * 2; }
__device__ __forceinline__ int v_rd_base(int lane) { return ((lane & 3) << 3) | (((lane >> 2) & 3) << 6) | (((lane >> 4) & 1) << 5) | (((lane >> 5) & 1) << 8); }
template <int OFF> __device__ __forceinline__ s16x4 tr_read(int vb) {
  s16x4 r; asm volatile("ds_read_b64_tr_b16 %0, %1 offset:%2" : "=&v"(r) : "v"(vb), "i"(OFF) : "memory"); return r;
}
template <int NCB, int D0> __device__ __forceinline__ void pv_one(f32x16& od, int vb, bf16x8 pa0, bf16x8 pa1, bf16x8 pa2, bf16x8 pa3) {
#define ATT_VOFF(ks, half) (D0 * 512 + (ks) * (NCB * 1024) + (half) * (NCB * 512))
  const s16x4 l0 = tr_read<ATT_VOFF(0, 0)>(vb), h0 = tr_read<ATT_VOFF(0, 1)>(vb), l1 = tr_read<ATT_VOFF(1, 0)>(vb), h1 = tr_read<ATT_VOFF(1, 1)>(vb);
  const s16x4 l2 = tr_read<ATT_VOFF(2, 0)>(vb), h2 = tr_read<ATT_VOFF(2, 1)>(vb), l3 = tr_read<ATT_VOFF(3, 0)>(vb), h3 = tr_read<ATT_VOFF(3, 1)>(vb);
#undef ATT_VOFF
  asm volatile("s_waitcnt lgkmcnt(0)" ::: "memory"); ATT_SBAR();
#define ATT_PK(L, H) (bf16x8){L[0], L[1], L[2], L[3], H[0], H[1], H[2], H[3]}
  od = __builtin_amdgcn_mfma_f32_32x32x16_bf16(pa0, ATT_PK(l0, h0), od, 0, 0, 0);
  od = __builtin_amdgcn_mfma_f32_32x32x16_bf16(pa1, ATT_PK(l1, h1), od, 0, 0, 0);
  od = __builtin_amdgcn_mfma_f32_32x32x16_bf16(pa2, ATT_PK(l2, h2), od, 0, 0, 0);
  od = __builtin_amdgcn_mfma_f32_32x32x16_bf16(pa3, ATT_PK(l3, h3), od, 0, 0, 0);
#undef ATT_PK
}
template <int NCB> __device__ __forceinline__ void pv_all(f32x16* o, int vb, bf16x8 pa0, bf16x8 pa1, bf16x8 pa2, bf16x8 pa3) {
  pv_one<NCB, 0>(o[0], vb, pa0, pa1, pa2, pa3); pv_one<NCB, 1>(o[1], vb, pa0, pa1, pa2, pa3);
  if constexpr (NCB == 4) { pv_one<NCB, 2>(o[2], vb, pa0, pa1, pa2, pa3); pv_one<NCB, 3>(o[3], vb, pa0, pa1, pa2, pa3); }
}

template <int NCB> constexpr int attn_lds_bytes() { return 3 * (KVBLK * 32 * NCB * 2) + 3 * SHM_K + 2048; }
template <int NCB, bool WINDOW>
__device__ __forceinline__ void attn_core(f32x16 (&o)[NCB], const bf16* __restrict__ Qb, const bf16* __restrict__ Kh, const bf16* __restrict__ Vh, int ld, int ntiles,
                                          int qpos0, int kpos0, float sink_l2, char* lds, int wv) {
  constexpr bool FOLD = (NCB == 2) && !WINDOW;
  constexpr int SHM_V = KVBLK * 32 * NCB * 2;
  const int tid = fresh_tid(wv), wid = tid >> 6, lane = tid & 63, r32 = lane & 31, hi = lane >> 5;
  char* V_lds = lds; char* K_lds = lds + 3 * SHM_V;
  float* wsf = (float*)(lds + 3 * SHM_V + 3 * SHM_K) + wid * 64; float* li_l = wsf; float* al_l = wsf + 32;
  float m_reg = -1e30f, l_reg = 0; asm volatile("" : "+v"(m_reg));
#pragma unroll
  for (int d = 0; d < NCB; ++d) o[d] = f32x16{};
  bf16x8 qr[4];
  const bf16* Qw = Qb + (long)(wid * 32 + r32) * ld + hi * 8;
#pragma unroll
  for (int d0 = 0; d0 < 4; ++d0) qr[d0] = *reinterpret_cast<const bf16x8*>(Qw + d0 * 16);
  const int dq0 = kpos0 - (qpos0 + wid * 32 + r32) + 128;
  const int ksr = tid >> 3, ksc = (tid & 7) * 8, kst = ATT_KSWZ(ksr, ksc * 2);
  constexpr int VCPR = 4 * NCB;
  const int vsr = tid / VCPR, vsc = (tid % VCPR) * 8, vst0 = v_st<NCB>(vsr, vsc), vst1 = v_st<NCB>(vsr + 32, vsc);
  const int vb0 = (int)(uintptr_t)V_lds + v_rd_base(lane);
  struct { bf16x8 ks, vs0, vs1; } sr_[2];
#define ATT_SLOAD(i, t) do { const long k0_ = (long)(t) * KVBLK; sr_[i].ks = *reinterpret_cast<const bf16x8*>(Kh + (k0_ + ksr) * ld + ksc); \
    sr_[i].vs0 = *reinterpret_cast<const bf16x8*>(Vh + (k0_ + vsr) * ld + vsc); \
    if constexpr (NCB == 4) sr_[i].vs1 = *reinterpret_cast<const bf16x8*>(Vh + (k0_ + vsr + 32) * ld + vsc); } while (0)
#define ATT_SWRITE(b, i) do { *(bf16x8*)(K_lds + (b) * SHM_K + kst) = sr_[i].ks; *(bf16x8*)(V_lds + (b) * SHM_V + vst0) = sr_[i].vs0; \
    if constexpr (NCB == 4) *(bf16x8*)(V_lds + (b) * SHM_V + vst1) = sr_[i].vs1; } while (0)
#define ATT_RESC(a) do { if (__any((a) < 1.f)) { if (hi == 0) al_l[r32] = (a); asm volatile("s_waitcnt lgkmcnt(0)" ::: "memory"); \
    _Pragma("unroll") for (int r = 0; r < 16; ++r) { const float al_ = al_l[crow(r, hi)]; _Pragma("unroll") for (int d = 0; d < NCB; ++d) o[d][r] *= al_; } } } while (0)
#define ATT_MASK(P0, P1, t) do { if constexpr (WINDOW) wmask(P0, P1, dq0 + (t) * KVBLK, hi); } while (0)
#define ATT_STEP(J, X0, X1, ALX, Y0, Y1, ALY, SLOT) do { const int j_ = (J); const int bn_ = bc == 2 ? 0 : bc + 1, bp_ = bc == 0 ? 2 : bc - 1; \
    __syncthreads(); \
    if (j_ + 1 < NT) ATT_SWRITE(bn_, SLOT); \
    if (j_ + 3 < NT) ATT_SLOAD(SLOT, j_ + 3); \
    ATT_SBAR(); \
    if constexpr (FOLD) qkt_fold(X0, X1, K_lds + bc * SHM_K, qr, negm, r32, hi); else { qkt(X0, X1, K_lds + bc * SHM_K, qr, r32, hi); ATT_MASK(X0, X1, j_); } \
    finishSM(Y0, Y1, ALY, l_reg, pa0, pa1, pa2, pa3); ATT_SBAR(); \
    pv_all<NCB>(o, vb0 + bp_ * SHM_V, pa0, pa1, pa2, pa3); \
    if constexpr (FOLD) partialSM_fold(X0, X1, m_reg, ALX, negm); else { float mn_; partialSM(X0, X1, m_reg, mn_, ALX); } \
    ATT_RESC(ALX); bc = bn_; } while (0)
  f32x16 pA0, pA1, pB0, pB1; float alA, alB; bf16x8 pa0, pa1, pa2, pa3; const int NT = ntiles;
  f32x16 negm = f32x16{};
  ATT_SLOAD(0, 0); asm volatile("s_waitcnt vmcnt(0)" ::: "memory"); ATT_SWRITE(0, 0);
  ATT_SLOAD(1, 1); if (2 < NT) ATT_SLOAD(0, 2);
  int bc = 0;
  __syncthreads();
  ATT_SWRITE(1, 1); if (3 < NT) ATT_SLOAD(1, 3);
  ATT_SBAR();
  if constexpr (FOLD) { qkt_fold(pA0, pA1, K_lds, qr, negm, r32, hi); partialSM_first(pA0, pA1, m_reg, alA, negm); }
  else { qkt(pA0, pA1, K_lds, qr, r32, hi); ATT_MASK(pA0, pA1, 0); float mn_; partialSM(pA0, pA1, m_reg, mn_, alA); }
  bc = 1;
  for (int j = 1; j + 1 < NT; j += 2) {
    ATT_STEP(j, pB0, pB1, alB, pA0, pA1, alA, 0);
    ATT_STEP(j + 1, pA0, pA1, alA, pB0, pB1, alB, 1);
  }
  ATT_STEP(NT - 1, pB0, pB1, alB, pA0, pA1, alA, 0);
  finishSM(pB0, pB1, alB, l_reg, pa0, pa1, pa2, pa3); ATT_SBAR();
  { const int bp_ = bc == 0 ? 2 : bc - 1; pv_all<NCB>(o, vb0 + bp_ * SHM_V, pa0, pa1, pa2, pa3); }
  l_reg += __builtin_amdgcn_exp2f(sink_l2 - m_reg);
  if (hi == 0) li_l[r32] = l_reg; asm volatile("s_waitcnt lgkmcnt(0)" ::: "memory");
#pragma unroll
  for (int r = 0; r < 16; ++r) { const float rl = __builtin_amdgcn_rcpf(li_l[crow(r, hi)]);
#pragma unroll
    for (int d = 0; d < NCB; ++d) o[d][r] *= rl; }
#undef ATT_SLOAD
#undef ATT_SWRITE
#undef ATT_RESC
#undef ATT_MASK
#undef ATT_STEP
}
template <int NCB> __device__ __forceinline__ void store_o(const f32x16 (&o)[NCB], bf16* Ob, int ld, int lane) {
  const int r32 = lane & 31, hi = lane >> 5, odd = lane & 1;
#pragma unroll
  for (int d = 0; d < NCB; ++d)
#pragma unroll
    for (int r = 0; r < 16; r += 2) {
      const float send = odd ? o[d][r] : o[d][r + 1];
      const float recv = dpp_xor1(send);
      const unsigned pk = cvtpk(odd ? recv : o[d][r], odd ? o[d][r + 1] : recv);
      const int row = crow(r + odd, hi);
      *(unsigned*)(Ob + (long)row * ld + d * 32 + (r32 & ~1)) = pk;
    }
}
template <int NCB> __device__ __forceinline__ void stage_o(const f32x16 (&o)[NCB], __attribute__((address_space(3))) unsigned char* stg, int ldb, int lane) {
  const int r32 = lane & 31, hi = lane >> 5, odd = lane & 1;
#pragma unroll
  for (int d = 0; d < NCB; ++d)
#pragma unroll
    for (int r = 0; r < 16; r += 2) {
      const float send = odd ? o[d][r] : o[d][r + 1];
      const float recv = dpp_xor1(send);
      const unsigned pk = cvtpk(odd ? recv : o[d][r], odd ? o[d][r + 1] : recv);
      const int row = crow(r + odd, hi);
      *(__attribute__((address_space(3))) unsigned*)(stg + row * ldb + (d * 32 + (r32 & ~1)) * 2) = pk;
    }
}
}


namespace ab2 {
using bf16=__hip_bfloat16;
using bf16x8=__attribute__((ext_vector_type(8)))short;
using s16x4=__attribute__((ext_vector_type(4)))short;
using f32x16=__attribute__((ext_vector_type(16)))float;
using u32x4=__attribute__((ext_vector_type(4)))unsigned;
constexpr int D=64;
constexpr int NW=8,QBLK=32,QB=QBLK*NW,KVBLK=64;
__device__ __forceinline__ int crow(int r,int hi){return (r&3)+8*(r>>2)+4*hi;}
#define SBAR() __builtin_amdgcn_sched_barrier(0)
__device__ __forceinline__ void wmask2(f32x16&p0,f32x16&p1,int dq,int hi){
  const float NEG=-__builtin_inff();
  #pragma unroll
  for(int r=0;r<16;++r){const unsigned d=(unsigned)(dq+crow(r,hi)); if(d>256u)p0[r]=NEG; if(d+32u>256u)p1[r]=NEG;}
}

constexpr int NSLOT=3, SLOTB=8192;
constexpr int LDS_K=0, LDS_V=NSLOT*SLOTB, LDS_WS=2*NSLOT*SLOTB, LDS_OST=LDS_WS+NW*64*4, LDS_BYTES=LDS_OST+NW*4096;
constexpr float C2=0.125f*1.4426950408889634f;
__device__ __forceinline__ void glds16(const void*gsrc,unsigned lds_dst){unsigned keep;
  asm volatile("s_mov_b32 %0, m0\n\ts_mov_b32 m0, %2\n\ts_nop 0\n\tglobal_load_lds_dwordx4 %1, off\n\ts_mov_b32 m0, %0":"=&s"(keep):"v"(gsrc),"s"(lds_dst):"memory");}
__device__ __forceinline__ float max3f(float a,float b,float c){float r;asm("v_max3_f32 %0, %1, %2, %3":"=v"(r):"v"(a),"v"(b),"v"(c));return r;}
__device__ __forceinline__ float max2f(float a,float b){float r;asm("v_max_f32_e32 %0, %1, %2":"=v"(r):"v"(a),"v"(b));return r;}
__device__ __forceinline__ float fadd_s(float a,float b){float r;asm("v_add_f32_e32 %0, %1, %2":"=v"(r):"v"(a),"v"(b));return r;}
__device__ __forceinline__ float fsub_s(float a,float b){float r;asm("v_sub_f32_e32 %0, %1, %2":"=v"(r):"v"(a),"v"(b));return r;}
typedef float f32x2_t __attribute__((ext_vector_type(2))); typedef __bf16 bf16x2_t __attribute__((ext_vector_type(2)));
__device__ __forceinline__ unsigned cvtpk_s(float lo,float hi){f32x2_t v={lo,hi};bf16x2_t b=__builtin_convertvector(v,bf16x2_t);return __builtin_bit_cast(unsigned,b);}
#define WAIT_BAR(N) asm volatile("s_waitcnt vmcnt(" #N ") lgkmcnt(0)\n\ts_barrier":::"memory")

__device__ __forceinline__ void qkt(f32x16&p0,f32x16&p1,const char*Kslot,const bf16x8*qr,const f32x16&negm,int r32,int hi){
  const char*kb=Kslot+hi*1024+r32*16;
  #pragma unroll
  for(int d0=0;d0<4;++d0){
    const bf16x8 b0=*reinterpret_cast<const bf16x8*>(kb+d0*2048);
    const bf16x8 b1=*reinterpret_cast<const bf16x8*>(kb+d0*2048+512);
    if(d0==0){p0=__builtin_amdgcn_mfma_f32_32x32x16_bf16(b0,qr[0],negm,0,0,0);p1=__builtin_amdgcn_mfma_f32_32x32x16_bf16(b1,qr[0],negm,0,0,0);}
    else{p0=__builtin_amdgcn_mfma_f32_32x32x16_bf16(b0,qr[d0],p0,0,0,0);p1=__builtin_amdgcn_mfma_f32_32x32x16_bf16(b1,qr[d0],p1,0,0,0);}}
}
typedef __attribute__((address_space(3))) const char* lds_cptr;
typedef short v4i16_t __attribute__((ext_vector_type(4)));
__device__ __forceinline__ void kload8(bf16x8*kf,lds_cptr kp){
  kf[0]=*(const __attribute__((address_space(3))) bf16x8*)(kp);      kf[1]=*(const __attribute__((address_space(3))) bf16x8*)(kp+512);
  kf[2]=*(const __attribute__((address_space(3))) bf16x8*)(kp+2048); kf[3]=*(const __attribute__((address_space(3))) bf16x8*)(kp+2560);
  kf[4]=*(const __attribute__((address_space(3))) bf16x8*)(kp+4096); kf[5]=*(const __attribute__((address_space(3))) bf16x8*)(kp+4608);
  kf[6]=*(const __attribute__((address_space(3))) bf16x8*)(kp+6144); kf[7]=*(const __attribute__((address_space(3))) bf16x8*)(kp+6656);
}
__device__ __forceinline__ void kload2(bf16x8*kf,lds_cptr kp,int j){ kf[2*j]=*(const __attribute__((address_space(3))) bf16x8*)(kp+j*2048); kf[2*j+1]=*(const __attribute__((address_space(3))) bf16x8*)(kp+j*2048+512); }
__device__ __forceinline__ s16x4 vtr(lds_cptr p){ return __builtin_bit_cast(s16x4,__builtin_amdgcn_ds_read_tr16_b64_v4i16((__attribute__((address_space(3))) v4i16_t*)p)); }
__device__ __forceinline__ float rowmax(const f32x16&p0,const f32x16&p1){
  float a=max3f(p0[0],p0[1],p1[0]),b=max3f(p0[2],p0[3],p1[1]);a=max3f(a,p1[2],p1[3]);
  #pragma unroll
  for(int r=4;r<16;r+=4){a=max3f(a,p0[r],p0[r+1]);b=max3f(b,p0[r+2],p0[r+3]);a=max3f(a,p1[r],p1[r+1]);b=max3f(b,p1[r+2],p1[r+3]);}
  const float m=max2f(a,b);
  auto rr=__builtin_amdgcn_permlane32_swap(__float_as_uint(m),__float_as_uint(m),false,false);
  return max2f(__uint_as_float(rr[0]),__uint_as_float(rr[1]));
}
__device__ __forceinline__ void pv(f32x16*o,int vb,bf16x8 pa0,bf16x8 pa1,bf16x8 pa2,bf16x8 pa3){
  #pragma unroll
  for(int d0=0;d0<2;++d0){s16x4 lo[4],hi[4];
    #pragma unroll
    for(int ks=0;ks<4;++ks){
      asm volatile("ds_read_b64_tr_b16 %0,%1 offset:%c2":"=&v"(lo[ks]):"v"(vb),"i"(d0*4096+ks*1024):"memory");
      asm volatile("ds_read_b64_tr_b16 %0,%1 offset:%c2":"=&v"(hi[ks]):"v"(vb),"i"(d0*4096+ks*1024+512):"memory");}
    asm volatile("s_waitcnt lgkmcnt(0)":::"memory");SBAR();
    #define PK(k) (bf16x8){lo[k][0],lo[k][1],lo[k][2],lo[k][3],hi[k][0],hi[k][1],hi[k][2],hi[k][3]}
    o[d0]=__builtin_amdgcn_mfma_f32_32x32x16_bf16(pa0,PK(0),o[d0],0,0,0);
    o[d0]=__builtin_amdgcn_mfma_f32_32x32x16_bf16(pa1,PK(1),o[d0],0,0,0);
    o[d0]=__builtin_amdgcn_mfma_f32_32x32x16_bf16(pa2,PK(2),o[d0],0,0,0);
    o[d0]=__builtin_amdgcn_mfma_f32_32x32x16_bf16(pa3,PK(3),o[d0],0,0,0);
    #undef PK
  }
}

#ifndef ATTN_STORE16
#define ATTN_STORE16(p,v) (*(u32x4*)(p)=(v))
#endif
template<int THRL,int LDQ,int LDO,bool WINDOW,bool TWOHEAD=false> __device__ __forceinline__ void attn_unit(const bf16*Qb,const bf16*__restrict__ Kh,const bf16*__restrict__ Vh,bf16*Ob,int ntiles,int qpos0,int kpos0,float sink_l2,char*shm,int wv,float sink2_l2=0.f){
  const int tid=fresh_tid(wv),lane=tid&63,r32=lane&31,hi=lane>>5; const int wid=__builtin_amdgcn_readfirstlane(tid>>6);
  const int wrow=TWOHEAD?(wid&3):wid, whead=TWOHEAD?(wid>>2):0;
  if constexpr(TWOHEAD) sink_l2=whead?sink2_l2:sink_l2;
  const bf16*Qw=Qb+(long)(wrow*QBLK)*LDQ+whead*64;
  const unsigned lds0=(unsigned)(uintptr_t)shm;
  float*wsf=(float*)(shm+LDS_WS)+wid*64;
  const bf16*ksrc=Kh+(long)lane*LDQ+wid*8;
  const bf16*vsrc=Vh+(long)(16*(wid&3)+(lane>>2))*LDQ+(wid>>2)*32+(lane&3)*8;
  const unsigned kdst=lds0+LDS_K+wid*1024, vdst=lds0+LDS_V+wid*1024;
  #define DMA_K(t,slot) glds16(ksrc+(long)(t)*KVBLK*LDQ,(unsigned)__builtin_amdgcn_readfirstlane(kdst+(slot)))
  #define DMA_V(t,slot) glds16(vsrc+(long)(t)*KVBLK*LDQ,(unsigned)__builtin_amdgcn_readfirstlane(vdst+(slot)))
  const int vb0=(int)(lds0+LDS_V)+((lane>>4)&1)*32+(lane&3)*8+(4*hi+((lane&15)>>2))*64;
  const char*Kbase=shm+LDS_K; bf16x8 kf[8];
  const lds_cptr shm3=(lds_cptr)shm; const lds_cptr kp0=shm3+LDS_K+hi*1024+r32*16; const lds_cptr vp0=shm3+LDS_V+((lane>>4)&1)*32+(lane&3)*8+(4*hi+((lane&15)>>2))*64;
  const int NT=ntiles;
  DMA_K(0,0);DMA_V(0,0);DMA_K(1,SLOTB);
  bf16x8 qr[4];
  #pragma unroll
  for(int d0=0;d0<4;++d0)qr[d0]=*reinterpret_cast<const bf16x8*>(&Qw[(long)r32*LDQ+d0*16+hi*8]);
  float mhat=0.f,l_reg=0.f;f32x16 o[2];o[0]=f32x16{};o[1]=f32x16{};f32x16 negm=f32x16{};asm volatile("":"+v"(negm));
  const int dq0=kpos0-(qpos0+wrow*QBLK+r32)+128;
  #define CMASK(P0,P1,t) do{ if constexpr(WINDOW) wmask2(P0,P1,dq0+(t)*KVBLK,hi); }while(0)
  bool resc=false;
  #define START(P0,P1) do{ const float rm=rowmax(P0,P1); resc=false; \
    { const float dl=__builtin_fmaxf(rm,0.f); mhat=fadd_s(mhat,dl); \
      _Pragma("unroll") for(int r=0;r<16;++r){P0[r]=fsub_s(P0[r],dl);P1[r]=fsub_s(P1[r],dl);} \
      _Pragma("unroll") for(int r=0;r<16;++r)negm[r]=-mhat; asm volatile("":"+v"(negm)); } \
    _Pragma("unroll") for(int r=0;r<16;++r)P0[r]=__builtin_amdgcn_exp2f(P0[r]); }while(0)
  #define RESC() do{ if(resc){ asm volatile("s_waitcnt lgkmcnt(0)":::"memory"); \
      _Pragma("unroll") for(int d_=0;d_<2;++d_) _Pragma("unroll") for(int r=0;r<16;++r)o[d_][r]*=wsf[crow(r,hi)]; } }while(0)
  f32x16 pA0,pA1,pB0,pB1;
  int sl_prev=0,sl_cur=0,sl_next=SLOTB;
  #define ROT() do{sl_prev=sl_cur;sl_cur=sl_next;sl_next=(sl_next==(NSLOT-1)*SLOTB)?0:sl_next+SLOTB;}while(0)
  DMA_K(2,2*SLOTB);
  WAIT_BAR(3);
  qkt(pA0,pA1,Kbase,qr,negm,r32,hi);asm volatile("s_nop 15\n\ts_nop 7":"+v"(pA0),"+v"(pA1));CMASK(pA0,pA1,0);
  START(pA0,pA1);
  _Pragma("unroll") for(int r=0;r<16;++r)pA1[r]=__builtin_amdgcn_exp2f(pA1[r]);
  WAIT_BAR(0);
  DMA_K(3,0);DMA_V(1,SLOTB);
  ROT();
  kload8(kf,kp0+sl_cur);
  WAIT_BAR(2);
  s16x4 vlo[8],vhi[8]; u32x4 pw0,pw1,pw2,pw3;
  #define PKW(P,B) cvtpk_s(P[B],P[B+1])
  #define PAF(k) __builtin_bit_cast(bf16x8,pw##k)
  #define VFR(i) (bf16x8){vlo[i][0],vlo[i][1],vlo[i][2],vlo[i][3],vhi[i][0],vhi[i][1],vhi[i][2],vhi[i][3]}
  #define PIN(x) asm volatile("":"+v"(x))
  #define MX3(a,b,c) __builtin_fmaxf(__builtin_fmaxf((a),(b)),(c))
  #define GAPA(MF,A0,A1,A2,A3,W0,W1,PW) do{ MF; sacc+=A0; sacc+=A1; sacc+=A2; sacc+=A3; PIN(sacc); W0; W1; PIN(PW); SBAR(); }while(0)
  #define EX(v) __builtin_amdgcn_exp2f(v)
  #define GAPB(MF,X,B) do{ MF; X[B]=EX(X[B]); X[B+1]=EX(X[B+1]); X[B+2]=EX(X[B+2]); X[B+3]=EX(X[B+3]); PIN(X); SBAR(); }while(0)
  #define VRD(i) do{ vlo[i]=vtr(vp_+(((i)>>2)*4096+((i)&3)*1024)); vhi[i]=vtr(vp_+(((i)>>2)*4096+((i)&3)*1024+512)); }while(0)
  #define KRD(G,j) do{ if(G){ kload2(kf,kp0+sl_next,j); SBAR(); } }while(0)
  #define STEP(C0,C1,P0,P1,t,GK,GV,GL) do{ SBAR(); \
    const lds_cptr vp_=vp0+sl_prev; \
    VRD(0); SBAR(); float sacc=(P0[0]+P0[1]); \
    GAPA(C0=__builtin_amdgcn_mfma_f32_32x32x16_bf16(kf[0],qr[0],negm,0,0,0), P0[2],P0[3],P0[4],P0[5],     pw0[0]=PKW(P0,0), pw0[1]=PKW(P0,2), pw0); \
    VRD(4); SBAR(); GAPA(C1=__builtin_amdgcn_mfma_f32_32x32x16_bf16(kf[1],qr[0],negm,0,0,0), P0[6],P0[7],P0[8],P0[9],     pw0[2]=PKW(P0,4), pw0[3]=PKW(P0,6), pw0); \
    VRD(1); SBAR(); GAPA(C0=__builtin_amdgcn_mfma_f32_32x32x16_bf16(kf[2],qr[1],C0,0,0,0),   P0[10],P0[11],P0[12],P0[13], pw1[0]=PKW(P0,8), pw1[1]=PKW(P0,10), pw1); \
    VRD(5); SBAR(); GAPA(C1=__builtin_amdgcn_mfma_f32_32x32x16_bf16(kf[3],qr[1],C1,0,0,0),   P0[14],P0[15],P1[0],P1[1],   pw1[2]=PKW(P0,12),pw1[3]=PKW(P0,14), pw1); \
    VRD(2); SBAR(); GAPA(C0=__builtin_amdgcn_mfma_f32_32x32x16_bf16(kf[4],qr[2],C0,0,0,0),   P1[2],P1[3],P1[4],P1[5],     pw2[0]=PKW(P1,0), pw2[1]=PKW(P1,2), pw2); \
    VRD(6); SBAR(); GAPA(C1=__builtin_amdgcn_mfma_f32_32x32x16_bf16(kf[5],qr[2],C1,0,0,0),   P1[6],P1[7],P1[8],P1[9],     pw2[2]=PKW(P1,4), pw2[3]=PKW(P1,6), pw2); \
    VRD(3); SBAR(); GAPA(C0=__builtin_amdgcn_mfma_f32_32x32x16_bf16(kf[6],qr[3],C0,0,0,0),   P1[10],P1[11],P1[12],P1[13], pw3[0]=PKW(P1,8), pw3[1]=PKW(P1,10), pw3); \
    VRD(7); SBAR(); GAPA(C1=__builtin_amdgcn_mfma_f32_32x32x16_bf16(kf[7],qr[3],C1,0,0,0),   P1[14],P1[15],0.f,0.f,       pw3[2]=PKW(P1,12),pw3[3]=PKW(P1,14), pw3); \
    l_reg+=sacc; \
    if(GK){DMA_K((t)+3,sl_cur);} if(GV){DMA_V((t)+1,sl_next);} \
    CMASK(C0,C1,t); \
    { float a=MX3(C0[0],C0[1],C1[0]),b=MX3(C0[2],C0[3],C1[1]); a=MX3(a,C1[2],C1[3]); \
      _Pragma("unroll") for(int r=4;r<16;r+=4){a=MX3(a,C0[r],C0[r+1]);b=MX3(b,C0[r+2],C0[r+3]);a=MX3(a,C1[r],C1[r+1]);b=MX3(b,C1[r+2],C1[r+3]);} \
      float rm=__builtin_fmaxf(a,b); { auto rr=__builtin_amdgcn_permlane32_swap(__float_as_uint(rm),__float_as_uint(rm),false,false); rm=__builtin_fmaxf(__uint_as_float(rr[0]),__uint_as_float(rr[1])); } \
      resc=false; \
      if(__builtin_expect(__any(rm>(float)THRL),0)){ const float dl=__builtin_fmaxf(rm,0.f); mhat+=dl; \
        _Pragma("unroll") for(int r=0;r<16;++r){C0[r]-=dl;C1[r]-=dl;} \
        _Pragma("unroll") for(int r=0;r<16;++r)negm[r]=-mhat; asm volatile("":"+v"(negm)); \
        const float f=__builtin_amdgcn_exp2f(-dl); l_reg*=f; if(hi==0)wsf[r32]=f; resc=true; } } \
    SBAR(); \
    GAPB(o[0]=__builtin_amdgcn_mfma_f32_32x32x16_bf16(PAF(0),VFR(0),o[0],0,0,0), C0,0); \
    GAPB(o[1]=__builtin_amdgcn_mfma_f32_32x32x16_bf16(PAF(0),VFR(4),o[1],0,0,0), C0,4); \
    KRD(GL,0); GAPB(o[0]=__builtin_amdgcn_mfma_f32_32x32x16_bf16(PAF(1),VFR(1),o[0],0,0,0), C0,8); \
    KRD(GL,1); GAPB(o[1]=__builtin_amdgcn_mfma_f32_32x32x16_bf16(PAF(1),VFR(5),o[1],0,0,0), C0,12); \
    KRD(GL,2); GAPB(o[0]=__builtin_amdgcn_mfma_f32_32x32x16_bf16(PAF(2),VFR(2),o[0],0,0,0), C1,0); \
    KRD(GL,3); GAPB(o[1]=__builtin_amdgcn_mfma_f32_32x32x16_bf16(PAF(2),VFR(6),o[1],0,0,0), C1,4); \
    GAPB(o[0]=__builtin_amdgcn_mfma_f32_32x32x16_bf16(PAF(3),VFR(3),o[0],0,0,0), C1,8); \
    GAPB(o[1]=__builtin_amdgcn_mfma_f32_32x32x16_bf16(PAF(3),VFR(7),o[1],0,0,0), C1,12); \
    }while(0)
  int t=1;
  for(;t+5<NT;t+=2){
    STEP(pB0,pB1,pA0,pA1,t,true,true,true);     WAIT_BAR(2); RESC(); ROT();
    STEP(pA0,pA1,pB0,pB1,t+1,true,true,true);   WAIT_BAR(2); RESC(); ROT();
  }
  #define ENDW(tt) do{ if((tt)+3<NT){WAIT_BAR(2);} else if((tt)+2<NT){WAIT_BAR(1);} else {WAIT_BAR(0);} }while(0)
  for(;t+1<NT;t+=2){
    STEP(pB0,pB1,pA0,pA1,t,(t+3<NT),(t+1<NT),(t+1<NT));       ENDW(t);   RESC(); ROT();
    STEP(pA0,pA1,pB0,pB1,t+1,(t+4<NT),(t+2<NT),(t+2<NT));     ENDW(t+1); RESC(); ROT();
  }
  STEP(pB0,pB1,pA0,pA1,NT-1,false,false,false); RESC();
  { float sacc=pB0[0]+pB0[1]; _Pragma("unroll") for(int r=2;r<16;++r)sacc+=pB0[r]; _Pragma("unroll") for(int r=0;r<16;++r)sacc+=pB1[r]; l_reg+=sacc;
    pw0=(u32x4){PKW(pB0,0),PKW(pB0,2),PKW(pB0,4),PKW(pB0,6)};pw1=(u32x4){PKW(pB0,8),PKW(pB0,10),PKW(pB0,12),PKW(pB0,14)};pw2=(u32x4){PKW(pB1,0),PKW(pB1,2),PKW(pB1,4),PKW(pB1,6)};pw3=(u32x4){PKW(pB1,8),PKW(pB1,10),PKW(pB1,12),PKW(pB1,14)};
    SBAR(); pv(o,vb0+sl_cur,PAF(0),PAF(1),PAF(2),PAF(3)); }
  #undef PKW
  #undef PAF
  #undef VFR
  #undef PIN
  #undef MX3
  #undef GAPA
  #undef GAPB
  #undef EX
  #undef VRD
  #undef KRD
  #undef STEP
  #undef ENDW
  {auto rr=__builtin_amdgcn_permlane32_swap(__float_as_uint(l_reg),__float_as_uint(l_reg),false,false);l_reg=__uint_as_float(rr[0])+__uint_as_float(rr[1]);}
  l_reg+=__builtin_amdgcn_exp2f(sink_l2-mhat);
  if(hi==0)wsf[32+r32]=l_reg;asm volatile("s_waitcnt lgkmcnt(0)":::"memory");
  float rli[16];
  #pragma unroll
  for(int r=0;r<16;++r)rli[r]=__builtin_amdgcn_rcpf(wsf[32+crow(r,hi)]);
  bf16*Ow=Ob+(long)(wrow*QBLK)*LDO+whead*64;
  { bf16*stg=(bf16*)(shm+LDS_OST)+wid*2048;
    #pragma unroll
    for(int r=0;r<16;++r){const int orow=crow(r,hi);
      #pragma unroll
      for(int d0=0;d0<2;++d0)stg[orow*64+d0*32+r32]=__float2bfloat16(o[d0][r]*rli[r]);}
    asm volatile("s_waitcnt lgkmcnt(0)":::"memory");
    #pragma unroll
    for(int i=0;i<4;++i){const int row=i*8+(lane>>3),ch=lane&7; const u32x4 v=*(const u32x4*)(stg+row*64+ch*8); ATTN_STORE16(Ow+(long)row*LDO+ch*8,v);} }
  asm volatile("s_waitcnt lgkmcnt(0)\n\ts_barrier":::"memory");
  #undef DMA_K
  #undef DMA_V
  #undef CMASK
  #undef START
  #undef RESC
  #undef ROT
}

constexpr int LDS128_K=0, LDS128_V=3*SLOTB, LDS128_WS=LDS128_V+3*2*SLOTB, LDS128_BYTES=LDS128_WS+NW*64*4;
__device__ __forceinline__ void pv128(f32x16*o,int vb,bf16x8 pa0,bf16x8 pa1,bf16x8 pa2,bf16x8 pa3){
  #pragma unroll
  for(int d0=0;d0<4;++d0){s16x4 lo[4],hi[4];
    #pragma unroll
    for(int ks=0;ks<4;++ks){
      asm volatile("ds_read_b64_tr_b16 %0,%1 offset:%c2":"=&v"(lo[ks]):"v"(vb),"i"(d0*4096+ks*1024):"memory");
      asm volatile("ds_read_b64_tr_b16 %0,%1 offset:%c2":"=&v"(hi[ks]):"v"(vb),"i"(d0*4096+ks*1024+512):"memory");}
    asm volatile("s_waitcnt lgkmcnt(0)":::"memory");SBAR();
    #define PK(k) (bf16x8){lo[k][0],lo[k][1],lo[k][2],lo[k][3],hi[k][0],hi[k][1],hi[k][2],hi[k][3]}
    o[d0]=__builtin_amdgcn_mfma_f32_32x32x16_bf16(pa0,PK(0),o[d0],0,0,0);
    o[d0]=__builtin_amdgcn_mfma_f32_32x32x16_bf16(pa1,PK(1),o[d0],0,0,0);
    o[d0]=__builtin_amdgcn_mfma_f32_32x32x16_bf16(pa2,PK(2),o[d0],0,0,0);
    o[d0]=__builtin_amdgcn_mfma_f32_32x32x16_bf16(pa3,PK(3),o[d0],0,0,0);
    #undef PK
  }
}
template<int THRL,int LDQ> __device__ __forceinline__ void attn_unit128(f32x16 (&o)[4],const bf16*Qb,const bf16*__restrict__ Kh,const bf16*__restrict__ Vh,int ntiles,char*shm,int wv){
  const int tid=fresh_tid(wv),lane=tid&63,r32=lane&31,hi=lane>>5; const int wid=__builtin_amdgcn_readfirstlane(tid>>6);
  const bf16*Qw=Qb+(long)(wid*QBLK)*LDQ;
  const unsigned lds0=(unsigned)(uintptr_t)shm;
  float*wsf=(float*)(shm+LDS128_WS)+wid*64;
  const bf16*ksrc=Kh+(long)lane*LDQ+wid*8;
  const bf16*vsrc=Vh+(long)(16*(wid&3)+(lane>>2))*LDQ+(wid>>2)*32+(lane&3)*8;
  const unsigned kdst=lds0+LDS128_K+wid*1024, vdst=lds0+LDS128_V+wid*1024;
  #define DMA_K(t,slot) glds16(ksrc+(long)(t)*KVBLK*LDQ,(unsigned)__builtin_amdgcn_readfirstlane(kdst+(slot)))
  #define DMA_V(t,slot) do{ glds16(vsrc+(long)(t)*KVBLK*LDQ,(unsigned)__builtin_amdgcn_readfirstlane(vdst+2*(slot))); glds16(vsrc+(long)(t)*KVBLK*LDQ+64,(unsigned)__builtin_amdgcn_readfirstlane(vdst+2*(slot)+8192)); }while(0)
  const int vb0=(int)(lds0+LDS128_V)+((lane>>4)&1)*32+(lane&3)*8+(4*hi+((lane&15)>>2))*64;
  const char*Kbase=shm+LDS128_K; bf16x8 kfa[2],kfb[2];
  const lds_cptr shm3=(lds_cptr)shm; const lds_cptr kp0=shm3+LDS128_K+hi*1024+r32*16; const lds_cptr vp0=shm3+LDS128_V+((lane>>4)&1)*32+(lane&3)*8+(4*hi+((lane&15)>>2))*64;
  const int NT=ntiles;
  DMA_K(0,0);DMA_V(0,0);DMA_K(1,SLOTB);
  bf16x8 qr[4];
  #pragma unroll
  for(int d0=0;d0<4;++d0)qr[d0]=*reinterpret_cast<const bf16x8*>(&Qw[(long)r32*LDQ+d0*16+hi*8]);
  float mhat=0.f,l_reg=0.f;
  float z0_=0.f; asm volatile("":"+v"(z0_));
  f32x16 negm;
  #pragma unroll
  for(int r=0;r<16;++r){negm[r]=z0_;
    #pragma unroll
    for(int d_=0;d_<4;++d_)o[d_][r]=z0_;}
  asm volatile("":"+v"(negm));
  bool resc=false;
  #define START(P0,P1) do{ const float rm=rowmax(P0,P1); resc=false; \
    { const float dl=__builtin_fmaxf(rm,0.f); mhat=fadd_s(mhat,dl); \
      _Pragma("unroll") for(int r=0;r<16;++r){P0[r]=fsub_s(P0[r],dl);P1[r]=fsub_s(P1[r],dl);} \
      _Pragma("unroll") for(int r=0;r<16;++r)negm[r]=-mhat; asm volatile("":"+v"(negm)); } \
    _Pragma("unroll") for(int r=0;r<16;++r)P0[r]=__builtin_amdgcn_exp2f(P0[r]); }while(0)
  #define RESC() do{ if(resc){ asm volatile("s_waitcnt lgkmcnt(0)":::"memory"); \
      _Pragma("unroll") for(int d_=0;d_<4;++d_) _Pragma("unroll") for(int r=0;r<16;++r)o[d_][r]*=wsf[crow(r,hi)]; } }while(0)
  f32x16 pA0,pA1,pB0,pB1;
  int sl_prev=0,sl_cur=0,sl_next=SLOTB;
  #define ROT() do{sl_prev=sl_cur;sl_cur=sl_next;sl_next=(sl_next==(NSLOT-1)*SLOTB)?0:sl_next+SLOTB;}while(0)
  WAIT_BAR(3);
  qkt(pA0,pA1,Kbase,qr,negm,r32,hi);asm volatile("s_nop 15\n\ts_nop 7":"+v"(pA0),"+v"(pA1));
  START(pA0,pA1);
  _Pragma("unroll") for(int r=0;r<16;++r)pA1[r]=__builtin_amdgcn_exp2f(pA1[r]);
  WAIT_BAR(0);
  DMA_K(2,2*SLOTB);DMA_V(1,SLOTB);
  ROT();
  s16x4 vlo[4],vhi[4]; u32x4 pw0,pw1,pw2,pw3;
  #define PKW(P,B) cvtpk_s(P[B],P[B+1])
  #define PAF(k) __builtin_bit_cast(bf16x8,pw##k)
  #define VFR(i) (bf16x8){vlo[i][0],vlo[i][1],vlo[i][2],vlo[i][3],vhi[i][0],vhi[i][1],vhi[i][2],vhi[i][3]}
  #define PIN(x) asm volatile("":"+v"(x))
  #define MX3(a,b,c) __builtin_fmaxf(__builtin_fmaxf((a),(b)),(c))
  #define GAPA(MF,A0,A1,A2,A3,W0,W1,PW) do{ MF; sacc+=A0; sacc+=A1; sacc+=A2; sacc+=A3; PIN(sacc); W0; W1; PIN(PW); SBAR(); }while(0)
  #define EX(v) __builtin_amdgcn_exp2f(v)
  #define GAPB2(MF,X,B) do{ MF; X[B]=EX(X[B]); X[B+1]=EX(X[B+1]); PIN(X); SBAR(); }while(0)
  #define VRDX(s,DB,KS) do{ vlo[s]=vtr(vp_+((DB)*4096+(KS)*1024)); vhi[s]=vtr(vp_+((DB)*4096+(KS)*1024+512)); }while(0)
  #define KRDP(DST,j) do{ DST[0]=*(const __attribute__((address_space(3))) bf16x8*)(kp_+(j)*2048); DST[1]=*(const __attribute__((address_space(3))) bf16x8*)(kp_+(j)*2048+512); }while(0)
  #define MF32(A,B,C) __builtin_amdgcn_mfma_f32_32x32x16_bf16(A,B,C,0,0,0)
  #define STEP128(C0,C1,P0,P1,t,GK,GV) do{ SBAR(); \
    if(GK){DMA_K((t)+2,sl_prev);} if(GV){DMA_V((t)+1,sl_next);} \
    const lds_cptr vp_=vp0+2*sl_prev; const lds_cptr kp_=kp0+sl_cur; \
    KRDP(kfa,0); KRDP(kfb,1); SBAR(); \
    VRDX(0,0,0); SBAR(); float sacc=(P0[0]+P0[1]); \
    GAPA(C0=MF32(kfa[0],qr[0],negm), P0[2],P0[3],P0[4],P0[5],     pw0[0]=PKW(P0,0), pw0[1]=PKW(P0,2), pw0); \
    VRDX(1,1,0); SBAR(); GAPA(C1=MF32(kfa[1],qr[0],negm), P0[6],P0[7],P0[8],P0[9],     pw0[2]=PKW(P0,4), pw0[3]=PKW(P0,6), pw0); \
    KRDP(kfa,2); SBAR(); \
    VRDX(2,2,0); SBAR(); GAPA(C0=MF32(kfb[0],qr[1],C0),   P0[10],P0[11],P0[12],P0[13], pw1[0]=PKW(P0,8), pw1[1]=PKW(P0,10), pw1); \
    VRDX(3,3,0); SBAR(); GAPA(C1=MF32(kfb[1],qr[1],C1),   P0[14],P0[15],P1[0],P1[1],   pw1[2]=PKW(P0,12),pw1[3]=PKW(P0,14), pw1); \
    KRDP(kfb,3); SBAR(); \
    GAPA(C0=MF32(kfa[0],qr[2],C0),   P1[2],P1[3],P1[4],P1[5],     pw2[0]=PKW(P1,0), pw2[1]=PKW(P1,2), pw2); \
    GAPA(C1=MF32(kfa[1],qr[2],C1),   P1[6],P1[7],P1[8],P1[9],     pw2[2]=PKW(P1,4), pw2[3]=PKW(P1,6), pw2); \
    GAPA(C0=MF32(kfb[0],qr[3],C0),   P1[10],P1[11],P1[12],P1[13], pw3[0]=PKW(P1,8), pw3[1]=PKW(P1,10), pw3); \
    GAPA(C1=MF32(kfb[1],qr[3],C1),   P1[14],P1[15],0.f,0.f,       pw3[2]=PKW(P1,12),pw3[3]=PKW(P1,14), pw3); \
    l_reg+=sacc; \
    { float a=MX3(C0[0],C0[1],C1[0]),b=MX3(C0[2],C0[3],C1[1]); a=MX3(a,C1[2],C1[3]); \
      _Pragma("unroll") for(int r=4;r<16;r+=4){a=MX3(a,C0[r],C0[r+1]);b=MX3(b,C0[r+2],C0[r+3]);a=MX3(a,C1[r],C1[r+1]);b=MX3(b,C1[r+2],C1[r+3]);} \
      float rm=__builtin_fmaxf(a,b); { auto rr=__builtin_amdgcn_permlane32_swap(__float_as_uint(rm),__float_as_uint(rm),false,false); rm=__builtin_fmaxf(__uint_as_float(rr[0]),__uint_as_float(rr[1])); } \
      resc=false; \
      if(__builtin_expect(__any(rm>(float)THRL),0)){ const float dl=__builtin_fmaxf(rm,0.f); mhat+=dl; \
        _Pragma("unroll") for(int r=0;r<16;++r){C0[r]-=dl;C1[r]-=dl;} \
        _Pragma("unroll") for(int r=0;r<16;++r)negm[r]=-mhat; asm volatile("":"+v"(negm)); \
        const float f=__builtin_amdgcn_exp2f(-dl); l_reg*=f; if(hi==0)wsf[r32]=f; resc=true; } } \
    SBAR(); \
    GAPB2(o[0]=MF32(PAF(0),VFR(0),o[0]), C0,0);  VRDX(0,0,1); SBAR(); \
    GAPB2(o[1]=MF32(PAF(0),VFR(1),o[1]), C0,2);  VRDX(1,1,1); SBAR(); \
    GAPB2(o[2]=MF32(PAF(0),VFR(2),o[2]), C0,4);  VRDX(2,2,1); SBAR(); \
    GAPB2(o[3]=MF32(PAF(0),VFR(3),o[3]), C0,6);  VRDX(3,3,1); SBAR(); \
    GAPB2(o[0]=MF32(PAF(1),VFR(0),o[0]), C0,8);  VRDX(0,0,2); SBAR(); \
    GAPB2(o[1]=MF32(PAF(1),VFR(1),o[1]), C0,10); VRDX(1,1,2); SBAR(); \
    GAPB2(o[2]=MF32(PAF(1),VFR(2),o[2]), C0,12); VRDX(2,2,2); SBAR(); \
    GAPB2(o[3]=MF32(PAF(1),VFR(3),o[3]), C0,14); VRDX(3,3,2); SBAR(); \
    GAPB2(o[0]=MF32(PAF(2),VFR(0),o[0]), C1,0);  VRDX(0,0,3); SBAR(); \
    GAPB2(o[1]=MF32(PAF(2),VFR(1),o[1]), C1,2);  VRDX(1,1,3); SBAR(); \
    GAPB2(o[2]=MF32(PAF(2),VFR(2),o[2]), C1,4);  VRDX(2,2,3); SBAR(); \
    GAPB2(o[3]=MF32(PAF(2),VFR(3),o[3]), C1,6);  VRDX(3,3,3); SBAR(); \
    GAPB2(o[0]=MF32(PAF(3),VFR(0),o[0]), C1,8); \
    GAPB2(o[1]=MF32(PAF(3),VFR(1),o[1]), C1,10); \
    GAPB2(o[2]=MF32(PAF(3),VFR(2),o[2]), C1,12); \
    GAPB2(o[3]=MF32(PAF(3),VFR(3),o[3]), C1,14); \
    }while(0)
  #define ENDW128(tt) do{ if((tt)+2<NT){WAIT_BAR(3);} else {WAIT_BAR(0);} }while(0)
  for(int t=1;t+1<NT;t+=2){
    STEP128(pB0,pB1,pA0,pA1,t,(t+2<NT),(t+1<NT));       ENDW128(t);   RESC(); ROT();
    STEP128(pA0,pA1,pB0,pB1,t+1,(t+3<NT),(t+2<NT));     ENDW128(t+1); RESC(); ROT();
  }
  STEP128(pB0,pB1,pA0,pA1,NT-1,false,false); RESC();
  { float sacc=pB0[0]+pB0[1]; _Pragma("unroll") for(int r=2;r<16;++r)sacc+=pB0[r]; _Pragma("unroll") for(int r=0;r<16;++r)sacc+=pB1[r]; l_reg+=sacc;
    pw0=(u32x4){PKW(pB0,0),PKW(pB0,2),PKW(pB0,4),PKW(pB0,6)};pw1=(u32x4){PKW(pB0,8),PKW(pB0,10),PKW(pB0,12),PKW(pB0,14)};pw2=(u32x4){PKW(pB1,0),PKW(pB1,2),PKW(pB1,4),PKW(pB1,6)};pw3=(u32x4){PKW(pB1,8),PKW(pB1,10),PKW(pB1,12),PKW(pB1,14)};
    SBAR(); pv128(o,vb0+2*sl_cur,PAF(0),PAF(1),PAF(2),PAF(3)); }
  #undef PKW
  #undef PAF
  #undef VFR
  #undef PIN
  #undef MX3
  #undef GAPA
  #undef GAPB2
  #undef EX
  #undef VRDX
  #undef KRDP
  #undef MF32
  #undef STEP128
  #undef ENDW128
  {auto rr=__builtin_amdgcn_permlane32_swap(__float_as_uint(l_reg),__float_as_uint(l_reg),false,false);l_reg=__uint_as_float(rr[0])+__uint_as_float(rr[1]);}
  if(hi==0)wsf[32+r32]=l_reg;asm volatile("s_waitcnt lgkmcnt(0)":::"memory");
  #pragma unroll
  for(int r=0;r<16;++r){const float rl=__builtin_amdgcn_rcpf(wsf[32+crow(r,hi)]);
    #pragma unroll
    for(int d_=0;d_<4;++d_)o[d_][r]*=rl;}
  asm volatile("s_waitcnt lgkmcnt(0)\n\ts_barrier":::"memory");
  #undef DMA_K
  #undef DMA_V
  #undef START
  #undef RESC
  #undef ROT
}

#undef SBAR
#undef WAIT_BAR
}

constexpr int NWAVES = 8;
constexpr int DM = 1024, NB = 32, SEQ = 2048, NTOK = NB * SEQ, DEPTH = 4, NE = 16, CAP = 256, FF = 2048, NROWS_E = NB * NE * CAP;
constexpr float RMS_EPS = 1e-6f;
constexpr float YE_SCALE = 32.0f, YE_INV = 1.0f / 32.0f;
constexpr float QSCALE = 0.125f * 1.4426950408889634f;
constexpr size_t MiB = 1u << 20;
constexpr size_t WS_CTL = 0, CTL_ZERO_BYTES = 64 * 1024;
constexpr size_t WS_TAB = 1 * MiB;
constexpr size_t WS_MISC = 2 * MiB;
constexpr size_t WS_AFF = 3 * MiB;
constexpr size_t WS_GATE = 7 * MiB;
constexpr size_t WS_TOK = 2 * MiB + 512 * 1024;
constexpr size_t WS_SLOT = 8 * MiB;
constexpr size_t WS_WATT = 10 * MiB, WATT_STRIDE = 8 * MiB, WATT_O = 6 * MiB;
constexpr size_t WS_WMOE = 42 * MiB, WMOE_STRIDE = 96 * MiB, WMOE_D = 64 * MiB;
constexpr size_t WS_H = 426 * MiB;
constexpr size_t WS_H8 = 554 * MiB;
constexpr size_t WS_BIG = 618 * MiB;
constexpr size_t WS_ATT = WS_BIG + 384 * MiB;
constexpr size_t WS_XE = 1130 * MiB;
constexpr size_t WS_XB = 1386 * MiB;
constexpr size_t WS_HID = 1514 * MiB;
constexpr size_t WS_END = 1770 * MiB;
constexpr int CW_BAR = 1024;
constexpr int RING_BYTES = 131072, LDSCTL_OFF = 146432, MISC_OFF = LDSCTL_OFF + 320, LDS_BYTES = 147456;

#define GAS __attribute__((address_space(1)))
#define LAS __attribute__((address_space(3)))
typedef unsigned short bf16;
typedef unsigned v4u __attribute__((ext_vector_type(4)));
typedef unsigned v2u __attribute__((ext_vector_type(2)));
typedef float f32x4 __attribute__((ext_vector_type(4)));
#define LDS_WAIT() asm volatile("s_waitcnt lgkmcnt(0)" ::: "memory")
#define VM_WAIT() asm volatile("s_waitcnt vmcnt(0)" ::: "memory")
__device__ __forceinline__ unsigned pk2(float lo, float hi) { unsigned r; asm volatile("v_cvt_pk_bf16_f32 %0, %1, %2" : "=v"(r) : "v"(lo), "v"(hi)); return r; }
__device__ __forceinline__ float bflo(unsigned w) { return __uint_as_float(w << 16); }
__device__ __forceinline__ float bfhi(unsigned w) { return __uint_as_float(w & 0xffff0000u); }


struct Args {
    const float* x; const float* attn_g; const float* ffn_g; const float* final_g;
    const float* w_in[4]; const float* w_o[4];
    const float* lq1[4]; const float* lk1[4]; const float* lq2[4]; const float* lk2[4]; const float* subln[4];
    const float* qn[4]; const float* kn[4];
    const float* sinks[4];
    const float* w_router; const float* w_gate; const float* w_up; const float* w_down;
    float* out; unsigned char* ws;
};

__device__ __forceinline__ float wave_sum(float v) { return sum64(v); }
__host__ __device__ __forceinline__ int dmap_axial(int u) { const int t = u >> 5, i = u & 31; return i < 16 ? i + 16 * t : 32 + (i - 16) + 16 * t; }

__device__ __forceinline__ void transpose_item(const float* W, size_t ldw, int srccol, bf16* WT, int K, int p0, int k0, LAS float* scr, int lane, const float* kscale = nullptr) {
    const float* src = W + (size_t)k0 * ldw + srccol;
    if (kscale) {
#pragma unroll 16
        for (int kk = 0; kk < 64; ++kk) scr[kk * 65 + lane] = __builtin_nontemporal_load(&src[(size_t)kk * ldw]) * kscale[k0 + kk];
    } else {
#pragma unroll 16
    for (int kk = 0; kk < 64; ++kk) scr[kk * 65 + lane] = __builtin_nontemporal_load(&src[(size_t)kk * ldw]);
    }
    LDS_WAIT(); asm volatile("" ::: "memory");
    const int c = lane & 7;
#pragma unroll
    for (int j = 0; j < 8; ++j) { const int n = (lane >> 3) + 8 * j; const LAS float* s = scr + (8 * c) * 65 + n;
        v4u o; o.x = pk2(s[0 * 65], s[1 * 65]); o.y = pk2(s[2 * 65], s[3 * 65]); o.z = pk2(s[4 * 65], s[5 * 65]); o.w = pk2(s[6 * 65], s[7 * 65]);
        *(v4u*)(WT + (size_t)(p0 + n) * K + k0 + 8 * c) = o; }
    LDS_WAIT(); asm volatile("" ::: "memory");
}

__device__ __forceinline__ void transpose_item_f8(const float* W, size_t ldw, int srccol, unsigned char* WT, int KB, int p0, int k0, LAS float* scr, int lane, float scale) {
    const float* src = W + (size_t)k0 * ldw + srccol;
#pragma unroll 16
    for (int kk = 0; kk < 64; ++kk) scr[kk * 65 + lane] = __builtin_nontemporal_load(&src[(size_t)kk * ldw]);
    LDS_WAIT(); asm volatile("" ::: "memory");
    const int c = lane & 3;
#pragma unroll
    for (int j = 0; j < 4; ++j) { const int n = (lane >> 2) + 16 * j; const LAS float* t = scr + (16 * c) * 65 + n;
        v4u o;
        o.x = pg8::cvt4_fp8(t[0 * 65] * scale, t[1 * 65] * scale, t[2 * 65] * scale, t[3 * 65] * scale);
        o.y = pg8::cvt4_fp8(t[4 * 65] * scale, t[5 * 65] * scale, t[6 * 65] * scale, t[7 * 65] * scale);
        o.z = pg8::cvt4_fp8(t[8 * 65] * scale, t[9 * 65] * scale, t[10 * 65] * scale, t[11 * 65] * scale);
        o.w = pg8::cvt4_fp8(t[12 * 65] * scale, t[13 * 65] * scale, t[14 * 65] * scale, t[15 * 65] * scale);
        *(v4u*)(WT + (size_t)(p0 + n) * KB + k0 + 16 * c) = o; }
    LDS_WAIT(); asm volatile("" ::: "memory");
}

__device__ __forceinline__ float row_rstd(const f32x4 (&v)[4]) {
    float s = 0.f;
#pragma unroll
    for (int j = 0; j < 4; ++j) s += (v[j].x * v[j].x + v[j].y * v[j].y) + (v[j].z * v[j].z + v[j].w * v[j].w);
    return __builtin_amdgcn_rsqf(wave_sum(s) * (1.0f / DM) + RMS_EPS);
}
__device__ __forceinline__ void store_row_bf16(bf16* orow, const f32x4 (&v)[4], int lane) {
    v2u* o8 = (v2u*)orow + lane;
#pragma unroll
    for (int j = 0; j < 4; ++j) { v2u w; w.x = pk2(v[j].x, v[j].y); w.y = pk2(v[j].z, v[j].w); o8[64 * j] = w; }
}


__device__ __forceinline__ void acc_fp8x4(f32x4& v, unsigned w) {
    typedef float f32x2 __attribute__((ext_vector_type(2)));
    const f32x2 lo = __builtin_amdgcn_cvt_pk_f32_fp8((int)w, false), hi = __builtin_amdgcn_cvt_pk_f32_fp8((int)w, true);
    v.x += lo.x * YE_INV; v.y += lo.y * YE_INV; v.z += hi.x * YE_INV; v.w += hi.y * YE_INV;
}
__device__ __forceinline__ void load_row_bf16(f32x4 (&v)[4], const bf16* row, int lane) {
    const v2u* r8 = (const v2u*)row + lane;
#pragma unroll
    for (int j = 0; j < 4; ++j) { const v2u w = r8[64 * j]; v[j].x = bflo(w.x); v[j].y = bfhi(w.x); v[j].z = bflo(w.y); v[j].w = bfhi(w.y); }
}
__device__ __forceinline__ void add_expert_rows(f32x4 (&v)[4], int sl, unsigned mask, int b, const unsigned char* YE, int lane) {
    while (mask) {
        unsigned w[4][4]; bool ok[4];
#pragma unroll
        for (int k = 0; k < 4; ++k) {
            ok[k] = mask != 0u;
            if (ok[k]) { const int e = __builtin_ctz(mask); mask &= mask - 1u; const int c = __builtin_amdgcn_readlane(sl, e);
                const unsigned* yr = (const unsigned*)(YE + ((size_t)((e * 32 + b) * 256 + c)) * DM) + lane;
#pragma unroll
                for (int j = 0; j < 4; ++j) w[k][j] = yr[64 * j]; }
        }
#pragma unroll
        for (int k = 0; k < 4; ++k)
            if (ok[k]) {
#pragma unroll
                for (int j = 0; j < 4; ++j) acc_fp8x4(v[j], w[k][j]); }
    }
}

__device__ __forceinline__ void load_combine2(f32x4 (&va)[4], f32x4 (&vb)[4], const bf16* xa, const bf16* xb, int sla, int slb, int ba, int bb, const unsigned char* YE, int lane) {
    unsigned ma = (unsigned)__ballot(sla >= 0) & 0xffffu, mb = (unsigned)__ballot(slb >= 0) & 0xffffu;
#pragma unroll
    for (int j = 0; j < 4; ++j) { va[j] = (f32x4){0.f, 0.f, 0.f, 0.f}; vb[j] = va[j]; }
    v2u xra[4], xrb[4];
#pragma unroll
    for (int j = 0; j < 4; ++j) { xra[j] = ((const v2u*)xa + lane)[64 * j]; xrb[j] = ((const v2u*)xb + lane)[64 * j]; }
    unsigned wa[3][4], wb[3][4]; bool oa[3], ob[3];
#pragma unroll
    for (int k = 0; k < 3; ++k) { oa[k] = ma != 0u;
        if (oa[k]) { const int e = __builtin_ctz(ma); ma &= ma - 1u; const int c = __builtin_amdgcn_readlane(sla, e); const unsigned* yr = (const unsigned*)(YE + ((size_t)((e * 32 + ba) * 256 + c)) * DM) + lane;
#pragma unroll
            for (int j = 0; j < 4; ++j) wa[k][j] = yr[64 * j]; } }
#pragma unroll
    for (int k = 0; k < 3; ++k) { ob[k] = mb != 0u;
        if (ob[k]) { const int e = __builtin_ctz(mb); mb &= mb - 1u; const int c = __builtin_amdgcn_readlane(slb, e); const unsigned* yr = (const unsigned*)(YE + ((size_t)((e * 32 + bb) * 256 + c)) * DM) + lane;
#pragma unroll
            for (int j = 0; j < 4; ++j) wb[k][j] = yr[64 * j]; } }
#pragma unroll
    for (int j = 0; j < 4; ++j) { va[j].x = bflo(xra[j].x); va[j].y = bfhi(xra[j].x); va[j].z = bflo(xra[j].y); va[j].w = bfhi(xra[j].y);
                                  vb[j].x = bflo(xrb[j].x); vb[j].y = bfhi(xrb[j].x); vb[j].z = bflo(xrb[j].y); vb[j].w = bfhi(xrb[j].y); }
#pragma unroll
    for (int k = 0; k < 3; ++k) if (oa[k]) {
#pragma unroll
        for (int j = 0; j < 4; ++j) acc_fp8x4(va[j], wa[k][j]); }
#pragma unroll
    for (int k = 0; k < 3; ++k) if (ob[k]) {
#pragma unroll
        for (int j = 0; j < 4; ++j) acc_fp8x4(vb[j], wb[k][j]); }
    if (ma) add_expert_rows(va, sla, ma, ba, YE, lane);
    if (mb) add_expert_rows(vb, slb, mb, bb, YE, lane);
}


#define XB_TMO      128
#define XB_XCNT(j)  (256  + 64 * (j))
#define XB_XSUB(j)  (1280 + 64 * (j))
#define XB_XGEN(j)  (2304 + 64 * (j))
#define XB_TOP      3328
#define XB_TOPGEN   3392
#define XCD_BAR_WORDS 3456
#define XB_SPIN_CAP (1u << 18)

__device__ __forceinline__ unsigned xb_ld(unsigned* p)              { return __hip_atomic_load(p, __ATOMIC_RELAXED, __HIP_MEMORY_SCOPE_AGENT); }
__device__ __forceinline__ unsigned xb_add(unsigned* p, unsigned v) { return __hip_atomic_fetch_add(p, v, __ATOMIC_RELAXED, __HIP_MEMORY_SCOPE_AGENT); }
__device__ __forceinline__ unsigned xb_xcc_id() { return (unsigned)__builtin_amdgcn_s_getreg((3 << 11) | 20) & 0xFu; }
#define XB_SPIN(cond, bar) do { unsigned _sp = 0; while (cond) { __builtin_amdgcn_s_sleep(1); \
    if ((++_sp & 255u) == 0u) { if (xb_ld(&(bar)[XB_TMO])) break; if (_sp > XB_SPIN_CAP) { atomicAdd(&(bar)[XB_TMO], 1u); break; } } } } while (0)

struct XcdBarrier {
    unsigned* bar; unsigned x;
    volatile LAS unsigned* st;
};

__device__ __forceinline__ XcdBarrier xcd_barrier_post(unsigned* bar, volatile LAS unsigned* st) {
    XcdBarrier b; b.bar = bar; b.x = xb_xcc_id(); b.st = st;
    if (threadIdx.x == 0) st[2] = xb_add(&bar[XB_XCNT(b.x)], 1u);
    return b;
}
__device__ __forceinline__ void xcd_barrier_complete(unsigned* bar, unsigned x, unsigned& nloc, unsigned& nx, unsigned& even) {
    const unsigned G = gridDim.x * gridDim.y * gridDim.z;
    unsigned sum, cnt, mine, sp = 0u, c32;
    for (;;) {
        sum = 0u; cnt = 0u; mine = 0u; c32 = 0u;
#pragma unroll
        for (unsigned j = 0; j < 16; ++j) { const unsigned c = xb_ld(&bar[XB_XCNT(j)]); sum += c; cnt += (c > 0u) ? 1u : 0u; c32 += (j < 8u && c == 32u) ? 1u : 0u; mine = (j == x) ? c : mine; }
        if (sum == G) break;
        __builtin_amdgcn_s_sleep(1);
        if ((++sp & 255u) == 0u) { if (xb_ld(&bar[XB_TMO])) break; if (sp > XB_SPIN_CAP) { atomicAdd(&bar[XB_TMO], 1u); break; } }
    }
    nloc = mine > 0u ? mine : 1u; nx = cnt > 0u ? cnt : 1u;
    even = (sum == G && G == 256u && c32 == 8u) ? 1u : 0u;
}

__device__ __forceinline__ void xcd_barrier(const XcdBarrier& b, bool local_only = false) {
    asm volatile("s_waitcnt vmcnt(0)" ::: "memory");
    __syncthreads();
    if (threadIdx.x == 0) {
        size_t zb_ = 0; asm volatile("" : "+s"(zb_)); unsigned* bar = b.bar + zb_; unsigned bx_ = b.x; asm volatile("" : "+s"(bx_));
        __builtin_amdgcn_s_waitcnt(0);
        unsigned nloc = b.st[0], nx = b.st[1];
        const unsigned old = xb_add(&bar[XB_XSUB(bx_)], 1u);
        const unsigned gen = old / nloc;
        if (old + 1u == (gen + 1u) * nloc) {
            __builtin_amdgcn_fence(__ATOMIC_RELEASE, "agent");
            asm volatile("s_waitcnt vmcnt(0)" ::: "memory");
            if (!local_only) {
            const unsigned og = xb_add(&bar[XB_TOP], 1u);
            const unsigned tg = og / nx;
            if (og + 1u == (tg + 1u) * nx) xb_add(&bar[XB_TOPGEN], 1u);
            else XB_SPIN(xb_ld(&bar[XB_TOPGEN]) == tg, bar);
            }
            __builtin_amdgcn_fence(__ATOMIC_ACQUIRE, "agent");
            xb_add(&bar[XB_XGEN(bx_)], 1u);
            asm volatile("s_waitcnt vmcnt(0)" ::: "memory");
        } else {
            XB_SPIN(xb_ld(&bar[XB_XGEN(bx_)]) == gen, bar);
            __builtin_amdgcn_fence(__ATOMIC_ACQUIRE, "agent");
            asm volatile("s_waitcnt vmcnt(0)" ::: "memory");
        }
    }
    __syncthreads();
}


__global__ void __launch_bounds__(NWAVES * 64, 2) mk_fwd(Args args) {
    extern __shared__ __attribute__((aligned(16))) unsigned char lds[];
    LAS unsigned char* ldsl = (LAS unsigned char*)lds;
    const int G = gridDim.x;
    const int wave0 = __builtin_amdgcn_readfirstlane((int)threadIdx.x >> 6);
    const int NGW = G * NWAVES;
#define PHASE_IDS() const int tid = fresh_tid(wave0), lane = tid & 63, wave = __builtin_amdgcn_readfirstlane(tid >> 6), gw = vcu * NWAVES + wave; (void)gw; (void)lane; (void)tid; size_t zero_ = 0; asm volatile("" : "+s"(zero_)); unsigned char* ws = args.ws + zero_; float* XR = args.out + zero_; (void)XR
    unsigned* ctl = (unsigned*)(args.ws + WS_CTL);
#define tab ((float*)(ws + WS_TAB))
#define gperm ((float*)(ws + WS_MISC))
#define AFF ((float*)(ws + WS_AFF))
#define GATE ((float*)(ws + WS_GATE))
#define SLOT ((short*)(ws + WS_SLOT))
#define TOK ((int*)(ws + WS_TOK))
#define H ((bf16*)(ws + WS_H))
#define QKV ((bf16*)(ws + WS_BIG))
#define ATT ((bf16*)(ws + WS_ATT))
#define HID8 (ws + WS_HID)
#define XE ((bf16*)(ws + WS_XE))
#define XE8 (ws + WS_XE)
#define H8 (ws + WS_H8)
#define XB ((bf16*)(ws + WS_XB))
#define RSTD ((float*)(ws + WS_MISC + 65536))
    for (int u = threadIdx.x; u < (LDS_BYTES - LDSCTL_OFF) / 4; u += NWAVES * 64) ((LAS unsigned*)(ldsl + LDSCTL_OFF))[u] = 0u;
    __syncthreads();
    volatile LAS unsigned* MISC = (volatile LAS unsigned*)(ldsl + MISC_OFF);
    XcdBarrier bar = xcd_barrier_post(ctl + CW_BAR, MISC + 8);
    if (threadIdx.x == 0) { unsigned nloc_, nx_, even_; xcd_barrier_complete(bar.bar, bar.x, nloc_, nx_, even_); MISC[8] = nloc_; MISC[9] = nx_; MISC[11] = even_; }
    __syncthreads();
    const int gmode = __builtin_amdgcn_readfirstlane((int)MISC[11]);
    const int bx = gmode ? __builtin_amdgcn_readfirstlane((int)MISC[10]) * 8 + (int)bar.x : (int)blockIdx.x;
    const int vcu = (G % 8 == 0) ? (bx % 8) * (G / 8) + bx / 8 : bx;
#define PHASE_ON() true
    if (PROBE_TYPE >= 0 && blockIdx.x == 0 && threadIdx.x == 0) __hip_atomic_store(ctl + 2049, (unsigned)__builtin_amdgcn_s_memrealtime(), __ATOMIC_RELAXED, __HIP_MEMORY_SCOPE_AGENT);
#ifndef EN_P0
#define EN_P0 1
#endif
#ifndef EN_N1
#define EN_N1 1
#endif
#ifndef EN_G1
#define EN_G1 1
#endif
#ifndef EN_AT
#define EN_AT 1
#endif
#ifndef EN_ATA
#define EN_ATA 1
#endif
#ifndef EN_ATB
#define EN_ATB 1
#endif
#ifndef EN_G2
#define EN_G2 1
#endif
#ifndef EN_N2
#define EN_N2 1
#endif
#ifndef EN_TK
#define EN_TK 1
#endif
#ifndef EN_G3
#define EN_G3 1
#endif
#ifndef EN_G4
#define EN_G4 1
#endif
#ifndef EN_FIN
#define EN_FIN 1
#endif
#define PHASE_END(KIND) do { xcd_barrier(bar, (KIND) != 0 && gmode != 0); if (PROBE_TYPE >= 0 && blockIdx.x == 0 && threadIdx.x == 0) { const unsigned t_ = (unsigned)__builtin_amdgcn_s_memrealtime(); \
    const unsigned p_ = __hip_atomic_load(ctl + 2049, __ATOMIC_RELAXED, __HIP_MEMORY_SCOPE_AGENT); __hip_atomic_store(ctl + 2049, t_, __ATOMIC_RELAXED, __HIP_MEMORY_SCOPE_AGENT); \
    if ((KIND) == PROBE_TYPE) __hip_atomic_fetch_add(ctl + 2048, t_ - p_, __ATOMIC_RELAXED, __HIP_MEMORY_SCOPE_AGENT); } } while (0)

    if (EN_P0 && PHASE_ON()) {
            PHASE_IDS();
        for (int i = gw * 64 + lane; i < 2 * SEQ * 32; i += NGW * 64) {
            const int which = i >> 16, s = (i >> 5) & 2047, f = i & 31; float ang;
            if (which == 0) ang = (float)s * exp2f(-(float)f * (13.287712379549449f / 32.0f));
            else ang = (float)(f < 16 ? (s >> 6) : (s & 63)) * exp2f(-(float)(f & 15) * (13.287712379549449f / 16.0f));
            tab[which * 131072 + s * 32 + f] = cosf(ang); tab[which * 131072 + 65536 + s * 32 + f] = sinf(ang);
        }
        if (gw == 0) { gperm[lane] = args.qn[1][dmap_axial(lane)]; gperm[64 + lane] = args.kn[1][dmap_axial(lane)]; }
        LAS float* scr = (LAS float*)(ldsl + wave * 16640);
        {
            constexpr int IT_A = 16 * 48 + 256, IT_B = 16 * 24 + 256, IT_ALL = 2 * IT_A + 2 * IT_B;
            for (int it = gw; it < IT_ALL; it += NGW) {
                int l, r = it;
                if (r < IT_A) l = 0; else { r -= IT_A; if (r < IT_B) l = 1; else { r -= IT_B; if (r < IT_B) l = 2; else { r -= IT_B; l = 3; } } }
                const int m = l % 3, n1 = (m == 0) ? 3072 : 1536, nin = 16 * (n1 / 64);
                bf16* wt = (bf16*)(ws + WS_WATT + (size_t)l * WATT_STRIDE);
                if (r < nin) { const int kb = r / (n1 / 64), pb = r % (n1 / 64), p = pb * 64 + lane;
                    const int pn = p >> 8, bj = (p >> 7) & 1, wc = (p >> 5) & 3, i = p & 31, hd = 4 * pn + wc, u = 32 * bj + i;
                    const int d = (m == 1 && hd < 20) ? dmap_axial(u) : u;
                    transpose_item(args.w_in[l], (size_t)n1, 64 * hd + d, wt, DM, pb * 64, kb * 64, scr, lane, args.attn_g + l * DM);
                } else { r -= nin; const int kb = r / 16, pb = r % 16;
                    transpose_item(args.w_o[l], (size_t)DM, pb * 64 + lane, (bf16*)((unsigned char*)wt + WATT_O), DM, pb * 64, kb * 64, scr, lane); }
            }
        }
        for (int it = gw; it < DEPTH * NE * 1536; it += NGW) {
            const int le = it / 1536, r = it % 1536, l = le >> 4, e = le & 15;
            unsigned char* wgu = ws + WS_WMOE + (size_t)l * WMOE_STRIDE + (size_t)e * 4096 * DM;
            unsigned char* wd = ws + WS_WMOE + (size_t)l * WMOE_STRIDE + WMOE_D + (size_t)e * DM * FF;
            if (r < 1024) { const int kb = r >> 6, pb = r & 63, bjj = (pb >> 1) & 1;
                const float* srcm = (bjj ? args.w_up : args.w_gate) + (size_t)le * DM * FF;
                transpose_item_f8(srcm, (size_t)FF, 128 * (pb >> 2) + 64 * (pb & 1) + lane, wgu, DM, pb * 64, kb * 64, scr, lane, pg8::W8_SCALE);
            } else { const int r2 = r - 1024, kb = r2 >> 4, pb = r2 & 15;
                transpose_item_f8(args.w_down + (size_t)le * FF * DM, (size_t)DM, 256 * (pb >> 2) + 64 * (2 * (pb & 1) + (lane >> 5)) + 32 * ((pb >> 1) & 1) + (lane & 31), wd, FF, pb * 64, kb * 64, scr, lane, pg8::W8_SCALE); }
        }
        {
            f32x4 g[4];
#pragma unroll
            for (int j = 0; j < 4; ++j) g[j] = ((const f32x4*)args.attn_g)[lane + 64 * j];
            for (int m = gw; m < NTOK; m += NGW) {
                const f32x4* xr = (const f32x4*)(args.x + (size_t)m * DM) + lane; f32x4 v[4];
#pragma unroll
                for (int j = 0; j < 4; ++j) v[j] = __builtin_nontemporal_load(&xr[64 * j]);
                store_row_bf16(XB + (size_t)m * DM, v, lane);
                const float rstd = row_rstd(v);
                if (lane == 0) RSTD[m] = rstd;
            }
        }
    }
    PHASE_END(0);

    for (int layer = 0; layer < DEPTH; ++layer) {
        const int mix = layer % 3;
        const int n1 = (mix == 0) ? 3072 : 1536;
#define Win_t ((const bf16*)(ws + WS_WATT + (size_t)layer * WATT_STRIDE))
#define Wo_t ((const bf16*)(ws + WS_WATT + (size_t)layer * WATT_STRIDE + WATT_O))
#define Wgu8 (ws + WS_WMOE + (size_t)layer * WMOE_STRIDE)
#define Wd8 (ws + WS_WMOE + (size_t)layer * WMOE_STRIDE + WMOE_D)

        if (layer > 0) {
            if (EN_N1 && PHASE_ON()) {
            PHASE_IDS();
                f32x4 g[4];
#pragma unroll
                for (int j = 0; j < 4; ++j) g[j] = ((const f32x4*)(args.attn_g + layer * DM))[lane + 64 * j];
              for (int rbk = vcu; rbk < NTOK / 256; rbk += G) {
                const int mbeg = rbk * 256 + wave, mend = rbk * 256 + 256;
                int sla = (lane < 16) ? (int)SLOT[(size_t)mbeg * 16 + lane] : -1, slb = (lane < 16) ? (int)SLOT[(size_t)(mbeg + 8) * 16 + lane] : -1;
                for (int m = mbeg; m < mend; m += 16) {
                    const int m2 = m + 8;
                    const int mn = m + 16; int sna = -1, snb = -1;
                    if (mn < mend) { sna = (lane < 16) ? (int)SLOT[(size_t)mn * 16 + lane] : -1; snb = (lane < 16) ? (int)SLOT[(size_t)(mn + 8) * 16 + lane] : -1; }
                    f32x4 va[4], vb[4];
                    load_combine2(va, vb, XB + (size_t)m * DM, XB + (size_t)m2 * DM, sla, slb, m >> 11, m2 >> 11, XE8, lane);
                    store_row_bf16(XB + (size_t)m * DM, va, lane);
                    const float ra = row_rstd(va);
                    if (lane == 0) RSTD[m] = ra;
                    if (m2 != m) {
                        store_row_bf16(XB + (size_t)m2 * DM, vb, lane);
                        const float rb = row_rstd(vb);
                        if (lane == 0) RSTD[m2] = rb;
                    }
                    sla = sna; slb = snb;
                }
              }
            }
            PHASE_END(1);
        }

        if (EN_G1 && PHASE_ON()) {
            PHASE_IDS();
              pg8::Gemm g{XB, Win_t, NTOK, n1, DM}; pg8::StaticOrder S; S.init(NTOK, n1, G, bx);
            const float* tc = tab + (mix == 1 ? 131072 : 0);
            LAS float* gl = (LAS float*)(ldsl + RING_BYTES);
            if (mix == 1 && tid < 128) gl[tid] = gperm[tid];
            __syncthreads();
            pg8::EpiQKV E{QKV, 3072  , tc, tc + 65536, (mix == 0) ? 8 : 5, 4, (mix == 1) ? gl : nullptr, (mix == 1) ? gl + 64 : nullptr, QSCALE, RSTD};
            pg8::gemm_phase<pg8::EpiQKV, pg8::StaticOrder, true, true>(ldsl, g, S, E, wave0);
        }
        PHASE_END(2);

        if (EN_AT && PHASE_ON()) {
            PHASE_IDS();
          for (int rb = vcu; rb < NTOK / 256; rb += G) {
            const int b = rb >> 3, qb = rb & 7;
            const int tid = fresh_tid(wave0), lane = tid & 63, wave = __builtin_amdgcn_readfirstlane(tid >> 6); (void)lane; (void)wave; (void)tid; size_t zs_ = 0; asm volatile("" : "+s"(zs_)); unsigned char* ws = args.ws + zs_;
            if (EN_ATA && mix == 0) {
                const int jl = layer / 3;
                const float lambda_init = (layer == 0) ? 0.2f : 0.55605820416f;
                const float s1 = wave_sum(args.lq1[layer][lane] * args.lk1[layer][lane]), s2 = wave_sum(args.lq2[layer][lane] * args.lk2[layer][lane]);
                const float lam = __uint_as_float(__builtin_amdgcn_readfirstlane(__float_as_uint(__expf(s1) - __expf(s2) + lambda_init))); (void)jl;
                const float* subg = args.subln[layer];
                LAS unsigned* stash = (LAS unsigned*)(ldsl + 75776) + tid;
                for (int h = 0; h < 8; ++h) {
                    const bf16* base = QKV + (size_t)(b * SEQ) * 3072;
                    att::f32x16 o[4];
#pragma unroll 1
                    for (int c = 0; c < 2; ++c) {
                        __syncthreads();
                        ab2::attn_unit128<8, 3072>(o, (const ab2::bf16*)(base + (size_t)(qb * 256) * 3072 + 64 * (2 * h + c)), (const ab2::bf16*)(base + 1024 + 64 * (2 * h + c)), (const ab2::bf16*)(base + 2048 + 128 * h), SEQ / 64, (char*)lds, wave0);
                        if (c == 0) {
#pragma unroll
                            for (int d = 0; d < 4; ++d)
#pragma unroll
                                for (int q = 0; q < 8; ++q) stash[(d * 8 + q) * 512] = att::cvtpk(o[d][2 * q], o[d][2 * q + 1]);
                        }
                    }
                    float ss[16], gs[4];
#pragma unroll
                    for (int d = 0; d < 4; ++d) gs[d] = subg[32 * d + (lane & 31)] * (1.0f - lambda_init);
#pragma unroll
                    for (int r = 0; r < 16; ++r) ss[r] = 0.f;
#pragma unroll
                    for (int d = 0; d < 4; ++d)
#pragma unroll
                        for (int q = 0; q < 8; ++q) { const unsigned w = stash[(d * 8 + q) * 512];
                            const float a = bflo(w) - lam * o[d][2 * q], bq = bfhi(w) - lam * o[d][2 * q + 1];
                            o[d][2 * q] = a; o[d][2 * q + 1] = bq; ss[2 * q] += a * a; ss[2 * q + 1] += bq * bq; }
#pragma unroll
                    for (int r = 0; r < 16; ++r) { const float s = sum32(ss[r]);
                        const float rstd = __builtin_amdgcn_rsqf(s * (1.0f / 128.0f) + RMS_EPS);
#pragma unroll
                        for (int d = 0; d < 4; ++d) o[d][r] *= rstd * gs[d]; }
                    {
                        const int t2 = fresh_tid(wave0), l2 = t2 & 63, w2 = __builtin_amdgcn_readfirstlane(t2 >> 6);
                        LAS unsigned char* stg = ldsl + 75776 + w2 * 256;
                        att::stage_o<4>(o, stg, 2048, l2);
                        asm volatile("s_waitcnt lgkmcnt(0)" ::: "memory");
                        const LAS unsigned char* sp = stg + (l2 >> 4) * 2048 + (l2 & 15) * 16;
                        bf16* op = ATT + (size_t)(b * SEQ + qb * 256 + w2 * 32 + (l2 >> 4)) * DM + 128 * h + (l2 & 15) * 8;
#pragma unroll
                        for (int i = 0; i < 8; ++i) { const v4u v = *(const LAS v4u*)(sp + i * 8192); *(v4u*)(op + (size_t)i * 4 * DM) = v; }
                        asm volatile("s_waitcnt lgkmcnt(0)" ::: "memory");
                    }
                }
            } else if (EN_ATB && mix == 1) {
                for (int hq = 0; hq < 16; ++hq) { const int kvh = hq >> 2;
                    const bf16* base = QKV + (size_t)(b * SEQ) * 3072;
                    att::f32x16 o[2];
                    __syncthreads();
                    ab2::attn_unit<8, 3072, 1024, false>((const ab2::bf16*)(base + (size_t)(qb * 256) * 3072 + 64 * hq), (const ab2::bf16*)(base + 1024 + 64 * kvh), (const ab2::bf16*)(base + 1280 + 64 * kvh),
                                                         (ab2::bf16*)(ATT + (size_t)(b * SEQ + qb * 256) * DM + 64 * hq), SEQ / 64, 0, 0, -__builtin_inff(), (char*)lds, wave0);
                }
            } else if (EN_ATB) {
                for (int hp = 0; hp < 8; ++hp)
                for (int qh = 0; qh < 2; ++qh) { const int hq = 2 * hp, kvh = hq >> 2, q0 = qb * 256 + qh * 128;
                    const bf16* base = QKV + (size_t)(b * SEQ) * 3072;
                    att::f32x16 o[2];
                    __syncthreads();
                    const int klo = (q0 - 128) < 0 ? 0 : q0 - 128, khi = (q0 + 256) > SEQ ? SEQ : q0 + 256;
                    ab2::attn_unit<8, 3072, 1024, true, true>((const ab2::bf16*)(base + (size_t)q0 * 3072 + 64 * hq), (const ab2::bf16*)(base + (size_t)klo * 3072 + 1024 + 64 * kvh), (const ab2::bf16*)(base + (size_t)klo * 3072 + 1280 + 64 * kvh),
                                                        (ab2::bf16*)(ATT + (size_t)(b * SEQ + q0) * DM + 64 * hq), (khi - klo) / 64, q0, klo, args.sinks[layer][hq] * 1.4426950408889634f, (char*)lds, wave0,
                                                        args.sinks[layer][hq + 1] * 1.4426950408889634f);
                }
            }
          }
        }
        PHASE_END(3 + mix);

        if (EN_G2 && PHASE_ON()) {
            PHASE_IDS();
            pg8::Gemm g{ATT, Wo_t, NTOK, DM, DM}; pg8::StaticOrder S; S.init(NTOK, DM, G, bx);
            pg8::EpiResBf16 E{XB, DM};
            pg8::gemm_phase<pg8::EpiResBf16, pg8::StaticOrder, true, true>(ldsl, g, S, E, wave0);
        }
        PHASE_END(6);

        if (EN_N2 && PHASE_ON()) {
            PHASE_IDS();
            LAS float* wr = (LAS float*)ldsl;
            const float* wsrc = args.w_router + (size_t)layer * DM * NE;
            for (int i4 = tid; i4 < DM * NE / 4; i4 += NWAVES * 64) { const f32x4 w = ((const f32x4*)wsrc)[i4]; const int col = i4 >> 2, e0 = (i4 & 3) * 4;
                wr[(e0 + 0) * DM + col] = w.x; wr[(e0 + 1) * DM + col] = w.y; wr[(e0 + 2) * DM + col] = w.z; wr[(e0 + 3) * DM + col] = w.w; }
            __syncthreads();
            f32x4 g[4];
#pragma unroll
            for (int j = 0; j < 4; ++j) g[j] = ((const f32x4*)(args.ffn_g + layer * DM))[lane + 64 * j];
            const bool hb3 = (lane & 8) != 0, hb2 = (lane & 4) != 0, hb1 = (lane & 2) != 0, hb0 = (lane & 1) != 0;
            for (int rbk = vcu; rbk < NTOK / 256; rbk += G)
            for (int m0 = rbk * 256 + wave * 4; m0 < rbk * 256 + 256; m0 += NWAVES * 4) {
                f32x4 v[4][4];
#pragma unroll
                for (int t = 0; t < 4; ++t) load_row_bf16(v[t], XB + (size_t)(m0 + t) * DM, lane);
#pragma unroll
                for (int t = 0; t < 4; ++t) { const float rstd = row_rstd(v[t]); unsigned* o4 = (unsigned*)(H8 + (size_t)(m0 + t) * DM) + lane;
#pragma unroll
                    for (int j = 0; j < 4; ++j) { v[t][j] = v[t][j] * rstd * g[j]; o4[64 * j] = pg8::cvt4_fp8(v[t][j].x, v[t][j].y, v[t][j].z, v[t][j].w); } }
                typedef float f32x2 __attribute__((ext_vector_type(2)));
                f32x2 vp[2][4][4];
#pragma unroll
                for (int p = 0; p < 2; ++p)
#pragma unroll
                    for (int j = 0; j < 4; ++j)
#pragma unroll
                        for (int c = 0; c < 4; ++c) vp[p][j][c] = (f32x2){v[2 * p][j][c], v[2 * p + 1][j][c]};
                float acc[4][16];
#pragma unroll
                for (int e = 0; e < 16; ++e) {
                    f32x2 a2[2] = {(f32x2){0.f, 0.f}, (f32x2){0.f, 0.f}};
#pragma unroll
                    for (int j = 0; j < 4; ++j) { const f32x4 w = *(const LAS f32x4*)(wr + e * DM + 256 * j + 4 * lane);
#pragma unroll
                        for (int p = 0; p < 2; ++p)
#pragma unroll
                            for (int c = 0; c < 4; ++c) a2[p] = __builtin_elementwise_fma(vp[p][j][c], (f32x2){w[c], w[c]}, a2[p]); }
                    acc[0][e] = a2[0].x; acc[1][e] = a2[0].y; acc[2][e] = a2[1].x; acc[3][e] = a2[1].y;
                    if (e & 1) __builtin_amdgcn_sched_barrier(0);
                }
                float a8[4][8], b4[4][4], c2[4][2], d1[4], e2[2];
#pragma unroll
                for (int t = 0; t < 4; ++t)
#pragma unroll
                    for (int e = 0; e < 8; ++e) { auto r = __builtin_amdgcn_permlane32_swap(__float_as_uint(acc[t][e]), __float_as_uint(acc[t][e + 8]), false, false); a8[t][e] = __uint_as_float(r[0]) + __uint_as_float(r[1]); }
#pragma unroll
                for (int t = 0; t < 4; ++t)
#pragma unroll
                    for (int e = 0; e < 4; ++e) { auto r = __builtin_amdgcn_permlane16_swap(__float_as_uint(a8[t][e]), __float_as_uint(a8[t][e + 4]), false, false); b4[t][e] = __uint_as_float(r[0]) + __uint_as_float(r[1]); }
#pragma unroll
                for (int t = 0; t < 4; ++t)
#pragma unroll
                    for (int e = 0; e < 2; ++e) { const float keep = hb3 ? b4[t][e + 2] : b4[t][e], send = hb3 ? b4[t][e] : b4[t][e + 2]; c2[t][e] = keep + dpp_mirror(send); }
#pragma unroll
                for (int t = 0; t < 4; ++t) { const float keep = hb2 ? c2[t][1] : c2[t][0], send = hb2 ? c2[t][0] : c2[t][1]; d1[t] = keep + dpp_hmirror(send); }
#pragma unroll
                for (int t = 0; t < 2; ++t) { const float keep = hb1 ? d1[t + 2] : d1[t], send = hb1 ? d1[t] : d1[t + 2]; e2[t] = keep + dpp_xor2(send); }
                const float lg = (hb0 ? e2[1] : e2[0]) + dpp_xor1(hb0 ? e2[0] : e2[1]);
                float mx = fmaxf(lg, dpp_ror4(lg)); mx = fmaxf(mx, dpp_ror8(mx));
                { auto r = __builtin_amdgcn_permlane16_swap(__float_as_uint(mx), __float_as_uint(mx), false, false); mx = fmaxf(__uint_as_float(r[0]), __uint_as_float(r[1])); }
                { auto r = __builtin_amdgcn_permlane32_swap(__float_as_uint(mx), __float_as_uint(mx), false, false); mx = fmaxf(__uint_as_float(r[0]), __uint_as_float(r[1])); }
                const float p = __expf(lg - mx);
                float sm = p + dpp_ror4(p); sm += dpp_ror8(sm); sm = sum_swap32(sum_swap16(sm));
                AFF[((size_t)(m0 >> 11) * 16 + (lane >> 2)) * SEQ + (m0 & 2047) + (lane & 3)] = p / sm;
            }
            __syncthreads();
        }
        PHASE_END(7);

        if (EN_TK && PHASE_ON()) {
            PHASE_IDS();
            LAS unsigned* red = (LAS unsigned*)ldsl;
            for (int pi = vcu; pi < NTOK / 256; pi += G)
            for (int ee = 0; ee < 2; ++ee) {
                const int b = pi >> 3, e = 2 * (pi & 7) + ee, pair = b * 16 + e;
                const f32x4 av = ((const f32x4*)(AFF + (size_t)pair * SEQ))[tid];
                const unsigned u0 = __float_as_uint(av.x), u1 = __float_as_uint(av.y), u2 = __float_as_uint(av.z), u3 = __float_as_uint(av.w);
                unsigned prefix = 0u;
                for (int bit = 30; bit >= 0; --bit) {
                    const unsigned cand = prefix | (1u << bit);
                    const unsigned cw = (unsigned)__popcll(__ballot(u0 >= cand)) + (unsigned)__popcll(__ballot(u1 >= cand)) + (unsigned)__popcll(__ballot(u2 >= cand)) + (unsigned)__popcll(__ballot(u3 >= cand));
                    LAS unsigned* rb = red + (bit & 1) * 8;
                    if (lane == 0) rb[wave] = cw;
                    __syncthreads();
                    unsigned tot = 0;
#pragma unroll
                    for (int w = 0; w < 8; ++w) tot += rb[w];
                    if (tot >= (unsigned)CAP) prefix = cand;
                }
                const unsigned T = prefix;
                const unsigned g0 = u0 > T, g1 = u1 > T, g2 = u2 > T, g3 = u3 > T, q0 = u0 == T, q1 = u1 == T, q2 = u2 == T, q3 = u3 == T;
                const unsigned long long bg0 = __ballot(g0), bg1 = __ballot(g1), bg2 = __ballot(g2), bg3 = __ballot(g3), bq0 = __ballot(q0), bq1 = __ballot(q1), bq2 = __ballot(q2), bq3 = __ballot(q3);
#define MBC(m) __builtin_amdgcn_mbcnt_hi((unsigned)((m) >> 32), __builtin_amdgcn_mbcnt_lo((unsigned)(m), 0u))
                const unsigned pre = (MBC(bg0) + MBC(bg1) + MBC(bg2) + MBC(bg3)) | ((MBC(bq0) + MBC(bq1) + MBC(bq2) + MBC(bq3)) << 16);
#undef MBC
                const unsigned wtot = (unsigned)(__popcll(bg0) + __popcll(bg1) + __popcll(bg2) + __popcll(bg3)) | ((unsigned)(__popcll(bq0) + __popcll(bq1) + __popcll(bq2) + __popcll(bq3)) << 16);
                LAS unsigned* tot8 = red + 16;
                __syncthreads();
                if (lane == 0) tot8[wave] = wtot;
                __syncthreads();
                unsigned woff = 0, all = 0;
#pragma unroll
                for (int w = 0; w < 8; ++w) { const unsigned t = tot8[w]; all += t; woff += (w < wave) ? t : 0u; }
                const unsigned excl = pre + woff;
                int bg = (int)(excl & 0xffffu), be = (int)(excl >> 16); const int ngt = (int)(all & 0xffffu), need = CAP - ngt;
                const size_t rowbase = (size_t)(e * 32 + b) * 256;
                int sl[4]; const unsigned gg[4] = {g0, g1, g2, g3}, qq[4] = {q0, q1, q2, q3}; const float vv[4] = {av.x, av.y, av.z, av.w};
#pragma unroll
                for (int q = 0; q < 4; ++q) { int s = -1;
                    if (gg[q]) s = bg++; else if (qq[q]) { const int r = be++; s = (r < need) ? ngt + r : -1; }
                    sl[q] = s;
                    if (s >= 0) { TOK[rowbase + s] = b * SEQ + 4 * tid + q; GATE[rowbase + s] = vv[q]; }
                    SLOT[((size_t)(b * SEQ + 4 * tid + q)) * 16 + e] = (short)s; }
                __syncthreads();
            }
        }
        PHASE_END(8);

        if (EN_G3 && PHASE_ON()) {
            PHASE_IDS();
              pg8::Gemm g{(const pg8::bf16_t*)H8, (const pg8::bf16_t*)Wgu8, NROWS_E, NE * 4096, DM, TOK}; pg8::GroupedOrder<16> S; S.init(G, bx);
            pg8::EpiSwiGLU8 E{HID8, FF};
            pg8::gemm_phase<pg8::EpiSwiGLU8, pg8::GroupedOrder<16>, true, true, true, true>(ldsl, g, S, E, wave0);
        }
        PHASE_END(9);

        if (EN_G4 && PHASE_ON()) {
            PHASE_IDS();
            pg8::Gemm g{(const pg8::bf16_t*)HID8, (const pg8::bf16_t*)Wd8, NROWS_E, NE * DM, FF, nullptr, GATE}; pg8::GroupedOrder<4> S; S.init(G, bx);
            pg8::EpiDown E{XE8, DM, (const LAS float*)(ldsl + pg8::STAGE_BYTES + 9216), YE_SCALE};
            pg8::gemm_phase<pg8::EpiDown, pg8::GroupedOrder<4>, true, true, true, false, true>(ldsl, g, S, E, wave0);
        }
        PHASE_END(10);
    }

    if (EN_FIN && PHASE_ON()) {
            PHASE_IDS();
        f32x4 g[4];
#pragma unroll
        for (int j = 0; j < 4; ++j) g[j] = ((const f32x4*)args.final_g)[lane + 64 * j];
        const float pscale_ = (PROBE_TYPE >= 0) ? 1.0f + (float)__hip_atomic_load(ctl + 2048, __ATOMIC_RELAXED, __HIP_MEMORY_SCOPE_AGENT) * 5e-6f : 1.0f;
      for (int rbk = vcu; rbk < NTOK / 256; rbk += G) {
        const int mbeg = rbk * 256 + wave, mend = rbk * 256 + 256;
        int sla = (lane < 16) ? (int)SLOT[(size_t)mbeg * 16 + lane] : -1, slb = (lane < 16) ? (int)SLOT[(size_t)(mbeg + 8) * 16 + lane] : -1;
        for (int m = mbeg; m < mend; m += 16) {
            const int m2 = m + 8;
            const int mn = m + 16; int sna = -1, snb = -1;
            if (mn < mend) { sna = (lane < 16) ? (int)SLOT[(size_t)mn * 16 + lane] : -1; snb = (lane < 16) ? (int)SLOT[(size_t)(mn + 8) * 16 + lane] : -1; }
            f32x4* xa = (f32x4*)(XR + (size_t)m * DM) + lane; f32x4* xb = (f32x4*)(XR + (size_t)m2 * DM) + lane; f32x4 va[4], vb[4];
            load_combine2(va, vb, XB + (size_t)m * DM, XB + (size_t)m2 * DM, sla, slb, m >> 11, m2 >> 11, XE8, lane);
            const float ra = row_rstd(va);
#pragma unroll
            for (int j = 0; j < 4; ++j) xa[64 * j] = va[j] * ra * g[j] * pscale_;
            if (m2 != m) {
                const float rb = row_rstd(vb);
#pragma unroll
                for (int j = 0; j < 4; ++j) xb[64 * j] = vb[j] * rb * g[j] * pscale_;
            }
            sla = sna; slb = snb;
        }
      }
    }
#undef PHASE_ON
#undef PHASE_END
}

extern "C" void kernel_launch(void* const* d_in, const int* in_sizes, int n_in, void* d_out, int out_size, void* d_ws, size_t ws_size, hipStream_t stream) {
    static int grid = 0;
    if (grid == 0) {
        if (n_in != 22 || in_sizes[0] != NTOK * DM || out_size != NTOK * DM || ws_size < WS_END) {
            fprintf(stderr, "kernel_launch: shape/workspace mismatch (n_in %d, in0 %d, out %d, ws %zu < %zu)\n", n_in, n_in > 0 ? in_sizes[0] : -1, out_size, ws_size, (size_t)WS_END); grid = -1; return; }
        int dev = 0, cus = 0;
        if (hipGetDevice(&dev) != hipSuccess || hipDeviceGetAttribute(&cus, hipDeviceAttributeMultiprocessorCount, dev) != hipSuccess) { grid = -1; return; }
        if (hipFuncSetAttribute((const void*)mk_fwd, hipFuncAttributeMaxDynamicSharedMemorySize, LDS_BYTES) != hipSuccess) { fprintf(stderr, "kernel_launch: hipFuncSetAttribute failed\n"); grid = -1; return; }
        int per_cu = 0;
        if (hipOccupancyMaxActiveBlocksPerMultiprocessor(&per_cu, (const void*)mk_fwd, NWAVES * 64, LDS_BYTES) != hipSuccess || per_cu < 1) fprintf(stderr, "kernel_launch: occupancy query says %d\n", per_cu);
        (void)hipGetLastError();
        grid = cus;
    }
    if (grid < 0) return;
    (void)hipMemsetAsync((char*)d_ws + WS_CTL, 0, CTL_ZERO_BYTES, stream);
    Args a{};
    const float* const* in = (const float* const*)d_in;
    a.x = in[0]; a.attn_g = in[1]; a.ffn_g = in[2]; a.final_g = in[3];
    for (int l = 0; l < 4; ++l) {
        const int m = l % 3, j = l / 3;
        a.w_in[l] = m == 0 ? in[4] + (size_t)j * DM * 3072 : (m == 1 ? in[11] + (size_t)j * DM * 1536 : in[15] + (size_t)j * DM * 1536);
        a.w_o[l] = m == 0 ? in[5] + (size_t)j * DM * DM : (m == 1 ? in[12] + (size_t)j * DM * DM : in[16] + (size_t)j * DM * DM);
        a.lq1[l] = in[6] + j * 64; a.lk1[l] = in[7] + j * 64; a.lq2[l] = in[8] + j * 64; a.lk2[l] = in[9] + j * 64; a.subln[l] = in[10] + j * 128;
        a.qn[l] = in[13]; a.kn[l] = in[14]; a.sinks[l] = in[17];
        if (m != 0) { a.lq1[l] = in[6]; a.lk1[l] = in[7]; a.lq2[l] = in[8]; a.lk2[l] = in[9]; a.subln[l] = in[10]; }
    }
    a.w_router = in[18]; a.w_gate = in[19]; a.w_up = in[20]; a.w_down = in[21];
    a.out = (float*)d_out; a.ws = (unsigned char*)d_ws;
    hipLaunchKernelGGL(mk_fwd, dim3(grid), dim3(NWAVES * 64), LDS_BYTES, stream, a);
    const hipError_t le = hipPeekAtLastError();
    if (le != hipSuccess) fprintf(stderr, "kernel_launch: launch failed: %s\n", hipGetErrorName(le));
}
```

```cpp
#include <hip/hip_runtime.h>
#include <cstdio>
#include <cstdint>
#include <hip/hip_bf16.h>
#ifndef PROBE_TYPE
#define PROBE_TYPE (-1)
#endif
__device__ __forceinline__ int fresh_lane() { unsigned ones = ~0u; asm volatile("" : "+s"(ones)); return (int)__builtin_amdgcn_mbcnt_hi(ones, __builtin_amdgcn_mbcnt_lo(ones, 0u)); }
__device__ __forceinline__ int fresh_tid(int wv) { asm volatile("" : "+s"(wv)); return (wv << 6) | fresh_lane(); }
__device__ __forceinline__ float dpp_xor1(float v) { return __uint_as_float((unsigned)__builtin_amdgcn_update_dpp(0, (int)__float_as_uint(v), 0xB1, 0xF, 0xF, true)); }
__device__ __forceinline__ float dpp_xor2(float v) { return __uint_as_float((unsigned)__builtin_amdgcn_update_dpp(0, (int)__float_as_uint(v), 0x4E, 0xF, 0xF, true)); }
__device__ __forceinline__ float dpp_hmirror(float v) { return __uint_as_float((unsigned)__builtin_amdgcn_update_dpp(0, (int)__float_as_uint(v), 0x141, 0xF, 0xF, true)); }
__device__ __forceinline__ float dpp_mirror(float v) { return __uint_as_float((unsigned)__builtin_amdgcn_update_dpp(0, (int)__float_as_uint(v), 0x140, 0xF, 0xF, true)); }
__device__ __forceinline__ float dpp_ror4(float v) { return __uint_as_float((unsigned)__builtin_amdgcn_update_dpp(0, (int)__float_as_uint(v), 0x124, 0xF, 0xF, true)); }
__device__ __forceinline__ float dpp_ror8(float v) { return __uint_as_float((unsigned)__builtin_amdgcn_update_dpp(0, (int)__float_as_uint(v), 0x128, 0xF, 0xF, true)); }
__device__ __forceinline__ float sum_swap16(float v) { auto r = __builtin_amdgcn_permlane16_swap(__float_as_uint(v), __float_as_uint(v), false, false); return __uint_as_float(r[0]) + __uint_as_float(r[1]); }
__device__ __forceinline__ float sum_swap32(float v) { auto r = __builtin_amdgcn_permlane32_swap(__float_as_uint(v), __float_as_uint(v), false, false); return __uint_as_float(r[0]) + __uint_as_float(r[1]); }
__device__ __forceinline__ float sum16(float v) { v += dpp_xor1(v); v += dpp_xor2(v); v += dpp_hmirror(v); v += dpp_mirror(v); return v; }
__device__ __forceinline__ float sum32(float v) { return sum_swap16(sum16(v)); }
__device__ __forceinline__ float sum64(float v) { return sum_swap32(sum32(v)); }
namespace pg8 {
#define PG8_LAS __attribute__((address_space(3)))
typedef unsigned short bf16_t;
typedef short bf16x8 __attribute__((ext_vector_type(8)));
typedef float f32x4 __attribute__((ext_vector_type(4)));
typedef unsigned u32x4 __attribute__((ext_vector_type(4)));
constexpr int BM = 256, BK = 64, HALF = 128, HTB = HALF * BK * 2  , STAGE_BYTES = 8 * HTB, NXCD = 8, WGM = 8;

__host__ __device__ __forceinline__ int lds_byte(int r, int c) { const int st = (r >> 4) * 2 + (c >> 5), rr = r & 15, cc = c & 31, ob = rr * 64 + cc * 2; return st * 1024 + (ob ^ (((ob >> 9) & 1) << 5)); }
__host__ __device__ __forceinline__ void stage_rc(int b, int& R, int& C) { const int st = b / 1024, sb = b % 1024, swz = sb ^ (((sb >> 9) & 1) << 5); R = (st >> 1) * 16 + swz / 64; C = (st & 1) * 32 + (swz % 64) / 2; }
__host__ __device__ __forceinline__ int perm32(int rho) { const int n = rho >> 4, i = rho & 15; return 8 * (i >> 2) + 4 * n + (i & 3); }

struct Unit { int pm, pn, par; };
struct Gemm { const bf16_t* A; const bf16_t* Bt; int M, N, K; const int* tok = nullptr; const float* rowv = nullptr; };

struct StaticOrder {
    int nM, nN, nwg, G, c;
    __host__ __device__ void init(int M, int N, int G_, int c_) { nM = M / BM; nN = N / BM; nwg = nM * nN; G = G_; c = c_; }
    __host__ __device__ bool next(int i, Unit& u) const {
        const long L = (long)i * G + c; if (L >= nwg) return false;
        int wgid = (int)L; { const int q = nwg / NXCD, r = nwg % NXCD, xcd = wgid % NXCD, off = wgid / NXCD; wgid = (xcd < r ? xcd * (q + 1) : r * (q + 1) + (xcd - r) * q) + off; }
        const int nig = WGM * nN, gid = wgid / nig, fm = gid * WGM, gsz = (nM - fm) < WGM ? (nM - fm) : WGM;
        u.pm = fm + ((wgid % nig) % gsz); u.pn = (wgid % nig) / gsz; return true;
    }
    __device__ __forceinline__ void a_ready(const Unit&) const {}
    __device__ __forceinline__ void done(const Unit&) const {}
};


template <int NNL> struct GroupedOrder {
    int G, c, nunits;
    __device__ void init(int G_, int c_) { G = G_; c = c_; nunits = 16 * 32 * NNL; }
    __device__ bool next(int i, Unit& u) const {
        const int L = i * G + c; if (L >= nunits) return false;
        if (G == 256) {
            const int x = c & 7, j = c >> 3;
            if (NNL == 16) { const int e = i >> 1, hh = i & 1; u.pm = e * 32 + 4 * x + (j & 3); u.pn = e * 16 + 8 * hh + (j >> 2); }
            else { const int e = 2 * i + (j >> 4); u.pm = e * 32 + 4 * x + (j & 3); u.pn = e * NNL + ((j >> 2) & 3); }
        } else { const int pmg = L / NNL; u.pm = pmg; u.pn = (pmg >> 5) * NNL + (L % NNL); }
        return true;
    }
    __device__ __forceinline__ void a_ready(const Unit&) const {}
    __device__ __forceinline__ void done(const Unit&) const {}
};

__device__ __forceinline__ unsigned cvt_pk_bf16(float lo, float hi) { unsigned r; asm volatile("v_cvt_pk_bf16_f32 %0, %1, %2" : "=v"(r) : "v"(lo), "v"(hi)); return r; }

struct EpiQKV {
    static constexpr bool PERM = true, AFTER_DRAIN = false;
    bf16_t* O; int ldc; const float* tcos; const float* tsin; int nrope, nq; const PG8_LAS float* qg; const PG8_LAS float* kg; float qscale; const float* rstd;
    __device__ __forceinline__ void operator()(const f32x4 (&acc)[2][2][4][2], const Unit& u, int wr, int wc, int fr, int fq) const {
        const int row0 = u.pm * BM + wr * 64 + fr, col0 = u.pn * BM + wc * 64 + 8 * fq;
        const bool rope = u.pn < nrope; const float sc = (u.pn < nq) ? qscale : 1.0f;
        const PG8_LAS float* gp = (u.pn < nq) ? qg : kg;
        float rs[2][4];
#pragma unroll
        for (int ai = 0; ai < 2; ++ai)
#pragma unroll
            for (int m = 0; m < 4; ++m) rs[ai][m] = rstd[row0 + ai * HALF + m * 16];
        f32x4 gv[2][2];
        if (rope && gp) {
#pragma unroll
            for (int bj = 0; bj < 2; ++bj)
#pragma unroll
                for (int n = 0; n < 2; ++n) gv[bj][n] = *(const PG8_LAS f32x4*)(gp + 32 * bj + 8 * fq + 4 * n);
        }
#pragma unroll
        for (int ai = 0; ai < 2; ++ai)
#pragma unroll
            for (int m = 0; m < 4; ++m) {
                const int row = row0 + ai * HALF + m * 16;
                f32x4 v[2][2];
#pragma unroll
                for (int bj = 0; bj < 2; ++bj)
#pragma unroll
                    for (int n = 0; n < 2; ++n) v[bj][n] = acc[ai][bj][m][n] * rs[ai][m];
                if (rope) {
                    if (gp) {
                        float ss = 0.f;
#pragma unroll
                        for (int bj = 0; bj < 2; ++bj)
#pragma unroll
                            for (int n = 0; n < 2; ++n) ss += (v[bj][n][0] * v[bj][n][0] + v[bj][n][1] * v[bj][n][1]) + (v[bj][n][2] * v[bj][n][2] + v[bj][n][3] * v[bj][n][3]);
                        ss = sum_swap32(sum_swap16(ss));
                        const float rstd = __builtin_amdgcn_rsqf(ss * (1.0f / 64.0f) + 1e-6f);
#pragma unroll
                        for (int bj = 0; bj < 2; ++bj)
#pragma unroll
                            for (int n = 0; n < 2; ++n) v[bj][n] = v[bj][n] * rstd * gv[bj][n];
                    }
                    const int s = row & 2047;
#pragma unroll
                    for (int n = 0; n < 2; ++n) {
                        const f32x4 c = *(const f32x4*)(tcos + s * 32 + 8 * fq + 4 * n), sn = *(const f32x4*)(tsin + s * 32 + 8 * fq + 4 * n);
                        const f32x4 x1 = v[0][n], x2 = v[1][n];
                        v[0][n] = x1 * c - x2 * sn; v[1][n] = x2 * c + x1 * sn;
                    }
                }
                bf16_t* rowp = O + (size_t)row * ldc + col0;
#pragma unroll
                for (int bj = 0; bj < 2; ++bj) { const f32x4 v0 = v[bj][0] * sc, v1 = v[bj][1] * sc;
                    u32x4 w; w.x = cvt_pk_bf16(v0[0], v0[1]); w.y = cvt_pk_bf16(v0[2], v0[3]); w.z = cvt_pk_bf16(v1[0], v1[1]); w.w = cvt_pk_bf16(v1[2], v1[3]);
                    *(u32x4*)(rowp + bj * 32) = w; }
            }
    }
};
struct EpiResBf16 {
    static constexpr bool PERM = true, AFTER_DRAIN = false;
    bf16_t* X; int ldc;
    __device__ __forceinline__ void operator()(const f32x4 (&acc)[2][2][4][2], const Unit& u, int wr, int wc, int fr, int fq) const {
        const int row0 = u.pm * BM + wr * 64 + fr, col0 = u.pn * BM + wc * 32 + 8 * fq;
        u32x4 ball[2][4][2];
#pragma unroll
        for (int ai = 0; ai < 2; ++ai)
#pragma unroll
            for (int m = 0; m < 4; ++m)
#pragma unroll
                for (int bj = 0; bj < 2; ++bj) ball[ai][m][bj] = *(const u32x4*)(X + (size_t)(row0 + ai * HALF + m * 16) * ldc + col0 + bj * HALF);
        asm volatile("" ::: "memory");
#pragma unroll
        for (int ai = 0; ai < 2; ++ai)
#pragma unroll
            for (int m = 0; m < 4; ++m) { bf16_t* rowp = X + (size_t)(row0 + ai * HALF + m * 16) * ldc + col0;
#pragma unroll
                for (int bj = 0; bj < 2; ++bj) { const f32x4 a0 = acc[ai][bj][m][0], a1 = acc[ai][bj][m][1]; const u32x4 x = ball[ai][m][bj];
                    u32x4 w;
                    w.x = cvt_pk_bf16(a0[0] + __uint_as_float(x.x << 16), a0[1] + __uint_as_float(x.x & 0xffff0000u));
                    w.y = cvt_pk_bf16(a0[2] + __uint_as_float(x.y << 16), a0[3] + __uint_as_float(x.y & 0xffff0000u));
                    w.z = cvt_pk_bf16(a1[0] + __uint_as_float(x.z << 16), a1[1] + __uint_as_float(x.z & 0xffff0000u));
                    w.w = cvt_pk_bf16(a1[2] + __uint_as_float(x.w << 16), a1[3] + __uint_as_float(x.w & 0xffff0000u));
                    *(u32x4*)(rowp + bj * HALF) = w; }
            }
    }
};
struct EpiSwiGLU {
    static constexpr bool PERM = true, AFTER_DRAIN = false;
    bf16_t* O; int ldc;
    __device__ __forceinline__ void operator()(const f32x4 (&acc)[2][2][4][2], const Unit& u, int wr, int wc, int fr, int fq) const {
        const int row0 = u.pm * BM + wr * 64 + fr, col0 = (u.pn & 15) * HALF + wc * 32 + 8 * fq;
#pragma unroll
        for (int ai = 0; ai < 2; ++ai)
#pragma unroll
            for (int m = 0; m < 4; ++m) { bf16_t* rowp = O + (size_t)(row0 + ai * HALF + m * 16) * ldc + col0;
                f32x4 h[2];
#pragma unroll
                for (int n = 0; n < 2; ++n) { const f32x4 g = acc[ai][0][m][n], up = acc[ai][1][m][n];
#pragma unroll
                    for (int j = 0; j < 4; ++j) { const float e = __builtin_amdgcn_exp2f(g[j] * -1.4426950408889634f); h[n][j] = g[j] * __builtin_amdgcn_rcpf(1.0f + e) * up[j]; } }
                u32x4 w; w.x = cvt_pk_bf16(h[0][0], h[0][1]); w.y = cvt_pk_bf16(h[0][2], h[0][3]); w.z = cvt_pk_bf16(h[1][0], h[1][1]); w.w = cvt_pk_bf16(h[1][2], h[1][3]);
                *(u32x4*)rowp = w; }
    }
};
__device__ __forceinline__ unsigned cvt4_fp8(float a, float b, float c, float d) { int r = __builtin_amdgcn_cvt_pk_fp8_f32(a, b, 0, false); r = __builtin_amdgcn_cvt_pk_fp8_f32(c, d, r, true); return (unsigned)r; }
constexpr float W8_SCALE = 32.0f, W8_INV = 1.0f / 32.0f;
struct EpiSwiGLU8 {
    static constexpr bool PERM = true, AFTER_DRAIN = false;
    unsigned char* O; int ldc;
    __device__ __forceinline__ void operator()(const f32x4 (&acc)[2][2][4][2], const Unit& u, int wr, int wc, int fr, int fq) const {
        const int row0 = u.pm * BM + wr * 64 + fr + 16 * (fq & 1), col0 = (u.pn & 15) * HALF + wc * 32 + 16 * (fq >> 1);
        typedef unsigned u32x2 __attribute__((ext_vector_type(2)));
#pragma unroll
        for (int ai = 0; ai < 2; ++ai)
#pragma unroll
            for (int mp = 0; mp < 4; mp += 2) { unsigned char* rowp = O + (size_t)(row0 + ai * HALF + mp * 16) * ldc + col0;
                u32x2 w[2];
#pragma unroll
                for (int k = 0; k < 2; ++k) { const int m = mp + k;
                    f32x4 h[2];
#pragma unroll
                    for (int n = 0; n < 2; ++n) { const f32x4 g = acc[ai][0][m][n], up = acc[ai][1][m][n];
                        const f32x4 t = g * -1.4426950408889634f, gu = g * up;
                        f32x4 e; e[0] = __builtin_amdgcn_exp2f(t[0]); e[1] = __builtin_amdgcn_exp2f(t[1]); e[2] = __builtin_amdgcn_exp2f(t[2]); e[3] = __builtin_amdgcn_exp2f(t[3]);
                        const f32x4 d = e + 1.0f;
                        f32x4 r; r[0] = __builtin_amdgcn_rcpf(d[0]); r[1] = __builtin_amdgcn_rcpf(d[1]); r[2] = __builtin_amdgcn_rcpf(d[2]); r[3] = __builtin_amdgcn_rcpf(d[3]);
                        h[n] = gu * r; }
                    w[k].x = cvt4_fp8(h[0][0], h[0][1], h[0][2], h[0][3]); w[k].y = cvt4_fp8(h[1][0], h[1][1], h[1][2], h[1][3]); }
                const auto sx = __builtin_amdgcn_permlane16_swap(w[0].x, w[1].x, false, false), sy = __builtin_amdgcn_permlane16_swap(w[0].y, w[1].y, false, false);
                u32x4 o; o.x = sx[0]; o.y = sy[0]; o.z = sx[1]; o.w = sy[1];
                *(u32x4*)rowp = o; }
    }
};
struct EpiDown {
    static constexpr bool PERM = true, AFTER_DRAIN = false;
    unsigned char* O; int ldc; const PG8_LAS float* gate; float osc;
    __device__ __forceinline__ void operator()(const f32x4 (&acc)[2][2][4][2], const Unit& u, int wr, int wc, int fr, int fq) const {
        const int row0 = u.pm * BM + wr * 64 + fr, col0 = (u.pn & 3) * BM + wc * 64 + 16 * (fq >> 1) + 32 * (fq & 1);
        typedef unsigned u32x2 __attribute__((ext_vector_type(2)));
#pragma unroll
        for (int ai = 0; ai < 2; ++ai)
#pragma unroll
            for (int m = 0; m < 4; ++m) { const int row = row0 + ai * HALF + m * 16; const float gt = gate[u.par * 512 + (row & 255)] * osc; unsigned char* rowp = O + (size_t)row * ldc + col0;
                u32x2 w[2];
#pragma unroll
                for (int bj = 0; bj < 2; ++bj) { const f32x4 v0 = acc[ai][bj][m][0] * gt, v1 = acc[ai][bj][m][1] * gt;
                    w[bj].x = cvt4_fp8(v0[0], v0[1], v0[2], v0[3]); w[bj].y = cvt4_fp8(v1[0], v1[1], v1[2], v1[3]); }
                const auto sx = __builtin_amdgcn_permlane16_swap(w[0].x, w[1].x, false, false), sy = __builtin_amdgcn_permlane16_swap(w[0].y, w[1].y, false, false);
                u32x4 o; o.x = sx[0]; o.y = sy[0]; o.z = sx[1]; o.w = sy[1];
                *(u32x4*)rowp = o; }
    }
};


__device__ __forceinline__ void glds16s(const char* gbase, unsigned voff, unsigned lds_dst) {
    unsigned keep; const unsigned dst = __builtin_amdgcn_readfirstlane(lds_dst);
    asm volatile("s_mov_b32 %0, m0\n\ts_mov_b32 m0, %3\n\ts_nop 0\n\tglobal_load_lds_dwordx4 %1, %2\n\ts_mov_b32 m0, %0" : "=&s"(keep) : "v"(voff), "s"(gbase), "s"(dst) : "memory");
}
__device__ __forceinline__ void glds4s(const char* gbase, unsigned voff, unsigned lds_dst) {
    unsigned keep; const unsigned dst = __builtin_amdgcn_readfirstlane(lds_dst);
    asm volatile("s_mov_b32 %0, m0\n\ts_mov_b32 m0, %3\n\ts_nop 0\n\tglobal_load_lds_dword %1, %2\n\ts_mov_b32 m0, %0" : "=&s"(keep) : "v"(voff), "s"(gbase), "s"(dst) : "memory");
}
typedef int i32x4 __attribute__((ext_vector_type(4)));
typedef int i32x8 __attribute__((ext_vector_type(8)));
template <class Epi, class Sched, bool ALIGN_EPI = false, bool SP2 = false, bool F8 = false, bool GATHER = false, bool ROWV = false>
__device__ __forceinline__ void gemm_phase(PG8_LAS unsigned char* lds, const Gemm g, const Sched& S, const Epi& E, int wv) {
    const int tid = fresh_tid(wv), wid = __builtin_amdgcn_readfirstlane(tid >> 6), lane = tid & 63, wr = wid >> 2, wc = wid & 3, fr = lane & 15, fq = lane >> 4;
    const int K = F8 ? g.K / 2 : g.K, nt = K / BK;
    unsigned voffA[2], voffB[2];
#pragma unroll
    for (int i = 0; i < 2; ++i) { int R, C; stage_rc(tid * 16 + i * 8192, R, C); const int Rb = Epi::PERM ? ((R & ~31) + perm32(R & 31)) : R;
        voffA[i] = (unsigned)(R * K + C) * 2u; voffB[i] = (unsigned)(Rb * K + C) * 2u; }
    const size_t kstep = (size_t)(BK * 2);
    const size_t hstep = (size_t)HALF * K * 2;
    const size_t tstep = 2 * hstep;
    static_assert(!GATHER || SP2, "GATHER is written for the SP2 K-loop");
    static_assert(!ROWV || (SP2 && !GATHER), "ROWV is written for the SP2 K-loop without GATHER");
    const size_t hstepA = GATHER ? 0 : hstep, tstepA = GATHER ? 0 : tstep;
    const unsigned rowb = (unsigned)K * 2u;
    const unsigned ldsw = (unsigned)wid * 1024u;
    const int aoff = lds_byte(wr * 64 + fr, fq * 8), boff = lds_byte(wc * 32 + fr, fq * 8);
#define PG8_SA(b, h) (((b) * 2 + (h)) * HTB)
#define PG8_SB(b, h) ((4 + (b) * 2 + (h)) * HTB)
    int sc8 = 0x7f7f7a7a; asm volatile("" : "+v"(sc8));
    const unsigned ldsb = (unsigned)(uintptr_t)lds;
#define PG8_STAGE(bufoff, gbase, voff) do { _Pragma("unroll") for (int _i = 0; _i < 2; ++_i) \
        glds16s((const char*)(gbase), (voff)[_i], ldsb + (unsigned)(bufoff) + ldsw + (unsigned)(_i * 8192)); } while (0)
#define PG8_LDA(dst, b, h) do { _Pragma("unroll") for (int m = 0; m < 4; ++m) _Pragma("unroll") for (int k = 0; k < 2; ++k) dst[m][k] = *(const PG8_LAS bf16x8*)(lds + PG8_SA(b, h) + aoff + m * 2048 + k * 1024); } while (0)
#define PG8_LDB(dst, b, h) do { _Pragma("unroll") for (int n = 0; n < 2; ++n) _Pragma("unroll") for (int k = 0; k < 2; ++k) dst[n][k] = *(const PG8_LAS bf16x8*)(lds + PG8_SB(b, h) + boff + n * 2048 + k * 1024); } while (0)
#define PG8_CAT(x) __builtin_shufflevector(__builtin_bit_cast(i32x4, (x)[0]), __builtin_bit_cast(i32x4, (x)[1]), 0, 1, 2, 3, 4, 5, 6, 7)
#define PG8_MMA(ai, bj, At, Bt) do { __builtin_amdgcn_s_setprio(1); _Pragma("unroll") for (int m = 0; m < 4; ++m) _Pragma("unroll") for (int n = 0; n < 2; ++n) { \
        if constexpr (F8) acc[ai][bj][m][n] = __builtin_amdgcn_mfma_scale_f32_16x16x128_f8f6f4(PG8_CAT(Bt[n]), PG8_CAT(At[m]), acc[ai][bj][m][n], 0, 0, 0, sc8, 2, sc8); \
        else { _Pragma("unroll") for (int k = 0; k < 2; ++k) acc[ai][bj][m][n] = __builtin_amdgcn_mfma_f32_16x16x32_bf16(Bt[n][k], At[m][k], acc[ai][bj][m][n], 0, 0, 0); } } __builtin_amdgcn_s_setprio(0); } while (0)
#define PG8_WAIT_V(n) asm volatile("s_waitcnt vmcnt(" #n ")" ::: "memory")
#define PG8_WAIT_L(n) asm volatile("s_waitcnt lgkmcnt(" #n ")" ::: "memory")
#define PG8_BAR __builtin_amdgcn_s_barrier()
#define PG8_SCHED __builtin_amdgcn_sched_barrier(0)
    Unit cur, nxt; int ui = 0;
    if (!S.next(0, cur)) return;
    f32x4 acc[2][2][4][2];
    float zacc_ = 0.f; asm volatile("" : "+v"(zacc_));
#pragma unroll
    for (int a = 0; a < 2; ++a)
#pragma unroll
        for (int b = 0; b < 2; ++b)
#pragma unroll
            for (int m = 0; m < 4; ++m)
#pragma unroll
                for (int n = 0; n < 2; ++n) acc[a][b][m][n] = (f32x4){zacc_, zacc_, zacc_, zacc_};
    bf16x8 At[4][2], B0[2][2], B1[2][2];
    const char* cA = (const char*)g.A + (size_t)cur.pm * tstepA; const char* cB = (const char*)g.Bt + (size_t)cur.pn * tstep;
    S.a_ready(cur);
    unsigned cv[2][2], sv[2][2];
    const PG8_LAS unsigned* tokl = (const PG8_LAS unsigned*)(lds + STAGE_BYTES + 1024) + wid * 256 + lane;
    if constexpr (GATHER) {
#pragma unroll
        for (int h = 0; h < 2; ++h)
#pragma unroll
            for (int i = 0; i < 2; ++i) { cv[h][i] = (unsigned)g.tok[cur.pm * BM + h * HALF + (int)(voffA[i] / rowb)] * rowb + (voffA[i] & (rowb - 1u)); sv[h][i] = cv[h][i]; }
    }
#define PG8_STAGEA(bufoff, gbase, h, nx) do { unsigned v0_, v1_; if constexpr (GATHER) { v0_ = (nx) ? sv[h][0] : cv[h][0]; v1_ = (nx) ? sv[h][1] : cv[h][1]; } else { v0_ = voffA[0]; v1_ = voffA[1]; } \
        glds16s((const char*)(gbase), v0_, ldsb + (unsigned)(bufoff) + ldsw); glds16s((const char*)(gbase), v1_, ldsb + (unsigned)(bufoff) + ldsw + 8192u); } while (0)
    if constexpr (SP2) {
        PG8_STAGE(PG8_SB(0, 0), cB, voffB); PG8_STAGE(PG8_SB(0, 1), cB + hstep, voffB); PG8_STAGEA(PG8_SA(0, 0), cA, 0, false); PG8_STAGEA(PG8_SA(0, 1), cA + hstepA, 1, false);
        if (wr == 1) PG8_BAR;
        PG8_WAIT_V(2); PG8_BAR;
        PG8_STAGE(PG8_SB(1, 0), cB + kstep, voffB); PG8_STAGEA(PG8_SA(1, 0), cA + kstep, 0, false); PG8_STAGE(PG8_SB(1, 1), cB + hstep + kstep, voffB);
        PG8_WAIT_V(6); PG8_BAR;
    } else {
        PG8_STAGE(PG8_SB(0, 0), cB, voffB); PG8_STAGE(PG8_SA(0, 0), cA, voffA); PG8_STAGE(PG8_SB(0, 1), cB + hstep, voffB); PG8_STAGE(PG8_SA(0, 1), cA + hstep, voffA);
        if (wr == 1) PG8_BAR;
        PG8_WAIT_V(4); PG8_BAR;
        PG8_STAGE(PG8_SB(1, 0), cB + kstep, voffB); PG8_STAGE(PG8_SA(1, 0), cA + kstep, voffA); PG8_STAGE(PG8_SB(1, 1), cB + hstep + kstep, voffB);
        PG8_WAIT_V(6); PG8_BAR;
    }
    for (;;) {
        const bool has_next = S.next(ui + 1, nxt);
        const char* nA = has_next ? (const char*)g.A + (size_t)nxt.pm * tstepA : cA; const char* nB = has_next ? (const char*)g.Bt + (size_t)nxt.pn * tstep : cB;
#pragma unroll 1
        for (int t = 0; t < nt; t += 2) {
            const bool last = (t == nt - 2);
            const char* a1 = cA + (size_t)(t + 1) * kstep;
            const char* a2 = last ? nA : cA + (size_t)(t + 2) * kstep; const char* b2 = last ? nB : cB + (size_t)(t + 2) * kstep;
            const char* a3 = a2 + kstep; const char* b3 = b2 + kstep;
            if (last && has_next) S.a_ready(nxt);
            if constexpr (GATHER) {
                if (last && has_next) {
                    asm volatile("" ::: "memory");
#pragma unroll
                    for (int h = 0; h < 2; ++h)
#pragma unroll
                        for (int i = 0; i < 2; ++i) sv[h][i] = tokl[(h * 2 + i) * 64] * rowb + (voffA[i] & (rowb - 1u));
                    asm volatile("" : "+v"(sv[0][0]), "+v"(sv[0][1]), "+v"(sv[1][0]), "+v"(sv[1][1]) :: "memory");
                }
            }
            if constexpr (SP2) {
            PG8_LDB(B0, 0, 0); PG8_LDB(B1, 0, 1); PG8_SCHED; PG8_LDA(At, 0, 0);
            if (GATHER && t == 0 && has_next) {
#pragma unroll
                for (int h = 0; h < 2; ++h)
#pragma unroll
                    for (int i = 0; i < 2; ++i) glds4s((const char*)g.tok, (unsigned)(nxt.pm * BM + h * HALF + (int)(voffA[i] / rowb)) * 4u, ldsb + (unsigned)STAGE_BYTES + 1024u + (unsigned)wid * 1024u + (unsigned)(h * 2 + i) * 256u);
                PG8_STAGEA(PG8_SA(1, 1), a1 + hstepA, 1, false);
                PG8_WAIT_V(12);
            } else if (ROWV && t == 0) {
                glds4s((const char*)g.rowv, (unsigned)(cur.pm * BM + (wid & 3) * 64 + lane) * 4u, ldsb + (unsigned)STAGE_BYTES + 9216u + (unsigned)(ui & 1) * 2048u + (unsigned)wid * 256u);
                PG8_STAGEA(PG8_SA(1, 1), a1 + hstepA, 1, false);
                PG8_WAIT_V(9);
            } else {
                PG8_STAGEA(PG8_SA(1, 1), a1 + hstepA, 1, false);
                PG8_WAIT_V(8);
            }
            PG8_WAIT_L(0); PG8_BAR; PG8_MMA(0, 0, At, B0); PG8_MMA(0, 1, At, B1); PG8_BAR; PG8_SCHED;
            PG8_LDA(At, 0, 1); PG8_STAGE(PG8_SB(0, 0), b2, voffB); PG8_STAGE(PG8_SB(0, 1), b2 + hstep, voffB); PG8_STAGEA(PG8_SA(0, 0), a2, 0, true);
            PG8_WAIT_V(8); PG8_WAIT_L(0); PG8_BAR; PG8_MMA(1, 0, At, B0); PG8_MMA(1, 1, At, B1); PG8_BAR; PG8_SCHED;
            PG8_LDB(B0, 1, 0); PG8_LDB(B1, 1, 1); PG8_SCHED; PG8_LDA(At, 1, 0); PG8_STAGEA(PG8_SA(0, 1), a2 + hstepA, 1, true);
            PG8_WAIT_V(8); PG8_WAIT_L(0); PG8_BAR; PG8_MMA(0, 0, At, B0); PG8_MMA(0, 1, At, B1); PG8_BAR; PG8_SCHED;
            PG8_LDA(At, 1, 1); PG8_STAGE(PG8_SB(1, 0), b3, voffB); PG8_STAGE(PG8_SB(1, 1), b3 + hstep, voffB); PG8_STAGEA(PG8_SA(1, 0), a3, 0, true);
            PG8_WAIT_V(8); PG8_WAIT_L(0); PG8_BAR; PG8_MMA(1, 0, At, B0); PG8_MMA(1, 1, At, B1); PG8_BAR; PG8_SCHED;
            } else {
            PG8_LDB(B0, 0, 0); PG8_SCHED; PG8_LDA(At, 0, 0); PG8_STAGE(PG8_SA(1, 1), a1 + hstep, voffA);
            PG8_WAIT_L(8); PG8_BAR; PG8_WAIT_L(0); PG8_MMA(0, 0, At, B0); PG8_BAR; PG8_SCHED;
            PG8_LDB(B1, 0, 1); PG8_STAGE(PG8_SB(0, 0), b2, voffB);
            PG8_BAR; PG8_WAIT_L(0); PG8_MMA(0, 1, At, B1); PG8_BAR;
            PG8_LDA(At, 0, 1); PG8_STAGE(PG8_SA(0, 0), a2, voffA);
            PG8_BAR; PG8_WAIT_L(0); PG8_MMA(1, 0, At, B0); PG8_BAR; PG8_SCHED;
            PG8_STAGE(PG8_SB(0, 1), b2 + hstep, voffB);
            PG8_WAIT_V(6); PG8_BAR; PG8_MMA(1, 1, At, B1); PG8_BAR;
            PG8_LDB(B0, 1, 0); PG8_SCHED; PG8_LDA(At, 1, 0); PG8_STAGE(PG8_SA(0, 1), a2 + hstep, voffA);
            PG8_WAIT_L(8); PG8_BAR; PG8_WAIT_L(0); PG8_MMA(0, 0, At, B0); PG8_BAR; PG8_SCHED;
            PG8_LDB(B1, 1, 1); PG8_STAGE(PG8_SB(1, 0), b3, voffB);
            PG8_BAR; PG8_WAIT_L(0); PG8_MMA(0, 1, At, B1); PG8_BAR;
            PG8_LDA(At, 1, 1); PG8_STAGE(PG8_SA(1, 0), a3, voffA);
            PG8_BAR; PG8_WAIT_L(0); PG8_MMA(1, 0, At, B0); PG8_BAR; PG8_SCHED;
            PG8_STAGE(PG8_SB(1, 1), b3 + hstep, voffB);
            PG8_WAIT_V(6); PG8_BAR; PG8_MMA(1, 1, At, B1); PG8_BAR;
            }
        }
        if constexpr (ALIGN_EPI) { if (wr == 0) PG8_BAR; }
        cur.par = ui & 1;
        if constexpr (!Epi::AFTER_DRAIN) { const int l_ = fresh_lane(); E(acc, cur, wr, wc, l_ & 15, l_ >> 4); S.done(cur); }
        if (!has_next) break;
#pragma unroll
        for (int a = 0; a < 2; ++a)
#pragma unroll
            for (int b = 0; b < 2; ++b)
#pragma unroll
                for (int m = 0; m < 4; ++m)
#pragma unroll
                    for (int n = 0; n < 2; ++n) acc[a][b][m][n] = (f32x4){zacc_, zacc_, zacc_, zacc_};
        cur = nxt; cA = nA; cB = nB; ++ui;
        if constexpr (GATHER) { cv[0][0] = sv[0][0]; cv[0][1] = sv[0][1]; cv[1][0] = sv[1][0]; cv[1][1] = sv[1][1]; }
        if constexpr (ALIGN_EPI) { if (wr == 1) PG8_BAR; }
    }
    PG8_WAIT_V(0);
    if constexpr (!ALIGN_EPI) { if (wr == 0) PG8_BAR; }
    PG8_BAR;
    if constexpr (Epi::AFTER_DRAIN) { E.fused(acc, cur, wr, wc, fr, fq, lds, wid, lane); S.done(cur); }
#undef PG8_SA
#undef PG8_SB
#undef PG8_STAGEA
#undef PG8_STAGE
#undef PG8_LDA
#undef PG8_LDB
#undef PG8_MMA
#undef PG8_CAT
#undef PG8_WAIT_V
#undef PG8_WAIT_L
#undef PG8_BAR
#undef PG8_SCHED
}
}


namespace att {
using bf16 = unsigned short;
using bf16x8 = __attribute__((ext_vector_type(8))) short;
using s16x4  = __attribute__((ext_vector_type(4))) short;
using f32x16 = __attribute__((ext_vector_type(16))) float;
using u32x4  = __attribute__((ext_vector_type(4))) unsigned;
constexpr int KVBLK = 64;
constexpr float THR = 8.f;
constexpr int SHM_K = KVBLK * 64 * 2;
#define ATT_KSWZ(row, colB) ((row) * 128 + ((colB) ^ ((((row) >> 1) & 7) << 4)))
#define ATT_SBAR() __builtin_amdgcn_sched_barrier(0)
__device__ __forceinline__ int crow(int r, int hi) { return (r & 3) + 8 * (r >> 2) + 4 * hi; }
__device__ __forceinline__ unsigned cvtpk(float lo, float hi) { unsigned r; asm volatile("v_cvt_pk_bf16_f32 %0, %1, %2" : "=v"(r) : "v"(lo), "v"(hi)); return r; }

__device__ __forceinline__ void partialSM(f32x16& p0, f32x16& p1, float& m_reg, float& mn, float& alpha) {
  float pmax = p0[0];
#pragma unroll
  for (int r = 1; r < 16; ++r) pmax = fmaxf(pmax, p0[r]);
#pragma unroll
  for (int r = 0; r < 16; ++r) pmax = fmaxf(pmax, p1[r]);
  { auto rr = __builtin_amdgcn_permlane32_swap(__float_as_uint(pmax), __float_as_uint(pmax), false, false);
    pmax = fmaxf(__uint_as_float(rr[0]), __uint_as_float(rr[1])); }
  if (__builtin_expect(__all(pmax - m_reg <= THR), 1)) { mn = m_reg; alpha = 1.f; }
  else { mn = fmaxf(m_reg, pmax); alpha = __builtin_amdgcn_exp2f(m_reg - mn); m_reg = mn; }
#pragma unroll
  for (int r = 0; r < 16; ++r) p0[r] = p0[r] - mn;
#pragma unroll
  for (int r = 0; r < 16; ++r) p1[r] = p1[r] - mn;
#pragma unroll
  for (int r = 0; r < 16; ++r) p0[r] = __builtin_amdgcn_exp2f(p0[r]);
}
__device__ __forceinline__ void finishSM(f32x16& p0, f32x16& p1, float alpha, float& l_reg, bf16x8& pa0, bf16x8& pa1, bf16x8& pa2, bf16x8& pa3) {
#pragma unroll
  for (int r = 0; r < 16; ++r) p1[r] = __builtin_amdgcn_exp2f(p1[r]);
  typedef float f32x2 __attribute__((ext_vector_type(2)));
  f32x2 s2 = (f32x2){p0[0], p0[1]} + (f32x2){p1[0], p1[1]};
#pragma unroll
  for (int r = 2; r < 16; r += 2) s2 += (f32x2){p0[r], p0[r + 1]} + (f32x2){p1[r], p1[r + 1]};
  float ps = s2.x + s2.y;
  { auto rr = __builtin_amdgcn_permlane32_swap(__float_as_uint(ps), __float_as_uint(ps), false, false);
    ps = __uint_as_float(rr[0]) + __uint_as_float(rr[1]); }
  l_reg = l_reg * alpha + ps;
#define ATT_PK4(P, BASE, OUT) do { unsigned a0 = cvtpk(P[BASE + 0], P[BASE + 1]), a1 = cvtpk(P[BASE + 2], P[BASE + 3]);   \
    unsigned b0 = cvtpk(P[BASE + 4], P[BASE + 5]), b1 = cvtpk(P[BASE + 6], P[BASE + 7]);                              \
    auto r0 = __builtin_amdgcn_permlane32_swap(a0, b0, false, false); auto r1 = __builtin_amdgcn_permlane32_swap(a1, b1, false, false); \
    u32x4 w = {r0[0], r1[0], r0[1], r1[1]}; OUT = *reinterpret_cast<bf16x8*>(&w); } while (0)
  ATT_PK4(p0, 0, pa0); ATT_PK4(p0, 8, pa1); ATT_PK4(p1, 0, pa2); ATT_PK4(p1, 8, pa3);
#undef ATT_PK4
}
__device__ __forceinline__ void qkt(f32x16& p0, f32x16& p1, const char* Ks, const bf16x8* qr, int r32, int hi) {
  p0 = f32x16{}; p1 = f32x16{};
#pragma unroll
  for (int d0 = 0; d0 < 4; ++d0) { const int cb = (d0 * 16 + hi * 8) * 2;
    bf16x8 b0 = *reinterpret_cast<const bf16x8*>(Ks + ATT_KSWZ(r32, cb));
    bf16x8 b1 = *reinterpret_cast<const bf16x8*>(Ks + ATT_KSWZ(32 + r32, cb));
    p0 = __builtin_amdgcn_mfma_f32_32x32x16_bf16(b0, qr[d0], p0, 0, 0, 0);
    p1 = __builtin_amdgcn_mfma_f32_32x32x16_bf16(b1, qr[d0], p1, 0, 0, 0); }
}
__device__ __forceinline__ void qkt_fold(f32x16& p0, f32x16& p1, const char* Ks, const bf16x8* qr, const f32x16& negm, int r32, int hi) {
  { const bf16x8 b0 = *reinterpret_cast<const bf16x8*>(Ks + ATT_KSWZ(r32, hi * 16)), b1 = *reinterpret_cast<const bf16x8*>(Ks + ATT_KSWZ(32 + r32, hi * 16));
    p0 = __builtin_amdgcn_mfma_f32_32x32x16_bf16(b0, qr[0], negm, 0, 0, 0); p1 = __builtin_amdgcn_mfma_f32_32x32x16_bf16(b1, qr[0], negm, 0, 0, 0); }
#pragma unroll
  for (int d0 = 1; d0 < 4; ++d0) { const int cb = (d0 * 16 + hi * 8) * 2;
    bf16x8 b0 = *reinterpret_cast<const bf16x8*>(Ks + ATT_KSWZ(r32, cb));
    bf16x8 b1 = *reinterpret_cast<const bf16x8*>(Ks + ATT_KSWZ(32 + r32, cb));
    p0 = __builtin_amdgcn_mfma_f32_32x32x16_bf16(b0, qr[d0], p0, 0, 0, 0);
    p1 = __builtin_amdgcn_mfma_f32_32x32x16_bf16(b1, qr[d0], p1, 0, 0, 0); }
}
__device__ __forceinline__ float rowmax32(const f32x16& p0, const f32x16& p1) {
  float pmax = p0[0];
#pragma unroll
  for (int r = 1; r < 16; ++r) pmax = fmaxf(pmax, p0[r]);
#pragma unroll
  for (int r = 0; r < 16; ++r) pmax = fmaxf(pmax, p1[r]);
  auto rr = __builtin_amdgcn_permlane32_swap(__float_as_uint(pmax), __float_as_uint(pmax), false, false);
  return fmaxf(__uint_as_float(rr[0]), __uint_as_float(rr[1]));
}
__device__ __forceinline__ void partialSM_first(f32x16& p0, f32x16& p1, float& m_reg, float& alpha, f32x16& negm) {
  const float pmax = rowmax32(p0, p1); m_reg = pmax; alpha = 1.f;
#pragma unroll
  for (int r = 0; r < 16; ++r) { p0[r] -= pmax; p1[r] -= pmax; negm[r] = -pmax; }
#pragma unroll
  for (int r = 0; r < 16; ++r) p0[r] = __builtin_amdgcn_exp2f(p0[r]);
}
__device__ __forceinline__ void partialSM_fold(f32x16& p0, f32x16& p1, float& m_reg, float& alpha, f32x16& negm) {
  const float pmax = rowmax32(p0, p1);
  if (__builtin_expect(__all(pmax <= THR), 1)) alpha = 1.f;
  else { const float delta = fmaxf(pmax, 0.f); m_reg += delta; alpha = __builtin_amdgcn_exp2f(-delta); const float nm = -m_reg;
#pragma unroll
    for (int r = 0; r < 16; ++r) { p0[r] -= delta; p1[r] -= delta; negm[r] = nm; } }
#pragma unroll
  for (int r = 0; r < 16; ++r) p0[r] = __builtin_amdgcn_exp2f(p0[r]);
}
__device__ __forceinline__ void wmask(f32x16& p0, f32x16& p1, int dq  , int hi) {
  const float ninf = -__builtin_inff();
#pragma unroll
  for (int r = 0; r < 16; ++r) { const unsigned d = (unsigned)(dq + crow(r, hi)); p0[r] = d <= 256u ? p0[r] : ninf; const unsigned d1 = d + 32u; p1[r] = d1 <= 256u ? p1[r] : ninf; }
}
template <int NCB> __device__ __forceinline__ int v_st(int k, int c) { const int kk = (k & ~0xC) | ((k & 4) << 1) | ((k & 8) >> 1); return ((kk >> 3) * NCB + (c >> 5)) * 512 + ((kk & 7) * 32 + (c & 31)) * 2; }
__device__ __forceinline__ int v_rd_base(int lane) { return ((lane & 3) << 3) | (((lane >> 2) & 3) << 6) | (((lane >> 4) & 1) << 5) | (((lane >> 5) & 1) << 8); }
template <int OFF> __device__ __forceinline__ s16x4 tr_read(int vb) {
  s16x4 r; asm volatile("ds_read_b64_tr_b16 %0, %1 offset:%2" : "=&v"(r) : "v"(vb), "i"(OFF) : "memory"); return r;
}
template <int NCB, int D0> __device__ __forceinline__ void pv_one(f32x16& od, int vb, bf16x8 pa0, bf16x8 pa1, bf16x8 pa2, bf16x8 pa3) {
#define ATT_VOFF(ks, half) (D0 * 512 + (ks) * (NCB * 1024) + (half) * (NCB * 512))
  const s16x4 l0 = tr_read<ATT_VOFF(0, 0)>(vb), h0 = tr_read<ATT_VOFF(0, 1)>(vb), l1 = tr_read<ATT_VOFF(1, 0)>(vb), h1 = tr_read<ATT_VOFF(1, 1)>(vb);
  const s16x4 l2 = tr_read<ATT_VOFF(2, 0)>(vb), h2 = tr_read<ATT_VOFF(2, 1)>(vb), l3 = tr_read<ATT_VOFF(3, 0)>(vb), h3 = tr_read<ATT_VOFF(3, 1)>(vb);
#undef ATT_VOFF
  asm volatile("s_waitcnt lgkmcnt(0)" ::: "memory"); ATT_SBAR();
#define ATT_PK(L, H) (bf16x8){L[0], L[1], L[2], L[3], H[0], H[1], H[2], H[3]}
  od = __builtin_amdgcn_mfma_f32_32x32x16_bf16(pa0, ATT_PK(l0, h0), od, 0, 0, 0);
  od = __builtin_amdgcn_mfma_f32_32x32x16_bf16(pa1, ATT_PK(l1, h1), od, 0, 0, 0);
  od = __builtin_amdgcn_mfma_f32_32x32x16_bf16(pa2, ATT_PK(l2, h2), od, 0, 0, 0);
  od = __builtin_amdgcn_mfma_f32_32x32x16_bf16(pa3, ATT_PK(l3, h3), od, 0, 0, 0);
#undef ATT_PK
}
template <int NCB> __device__ __forceinline__ void pv_all(f32x16* o, int vb, bf16x8 pa0, bf16x8 pa1, bf16x8 pa2, bf16x8 pa3) {
  pv_one<NCB, 0>(o[0], vb, pa0, pa1, pa2, pa3); pv_one<NCB, 1>(o[1], vb, pa0, pa1, pa2, pa3);
  if constexpr (NCB == 4) { pv_one<NCB, 2>(o[2], vb, pa0, pa1, pa2, pa3); pv_one<NCB, 3>(o[3], vb, pa0, pa1, pa2, pa3); }
}

template <int NCB> constexpr int attn_lds_bytes() { return 3 * (KVBLK * 32 * NCB * 2) + 3 * SHM_K + 2048; }
template <int NCB, bool WINDOW>
__device__ __forceinline__ void attn_core(f32x16 (&o)[NCB], const bf16* __restrict__ Qb, const bf16* __restrict__ Kh, const bf16* __restrict__ Vh, int ld, int ntiles,
                                          int qpos0, int kpos0, float sink_l2, char* lds, int wv) {
  constexpr bool FOLD = (NCB == 2) && !WINDOW;
  constexpr int SHM_V = KVBLK * 32 * NCB * 2;
  const int tid = fresh_tid(wv), wid = tid >> 6, lane = tid & 63, r32 = lane & 31, hi = lane >> 5;
  char* V_lds = lds; char* K_lds = lds + 3 * SHM_V;
  float* wsf = (float*)(lds + 3 * SHM_V + 3 * SHM_K) + wid * 64; float* li_l = wsf; float* al_l = wsf + 32;
  float m_reg = -1e30f, l_reg = 0; asm volatile("" : "+v"(m_reg));
#pragma unroll
  for (int d = 0; d < NCB; ++d) o[d] = f32x16{};
  bf16x8 qr[4];
  const bf16* Qw = Qb + (long)(wid * 32 + r32) * ld + hi * 8;
#pragma unroll
  for (int d0 = 0; d0 < 4; ++d0) qr[d0] = *reinterpret_cast<const bf16x8*>(Qw + d0 * 16);
  const int dq0 = kpos0 - (qpos0 + wid * 32 + r32) + 128;
  const int ksr = tid >> 3, ksc = (tid & 7) * 8, kst = ATT_KSWZ(ksr, ksc * 2);
  constexpr int VCPR = 4 * NCB;
  const int vsr = tid / VCPR, vsc = (tid % VCPR) * 8, vst0 = v_st<NCB>(vsr, vsc), vst1 = v_st<NCB>(vsr + 32, vsc);
  const int vb0 = (int)(uintptr_t)V_lds + v_rd_base(lane);
  struct { bf16x8 ks, vs0, vs1; } sr_[2];
#define ATT_SLOAD(i, t) do { const long k0_ = (long)(t) * KVBLK; sr_[i].ks = *reinterpret_cast<const bf16x8*>(Kh + (k0_ + ksr) * ld + ksc); \
    sr_[i].vs0 = *reinterpret_cast<const bf16x8*>(Vh + (k0_ + vsr) * ld + vsc); \
    if constexpr (NCB == 4) sr_[i].vs1 = *reinterpret_cast<const bf16x8*>(Vh + (k0_ + vsr + 32) * ld + vsc); } while (0)
#define ATT_SWRITE(b, i) do { *(bf16x8*)(K_lds + (b) * SHM_K + kst) = sr_[i].ks; *(bf16x8*)(V_lds + (b) * SHM_V + vst0) = sr_[i].vs0; \
    if constexpr (NCB == 4) *(bf16x8*)(V_lds + (b) * SHM_V + vst1) = sr_[i].vs1; } while (0)
#define ATT_RESC(a) do { if (__any((a) < 1.f)) { if (hi == 0) al_l[r32] = (a); asm volatile("s_waitcnt lgkmcnt(0)" ::: "memory"); \
    _Pragma("unroll") for (int r = 0; r < 16; ++r) { const float al_ = al_l[crow(r, hi)]; _Pragma("unroll") for (int d = 0; d < NCB; ++d) o[d][r] *= al_; } } } while (0)
#define ATT_MASK(P0, P1, t) do { if constexpr (WINDOW) wmask(P0, P1, dq0 + (t) * KVBLK, hi); } while (0)
#define ATT_STEP(J, X0, X1, ALX, Y0, Y1, ALY, SLOT) do { const int j_ = (J); const int bn_ = bc == 2 ? 0 : bc + 1, bp_ = bc == 0 ? 2 : bc - 1; \
    __syncthreads(); \
    if (j_ + 1 < NT) ATT_SWRITE(bn_, SLOT); \
    if (j_ + 3 < NT) ATT_SLOAD(SLOT, j_ + 3); \
    ATT_SBAR(); \
    if constexpr (FOLD) qkt_fold(X0, X1, K_lds + bc * SHM_K, qr, negm, r32, hi); else { qkt(X0, X1, K_lds + bc * SHM_K, qr, r32, hi); ATT_MASK(X0, X1, j_); } \
    finishSM(Y0, Y1, ALY, l_reg, pa0, pa1, pa2, pa3); ATT_SBAR(); \
    pv_all<NCB>(o, vb0 + bp_ * SHM_V, pa0, pa1, pa2, pa3); \
    if constexpr (FOLD) partialSM_fold(X0, X1, m_reg, ALX, negm); else { float mn_; partialSM(X0, X1, m_reg, mn_, ALX); } \
    ATT_RESC(ALX); bc = bn_; } while (0)
  f32x16 pA0, pA1, pB0, pB1; float alA, alB; bf16x8 pa0, pa1, pa2, pa3; const int NT = ntiles;
  f32x16 negm = f32x16{};
  ATT_SLOAD(0, 0); asm volatile("s_waitcnt vmcnt(0)" ::: "memory"); ATT_SWRITE(0, 0);
  ATT_SLOAD(1, 1); if (2 < NT) ATT_SLOAD(0, 2);
  int bc = 0;
  __syncthreads();
  ATT_SWRITE(1, 1); if (3 < NT) ATT_SLOAD(1, 3);
  ATT_SBAR();
  if constexpr (FOLD) { qkt_fold(pA0, pA1, K_lds, qr, negm, r32, hi); partialSM_first(pA0, pA1, m_reg, alA, negm); }
  else { qkt(pA0, pA1, K_lds, qr, r32, hi); ATT_MASK(pA0, pA1, 0); float mn_; partialSM(pA0, pA1, m_reg, mn_, alA); }
  bc = 1;
  for (int j = 1; j + 1 < NT; j += 2) {
    ATT_STEP(j, pB0, pB1, alB, pA0, pA1, alA, 0);
    ATT_STEP(j + 1, pA0, pA1, alA, pB0, pB1, alB, 1);
  }
  ATT_STEP(NT - 1, pB0, pB1, alB, pA0, pA1, alA, 0);
  finishSM(pB0, pB1, alB, l_reg, pa0, pa1, pa2, pa3); ATT_SBAR();
  { const int bp_ = bc == 0 ? 2 : bc - 1; pv_all<NCB>(o, vb0 + bp_ * SHM_V, pa0, pa1, pa2, pa3); }
  l_reg += __builtin_amdgcn_exp2f(sink_l2 - m_reg);
  if (hi == 0) li_l[r32] = l_reg; asm volatile("s_waitcnt lgkmcnt(0)" ::: "memory");
#pragma unroll
  for (int r = 0; r < 16; ++r) { const float rl = __builtin_amdgcn_rcpf(li_l[crow(r, hi)]);
#pragma unroll
    for (int d = 0; d < NCB; ++d) o[d][r] *= rl; }
#undef ATT_SLOAD
#undef ATT_SWRITE
#undef ATT_RESC
#undef ATT_MASK
#undef ATT_STEP
}
template <int NCB> __device__ __forceinline__ void store_o(const f32x16 (&o)[NCB], bf16* Ob, int ld, int lane) {
  const int r32 = lane & 31, hi = lane >> 5, odd = lane & 1;
#pragma unroll
  for (int d = 0; d < NCB; ++d)
#pragma unroll
    for (int r = 0; r < 16; r += 2) {
      const float send = odd ? o[d][r] : o[d][r + 1];
      const float recv = dpp_xor1(send);
      const unsigned pk = cvtpk(odd ? recv : o[d][r], odd ? o[d][r + 1] : recv);
      const int row = crow(r + odd, hi);
      *(unsigned*)(Ob + (long)row * ld + d * 32 + (r32 & ~1)) = pk;
    }
}
template <int NCB> __device__ __forceinline__ void stage_o(const f32x16 (&o)[NCB], __attribute__((address_space(3))) unsigned char* stg, int ldb, int lane) {
  const int r32 = lane & 31, hi = lane >> 5, odd = lane & 1;
#pragma unroll
  for (int d = 0; d < NCB; ++d)
#pragma unroll
    for (int r = 0; r < 16; r += 2) {
      const float send = odd ? o[d][r] : o[d][r + 1];
      const float recv = dpp_xor1(send);
      const unsigned pk = cvtpk(odd ? recv : o[d][r], odd ? o[d][r + 1] : recv);
      const int row = crow(r + odd, hi);
      *(__attribute__((address_space(3))) unsigned*)(stg + row * ldb + (d * 32 + (r32 & ~1)) * 2) = pk;
    }
}
}


namespace ab2 {
using bf16=__hip_bfloat16;
using bf16x8=__attribute__((ext_vector_type(8)))short;
using s16x4=__attribute__((ext_vector_type(4)))short;
using f32x16=__attribute__((ext_vector_type(16)))float;
using u32x4=__attribute__((ext_vector_type(4)))unsigned;
constexpr int D=64;
constexpr int NW=8,QBLK=32,QB=QBLK*NW,KVBLK=64;
__device__ __forceinline__ int crow(int r,int hi){return (r&3)+8*(r>>2)+4*hi;}
#define SBAR() __builtin_amdgcn_sched_barrier(0)
__device__ __forceinline__ void wmask2(f32x16&p0,f32x16&p1,int dq,int hi){
  const float NEG=-__builtin_inff();
  #pragma unroll
  for(int r=0;r<16;++r){const unsigned d=(unsigned)(dq+crow(r,hi)); if(d>256u)p0[r]=NEG; if(d+32u>256u)p1[r]=NEG;}
}

constexpr int NSLOT=3, SLOTB=8192;
constexpr int LDS_K=0, LDS_V=NSLOT*SLOTB, LDS_WS=2*NSLOT*SLOTB, LDS_OST=LDS_WS+NW*64*4, LDS_BYTES=LDS_OST+NW*4096;
constexpr float C2=0.125f*1.4426950408889634f;
__device__ __forceinline__ void glds16(const void*gsrc,unsigned lds_dst){unsigned keep;
  asm volatile("s_mov_b32 %0, m0\n\ts_mov_b32 m0, %2\n\ts_nop 0\n\tglobal_load_lds_dwordx4 %1, off\n\ts_mov_b32 m0, %0":"=&s"(keep):"v"(gsrc),"s"(lds_dst):"memory");}
__device__ __forceinline__ float max3f(float a,float b,float c){float r;asm("v_max3_f32 %0, %1, %2, %3":"=v"(r):"v"(a),"v"(b),"v"(c));return r;}
__device__ __forceinline__ float max2f(float a,float b){float r;asm("v_max_f32_e32 %0, %1, %2":"=v"(r):"v"(a),"v"(b));return r;}
__device__ __forceinline__ float fadd_s(float a,float b){float r;asm("v_add_f32_e32 %0, %1, %2":"=v"(r):"v"(a),"v"(b));return r;}
__device__ __forceinline__ float fsub_s(float a,float b){float r;asm("v_sub_f32_e32 %0, %1, %2":"=v"(r):"v"(a),"v"(b));return r;}
typedef float f32x2_t __attribute__((ext_vector_type(2))); typedef __bf16 bf16x2_t __attribute__((ext_vector_type(2)));
__device__ __forceinline__ unsigned cvtpk_s(float lo,float hi){f32x2_t v={lo,hi};bf16x2_t b=__builtin_convertvector(v,bf16x2_t);return __builtin_bit_cast(unsigned,b);}
#define WAIT_BAR(N) asm volatile("s_waitcnt vmcnt(" #N ") lgkmcnt(0)\n\ts_barrier":::"memory")

__device__ __forceinline__ void qkt(f32x16&p0,f32x16&p1,const char*Kslot,const bf16x8*qr,const f32x16&negm,int r32,int hi){
  const char*kb=Kslot+hi*1024+r32*16;
  #pragma unroll
  for(int d0=0;d0<4;++d0){
    const bf16x8 b0=*reinterpret_cast<const bf16x8*>(kb+d0*2048);
    const bf16x8 b1=*reinterpret_cast<const bf16x8*>(kb+d0*2048+512);
    if(d0==0){p0=__builtin_amdgcn_mfma_f32_32x32x16_bf16(b0,qr[0],negm,0,0,0);p1=__builtin_amdgcn_mfma_f32_32x32x16_bf16(b1,qr[0],negm,0,0,0);}
    else{p0=__builtin_amdgcn_mfma_f32_32x32x16_bf16(b0,qr[d0],p0,0,0,0);p1=__builtin_amdgcn_mfma_f32_32x32x16_bf16(b1,qr[d0],p1,0,0,0);}}
}
typedef __attribute__((address_space(3))) const char* lds_cptr;
typedef short v4i16_t __attribute__((ext_vector_type(4)));
__device__ __forceinline__ void kload8(bf16x8*kf,lds_cptr kp){
  kf[0]=*(const __attribute__((address_space(3))) bf16x8*)(kp);      kf[1]=*(const __attribute__((address_space(3))) bf16x8*)(kp+512);
  kf[2]=*(const __attribute__((address_space(3))) bf16x8*)(kp+2048); kf[3]=*(const __attribute__((address_space(3))) bf16x8*)(kp+2560);
  kf[4]=*(const __attribute__((address_space(3))) bf16x8*)(kp+4096); kf[5]=*(const __attribute__((address_space(3))) bf16x8*)(kp+4608);
  kf[6]=*(const __attribute__((address_space(3))) bf16x8*)(kp+6144); kf[7]=*(const __attribute__((address_space(3))) bf16x8*)(kp+6656);
}
__device__ __forceinline__ void kload2(bf16x8*kf,lds_cptr kp,int j){ kf[2*j]=*(const __attribute__((address_space(3))) bf16x8*)(kp+j*2048); kf[2*j+1]=*(const __attribute__((address_space(3))) bf16x8*)(kp+j*2048+512); }
__device__ __forceinline__ s16x4 vtr(lds_cptr p){ return __builtin_bit_cast(s16x4,__builtin_amdgcn_ds_read_tr16_b64_v4i16((__attribute__((address_space(3))) v4i16_t*)p)); }
__device__ __forceinline__ float rowmax(const f32x16&p0,const f32x16&p1){
  float a=max3f(p0[0],p0[1],p1[0]),b=max3f(p0[2],p0[3],p1[1]);a=max3f(a,p1[2],p1[3]);
  #pragma unroll
  for(int r=4;r<16;r+=4){a=max3f(a,p0[r],p0[r+1]);b=max3f(b,p0[r+2],p0[r+3]);a=max3f(a,p1[r],p1[r+1]);b=max3f(b,p1[r+2],p1[r+3]);}
  const float m=max2f(a,b);
  auto rr=__builtin_amdgcn_permlane32_swap(__float_as_uint(m),__float_as_uint(m),false,false);
  return max2f(__uint_as_float(rr[0]),__uint_as_float(rr[1]));
}
__device__ __forceinline__ void pv(f32x16*o,int vb,bf16x8 pa0,bf16x8 pa1,bf16x8 pa2,bf16x8 pa3){
  #pragma unroll
  for(int d0=0;d0<2;++d0){s16x4 lo[4],hi[4];
    #pragma unroll
    for(int ks=0;ks<4;++ks){
      asm volatile("ds_read_b64_tr_b16 %0,%1 offset:%c2":"=&v"(lo[ks]):"v"(vb),"i"(d0*4096+ks*1024):"memory");
      asm volatile("ds_read_b64_tr_b16 %0,%1 offset:%c2":"=&v"(hi[ks]):"v"(vb),"i"(d0*4096+ks*1024+512):"memory");}
    asm volatile("s_waitcnt lgkmcnt(0)":::"memory");SBAR();
    #define PK(k) (bf16x8){lo[k][0],lo[k][1],lo[k][2],lo[k][3],hi[k][0],hi[k][1],hi[k][2],hi[k][3]}
    o[d0]=__builtin_amdgcn_mfma_f32_32x32x16_bf16(pa0,PK(0),o[d0],0,0,0);
    o[d0]=__builtin_amdgcn_mfma_f32_32x32x16_bf16(pa1,PK(1),o[d0],0,0,0);
    o[d0]=__builtin_amdgcn_mfma_f32_32x32x16_bf16(pa2,PK(2),o[d0],0,0,0);
    o[d0]=__builtin_amdgcn_mfma_f32_32x32x16_bf16(pa3,PK(3),o[d0],0,0,0);
    #undef PK
  }
}

#ifndef ATTN_STORE16
#define ATTN_STORE16(p,v) (*(u32x4*)(p)=(v))
#endif
template<int THRL,int LDQ,int LDO,bool WINDOW,bool TWOHEAD=false> __device__ __forceinline__ bool attn_unit(bool pre,const bf16*Qb,const bf16*__restrict__ Kh,const bf16*__restrict__ Vh,bf16*Ob,int ntiles,int qpos0,int kpos0,float sink_l2,char*shm,int wv,float sink2_l2,
                                                                                                          const bf16*Qn,const bf16*Kn,const bf16*Vn,bool has_next){
  const int tid=fresh_tid(wv),lane=tid&63,r32=lane&31,hi=lane>>5; const int wid=__builtin_amdgcn_readfirstlane(tid>>6);
  const int wrow=TWOHEAD?(wid&3):wid, whead=TWOHEAD?(wid>>2):0;
  if constexpr(TWOHEAD) sink_l2=whead?sink2_l2:sink_l2;
  const bf16*Qw=Qb+(long)(wrow*QBLK)*LDQ+whead*64;
  const unsigned lds0=(unsigned)(uintptr_t)shm;
  float*wsf=(float*)(shm+LDS_WS)+wid*64;
  const bf16*ksrc=Kh+(long)lane*LDQ+wid*8;
  const bf16*vsrc=Vh+(long)(16*(wid&3)+(lane>>2))*LDQ+(wid>>2)*32+(lane&3)*8;
  const unsigned kdst=lds0+LDS_K+wid*1024, vdst=lds0+LDS_V+wid*1024;
  #define DMA_K(t,slot) glds16(ksrc+(long)(t)*KVBLK*LDQ,(unsigned)__builtin_amdgcn_readfirstlane(kdst+(slot)))
  #define DMA_V(t,slot) glds16(vsrc+(long)(t)*KVBLK*LDQ,(unsigned)__builtin_amdgcn_readfirstlane(vdst+(slot)))
  const int vb0=(int)(lds0+LDS_V)+((lane>>4)&1)*32+(lane&3)*8+(4*hi+((lane&15)>>2))*64;
  const char*Kbase=shm+LDS_K; bf16x8 kf[8];
  const lds_cptr shm3=(lds_cptr)shm; const lds_cptr kp0=shm3+LDS_K+hi*1024+r32*16; const lds_cptr vp0=shm3+LDS_V+((lane>>4)&1)*32+(lane&3)*8+(4*hi+((lane&15)>>2))*64;
  const int NT=ntiles;
  const unsigned qscr=lds0+86016u+(unsigned)wid*4096u;
  bf16x8 qr[4];
  if(!pre){
  DMA_K(0,0);DMA_V(0,0);DMA_K(1,SLOTB);
  #pragma unroll
  for(int d0=0;d0<4;++d0)qr[d0]=*reinterpret_cast<const bf16x8*>(&Qw[(long)r32*LDQ+d0*16+hi*8]);
  }
  float mhat=0.f,l_reg=0.f;f32x16 o[2];o[0]=f32x16{};o[1]=f32x16{};f32x16 negm=f32x16{};asm volatile("":"+v"(negm));
  const int dq0=kpos0-(qpos0+wrow*QBLK+r32)+128;
  #define CMASK(P0,P1,t) do{ if constexpr(WINDOW) wmask2(P0,P1,dq0+(t)*KVBLK,hi); }while(0)
  bool resc=false;
  #define START(P0,P1) do{ const float rm=rowmax(P0,P1); resc=false; \
    { const float dl=__builtin_fmaxf(rm,0.f); mhat=fadd_s(mhat,dl); \
      _Pragma("unroll") for(int r=0;r<16;++r){P0[r]=fsub_s(P0[r],dl);P1[r]=fsub_s(P1[r],dl);} \
      _Pragma("unroll") for(int r=0;r<16;++r)negm[r]=-mhat; asm volatile("":"+v"(negm)); } \
    _Pragma("unroll") for(int r=0;r<16;++r)P0[r]=__builtin_amdgcn_exp2f(P0[r]); }while(0)
  #define RESC() do{ if(resc){ asm volatile("s_waitcnt lgkmcnt(0)":::"memory"); \
      _Pragma("unroll") for(int d_=0;d_<2;++d_) _Pragma("unroll") for(int r=0;r<16;++r)o[d_][r]*=wsf[crow(r,hi)]; } }while(0)
  f32x16 pA0,pA1,pB0,pB1;
  int sl_prev=0,sl_cur=0,sl_next=SLOTB;
  #define ROT() do{sl_prev=sl_cur;sl_cur=sl_next;sl_next=(sl_next==(NSLOT-1)*SLOTB)?0:sl_next+SLOTB;}while(0)
  if(!pre){DMA_K(2,2*SLOTB);}
  WAIT_BAR(3);
  if(pre){
    #pragma unroll
    for(int d0=0;d0<4;++d0)qr[d0]=*(const __attribute__((address_space(3))) bf16x8*)((lds_cptr)shm+86016+wid*4096+d0*1024+lane*16);
  }
  qkt(pA0,pA1,Kbase,qr,negm,r32,hi);asm volatile("s_nop 15\n\ts_nop 7":"+v"(pA0),"+v"(pA1));CMASK(pA0,pA1,0);
  START(pA0,pA1);
  _Pragma("unroll") for(int r=0;r<16;++r)pA1[r]=__builtin_amdgcn_exp2f(pA1[r]);
  WAIT_BAR(0);
  DMA_K(3,0);DMA_V(1,SLOTB);
  ROT();
  kload8(kf,kp0+sl_cur);
  WAIT_BAR(2);
  s16x4 vlo[8],vhi[8]; u32x4 pw0,pw1,pw2,pw3;
  #define PKW(P,B) cvtpk_s(P[B],P[B+1])
  #define PAF(k) __builtin_bit_cast(bf16x8,pw##k)
  #define VFR(i) (bf16x8){vlo[i][0],vlo[i][1],vlo[i][2],vlo[i][3],vhi[i][0],vhi[i][1],vhi[i][2],vhi[i][3]}
  #define PIN(x) asm volatile("":"+v"(x))
  #define MX3(a,b,c) __builtin_fmaxf(__builtin_fmaxf((a),(b)),(c))
  #define GAPA(MF,A0,A1,A2,A3,W0,W1,PW) do{ MF; sacc+=A0; sacc+=A1; sacc+=A2; sacc+=A3; PIN(sacc); W0; W1; PIN(PW); SBAR(); }while(0)
  #define EX(v) __builtin_amdgcn_exp2f(v)
  #define GAPB(MF,X,B) do{ MF; X[B]=EX(X[B]); X[B+1]=EX(X[B+1]); X[B+2]=EX(X[B+2]); X[B+3]=EX(X[B+3]); PIN(X); SBAR(); }while(0)
  #define VRD(i) do{ vlo[i]=vtr(vp_+(((i)>>2)*4096+((i)&3)*1024)); vhi[i]=vtr(vp_+(((i)>>2)*4096+((i)&3)*1024+512)); }while(0)
  #define KRD(G,j) do{ if(G){ kload2(kf,kp0+sl_next,j); SBAR(); } }while(0)
  #define STEP(C0,C1,P0,P1,t,GK,GV,GL) do{ SBAR(); \
    const lds_cptr vp_=vp0+sl_prev; \
    VRD(0); SBAR(); float sacc=(P0[0]+P0[1]); \
    GAPA(C0=__builtin_amdgcn_mfma_f32_32x32x16_bf16(kf[0],qr[0],negm,0,0,0), P0[2],P0[3],P0[4],P0[5],     pw0[0]=PKW(P0,0), pw0[1]=PKW(P0,2), pw0); \
    VRD(4); SBAR(); GAPA(C1=__builtin_amdgcn_mfma_f32_32x32x16_bf16(kf[1],qr[0],negm,0,0,0), P0[6],P0[7],P0[8],P0[9],     pw0[2]=PKW(P0,4), pw0[3]=PKW(P0,6), pw0); \
    VRD(1); SBAR(); GAPA(C0=__builtin_amdgcn_mfma_f32_32x32x16_bf16(kf[2],qr[1],C0,0,0,0),   P0[10],P0[11],P0[12],P0[13], pw1[0]=PKW(P0,8), pw1[1]=PKW(P0,10), pw1); \
    VRD(5); SBAR(); GAPA(C1=__builtin_amdgcn_mfma_f32_32x32x16_bf16(kf[3],qr[1],C1,0,0,0),   P0[14],P0[15],P1[0],P1[1],   pw1[2]=PKW(P0,12),pw1[3]=PKW(P0,14), pw1); \
    VRD(2); SBAR(); GAPA(C0=__builtin_amdgcn_mfma_f32_32x32x16_bf16(kf[4],qr[2],C0,0,0,0),   P1[2],P1[3],P1[4],P1[5],     pw2[0]=PKW(P1,0), pw2[1]=PKW(P1,2), pw2); \
    VRD(6); SBAR(); GAPA(C1=__builtin_amdgcn_mfma_f32_32x32x16_bf16(kf[5],qr[2],C1,0,0,0),   P1[6],P1[7],P1[8],P1[9],     pw2[2]=PKW(P1,4), pw2[3]=PKW(P1,6), pw2); \
    VRD(3); SBAR(); GAPA(C0=__builtin_amdgcn_mfma_f32_32x32x16_bf16(kf[6],qr[3],C0,0,0,0),   P1[10],P1[11],P1[12],P1[13], pw3[0]=PKW(P1,8), pw3[1]=PKW(P1,10), pw3); \
    VRD(7); SBAR(); GAPA(C1=__builtin_amdgcn_mfma_f32_32x32x16_bf16(kf[7],qr[3],C1,0,0,0),   P1[14],P1[15],0.f,0.f,       pw3[2]=PKW(P1,12),pw3[3]=PKW(P1,14), pw3); \
    l_reg+=sacc; \
    if(GK){DMA_K((t)+3,sl_cur);} if(GV){DMA_V((t)+1,sl_next);} \
    CMASK(C0,C1,t); \
    { float a=MX3(C0[0],C0[1],C1[0]),b=MX3(C0[2],C0[3],C1[1]); a=MX3(a,C1[2],C1[3]); \
      _Pragma("unroll") for(int r=4;r<16;r+=4){a=MX3(a,C0[r],C0[r+1]);b=MX3(b,C0[r+2],C0[r+3]);a=MX3(a,C1[r],C1[r+1]);b=MX3(b,C1[r+2],C1[r+3]);} \
      float rm=__builtin_fmaxf(a,b); { auto rr=__builtin_amdgcn_permlane32_swap(__float_as_uint(rm),__float_as_uint(rm),false,false); rm=__builtin_fmaxf(__uint_as_float(rr[0]),__uint_as_float(rr[1])); } \
      resc=false; \
      if(__builtin_expect(__any(rm>(float)THRL),0)){ const float dl=__builtin_fmaxf(rm,0.f); mhat+=dl; \
        _Pragma("unroll") for(int r=0;r<16;++r){C0[r]-=dl;C1[r]-=dl;} \
        _Pragma("unroll") for(int r=0;r<16;++r)negm[r]=-mhat; asm volatile("":"+v"(negm)); \
        const float f=__builtin_amdgcn_exp2f(-dl); l_reg*=f; if(hi==0)wsf[r32]=f; resc=true; } } \
    SBAR(); \
    GAPB(o[0]=__builtin_amdgcn_mfma_f32_32x32x16_bf16(PAF(0),VFR(0),o[0],0,0,0), C0,0); \
    GAPB(o[1]=__builtin_amdgcn_mfma_f32_32x32x16_bf16(PAF(0),VFR(4),o[1],0,0,0), C0,4); \
    KRD(GL,0); GAPB(o[0]=__builtin_amdgcn_mfma_f32_32x32x16_bf16(PAF(1),VFR(1),o[0],0,0,0), C0,8); \
    KRD(GL,1); GAPB(o[1]=__builtin_amdgcn_mfma_f32_32x32x16_bf16(PAF(1),VFR(5),o[1],0,0,0), C0,12); \
    KRD(GL,2); GAPB(o[0]=__builtin_amdgcn_mfma_f32_32x32x16_bf16(PAF(2),VFR(2),o[0],0,0,0), C1,0); \
    KRD(GL,3); GAPB(o[1]=__builtin_amdgcn_mfma_f32_32x32x16_bf16(PAF(2),VFR(6),o[1],0,0,0), C1,4); \
    GAPB(o[0]=__builtin_amdgcn_mfma_f32_32x32x16_bf16(PAF(3),VFR(3),o[0],0,0,0), C1,8); \
    GAPB(o[1]=__builtin_amdgcn_mfma_f32_32x32x16_bf16(PAF(3),VFR(7),o[1],0,0,0), C1,12); \
    }while(0)
  int t=1;
  for(;t+5<NT;t+=2){
    STEP(pB0,pB1,pA0,pA1,t,true,true,true);     WAIT_BAR(2); RESC(); ROT();
    STEP(pA0,pA1,pB0,pB1,t+1,true,true,true);   WAIT_BAR(2); RESC(); ROT();
  }
  #define ENDW(tt) do{ if((tt)+3<NT){WAIT_BAR(2);} else if((tt)+2<NT){WAIT_BAR(1);} else {WAIT_BAR(0);} }while(0)
  for(;t+1<NT;t+=2){
    STEP(pB0,pB1,pA0,pA1,t,(t+3<NT),(t+1<NT),(t+1<NT));       ENDW(t);   RESC(); ROT();
    STEP(pA0,pA1,pB0,pB1,t+1,(t+4<NT),(t+2<NT),(t+2<NT));     ENDW(t+1); RESC(); ROT();
  }
  STEP(pB0,pB1,pA0,pA1,NT-1,false,false,false); RESC();
  bool issued=false;
  if(has_next&&(NT%3!=1)){
    asm volatile("s_waitcnt lgkmcnt(0)\n\ts_barrier":::"memory");
    const bf16*ksn=Kn+(long)lane*LDQ+wid*8; const bf16*vsn=Vn+(long)(16*(wid&3)+(lane>>2))*LDQ+(wid>>2)*32+(lane&3)*8; const bf16*Qwn=Qn+(long)(wrow*QBLK)*LDQ+whead*64;
    glds16(ksn,(unsigned)__builtin_amdgcn_readfirstlane(kdst)); glds16(vsn,(unsigned)__builtin_amdgcn_readfirstlane(vdst)); glds16(ksn+(long)KVBLK*LDQ,(unsigned)__builtin_amdgcn_readfirstlane(kdst+SLOTB));
    #pragma unroll
    for(int d0=0;d0<4;++d0)glds16(&Qwn[(long)r32*LDQ+d0*16+hi*8],(unsigned)__builtin_amdgcn_readfirstlane(qscr+(unsigned)d0*1024u));
    glds16(ksn+(long)2*KVBLK*LDQ,(unsigned)__builtin_amdgcn_readfirstlane(kdst+2*SLOTB));
    issued=true;
  }
  { float sacc=pB0[0]+pB0[1]; _Pragma("unroll") for(int r=2;r<16;++r)sacc+=pB0[r]; _Pragma("unroll") for(int r=0;r<16;++r)sacc+=pB1[r]; l_reg+=sacc;
    pw0=(u32x4){PKW(pB0,0),PKW(pB0,2),PKW(pB0,4),PKW(pB0,6)};pw1=(u32x4){PKW(pB0,8),PKW(pB0,10),PKW(pB0,12),PKW(pB0,14)};pw2=(u32x4){PKW(pB1,0),PKW(pB1,2),PKW(pB1,4),PKW(pB1,6)};pw3=(u32x4){PKW(pB1,8),PKW(pB1,10),PKW(pB1,12),PKW(pB1,14)};
    SBAR(); pv(o,vb0+sl_cur,PAF(0),PAF(1),PAF(2),PAF(3)); }
  #undef PKW
  #undef PAF
  #undef VFR
  #undef PIN
  #undef MX3
  #undef GAPA
  #undef GAPB
  #undef EX
  #undef VRD
  #undef KRD
  #undef STEP
  #undef ENDW
  {auto rr=__builtin_amdgcn_permlane32_swap(__float_as_uint(l_reg),__float_as_uint(l_reg),false,false);l_reg=__uint_as_float(rr[0])+__uint_as_float(rr[1]);}
  l_reg+=__builtin_amdgcn_exp2f(sink_l2-mhat);
  if(hi==0)wsf[32+r32]=l_reg;asm volatile("s_waitcnt lgkmcnt(0)":::"memory");
  float rli[16];
  #pragma unroll
  for(int r=0;r<16;++r)rli[r]=__builtin_amdgcn_rcpf(wsf[32+crow(r,hi)]);
  bf16*Ow=Ob+(long)(wrow*QBLK)*LDO+whead*64;
  { bf16*stg=(bf16*)(shm+LDS_OST)+wid*2048;
    #pragma unroll
    for(int r=0;r<16;++r){const int orow=crow(r,hi);
      #pragma unroll
      for(int d0=0;d0<2;++d0)stg[orow*64+d0*32+r32]=__float2bfloat16(o[d0][r]*rli[r]);}
    asm volatile("s_waitcnt lgkmcnt(0)":::"memory");
    #pragma unroll
    for(int i=0;i<4;++i){const int row=i*8+(lane>>3),ch=lane&7; const u32x4 v=*(const u32x4*)(stg+row*64+ch*8); ATTN_STORE16(Ow+(long)row*LDO+ch*8,v);} }
  asm volatile("s_waitcnt lgkmcnt(0)\n\ts_barrier":::"memory");
  #undef DMA_K
  #undef DMA_V
  #undef CMASK
  #undef START
  #undef RESC
  #undef ROT
  return issued;
}

constexpr int LDS128_K=0, LDS128_V=3*SLOTB, LDS128_WS=LDS128_V+3*2*SLOTB, LDS128_BYTES=LDS128_WS+NW*64*4;
__device__ __forceinline__ void pv128(f32x16*o,int vb,bf16x8 pa0,bf16x8 pa1,bf16x8 pa2,bf16x8 pa3){
  #pragma unroll
  for(int d0=0;d0<4;++d0){s16x4 lo[4],hi[4];
    #pragma unroll
    for(int ks=0;ks<4;++ks){
      asm volatile("ds_read_b64_tr_b16 %0,%1 offset:%c2":"=&v"(lo[ks]):"v"(vb),"i"(d0*4096+ks*1024):"memory");
      asm volatile("ds_read_b64_tr_b16 %0,%1 offset:%c2":"=&v"(hi[ks]):"v"(vb),"i"(d0*4096+ks*1024+512):"memory");}
    asm volatile("s_waitcnt lgkmcnt(0)":::"memory");SBAR();
    #define PK(k) (bf16x8){lo[k][0],lo[k][1],lo[k][2],lo[k][3],hi[k][0],hi[k][1],hi[k][2],hi[k][3]}
    o[d0]=__builtin_amdgcn_mfma_f32_32x32x16_bf16(pa0,PK(0),o[d0],0,0,0);
    o[d0]=__builtin_amdgcn_mfma_f32_32x32x16_bf16(pa1,PK(1),o[d0],0,0,0);
    o[d0]=__builtin_amdgcn_mfma_f32_32x32x16_bf16(pa2,PK(2),o[d0],0,0,0);
    o[d0]=__builtin_amdgcn_mfma_f32_32x32x16_bf16(pa3,PK(3),o[d0],0,0,0);
    #undef PK
  }
}
template<int THRL,int LDQ> __device__ __forceinline__ void attn_unit128(f32x16 (&o)[4],const bf16*Qb,const bf16*__restrict__ Kh,const bf16*__restrict__ Vh,int ntiles,char*shm,int wv){
  const int tid=fresh_tid(wv),lane=tid&63,r32=lane&31,hi=lane>>5; const int wid=__builtin_amdgcn_readfirstlane(tid>>6);
  const bf16*Qw=Qb+(long)(wid*QBLK)*LDQ;
  const unsigned lds0=(unsigned)(uintptr_t)shm;
  float*wsf=(float*)(shm+LDS128_WS)+wid*64;
  const bf16*ksrc=Kh+(long)lane*LDQ+wid*8;
  const bf16*vsrc=Vh+(long)(16*(wid&3)+(lane>>2))*LDQ+(wid>>2)*32+(lane&3)*8;
  const unsigned kdst=lds0+LDS128_K+wid*1024, vdst=lds0+LDS128_V+wid*1024;
  #define DMA_K(t,slot) glds16(ksrc+(long)(t)*KVBLK*LDQ,(unsigned)__builtin_amdgcn_readfirstlane(kdst+(slot)))
  #define DMA_V(t,slot) do{ glds16(vsrc+(long)(t)*KVBLK*LDQ,(unsigned)__builtin_amdgcn_readfirstlane(vdst+2*(slot))); glds16(vsrc+(long)(t)*KVBLK*LDQ+64,(unsigned)__builtin_amdgcn_readfirstlane(vdst+2*(slot)+8192)); }while(0)
  const int vb0=(int)(lds0+LDS128_V)+((lane>>4)&1)*32+(lane&3)*8+(4*hi+((lane&15)>>2))*64;
  const char*Kbase=shm+LDS128_K; bf16x8 kfa[2],kfb[2];
  const lds_cptr shm3=(lds_cptr)shm; const lds_cptr kp0=shm3+LDS128_K+hi*1024+r32*16; const lds_cptr vp0=shm3+LDS128_V+((lane>>4)&1)*32+(lane&3)*8+(4*hi+((lane&15)>>2))*64;
  const int NT=ntiles;
  DMA_K(0,0);DMA_V(0,0);DMA_K(1,SLOTB);
  bf16x8 qr[4];
  #pragma unroll
  for(int d0=0;d0<4;++d0)qr[d0]=*reinterpret_cast<const bf16x8*>(&Qw[(long)r32*LDQ+d0*16+hi*8]);
  float mhat=0.f,l_reg=0.f;
  float z0_=0.f; asm volatile("":"+v"(z0_));
  f32x16 negm;
  #pragma unroll
  for(int r=0;r<16;++r){negm[r]=z0_;
    #pragma unroll
    for(int d_=0;d_<4;++d_)o[d_][r]=z0_;}
  asm volatile("":"+v"(negm));
  bool resc=false;
  #define START(P0,P1) do{ const float rm=rowmax(P0,P1); resc=false; \
    { const float dl=__builtin_fmaxf(rm,0.f); mhat=fadd_s(mhat,dl); \
      _Pragma("unroll") for(int r=0;r<16;++r){P0[r]=fsub_s(P0[r],dl);P1[r]=fsub_s(P1[r],dl);} \
      _Pragma("unroll") for(int r=0;r<16;++r)negm[r]=-mhat; asm volatile("":"+v"(negm)); } \
    _Pragma("unroll") for(int r=0;r<16;++r)P0[r]=__builtin_amdgcn_exp2f(P0[r]); }while(0)
  #define RESC() do{ if(resc){ asm volatile("s_waitcnt lgkmcnt(0)":::"memory"); \
      _Pragma("unroll") for(int d_=0;d_<4;++d_) _Pragma("unroll") for(int r=0;r<16;++r)o[d_][r]*=wsf[crow(r,hi)]; } }while(0)
  f32x16 pA0,pA1,pB0,pB1;
  int sl_prev=0,sl_cur=0,sl_next=SLOTB;
  #define ROT() do{sl_prev=sl_cur;sl_cur=sl_next;sl_next=(sl_next==(NSLOT-1)*SLOTB)?0:sl_next+SLOTB;}while(0)
  WAIT_BAR(3);
  qkt(pA0,pA1,Kbase,qr,negm,r32,hi);asm volatile("s_nop 15\n\ts_nop 7":"+v"(pA0),"+v"(pA1));
  START(pA0,pA1);
  _Pragma("unroll") for(int r=0;r<16;++r)pA1[r]=__builtin_amdgcn_exp2f(pA1[r]);
  WAIT_BAR(0);
  DMA_K(2,2*SLOTB);DMA_V(1,SLOTB);
  ROT();
  s16x4 vlo[4],vhi[4]; u32x4 pw0,pw1,pw2,pw3;
  #define PKW(P,B) cvtpk_s(P[B],P[B+1])
  #define PAF(k) __builtin_bit_cast(bf16x8,pw##k)
  #define VFR(i) (bf16x8){vlo[i][0],vlo[i][1],vlo[i][2],vlo[i][3],vhi[i][0],vhi[i][1],vhi[i][2],vhi[i][3]}
  #define PIN(x) asm volatile("":"+v"(x))
  #define MX3(a,b,c) __builtin_fmaxf(__builtin_fmaxf((a),(b)),(c))
  #define GAPA(MF,A0,A1,A2,A3,W0,W1,PW) do{ MF; sacc+=A0; sacc+=A1; sacc+=A2; sacc+=A3; PIN(sacc); W0; W1; PIN(PW); SBAR(); }while(0)
  #define EX(v) __builtin_amdgcn_exp2f(v)
  #define GAPB2(MF,X,B) do{ MF; X[B]=EX(X[B]); X[B+1]=EX(X[B+1]); PIN(X); SBAR(); }while(0)
  #define VRDX(s,DB,KS) do{ vlo[s]=vtr(vp_+((DB)*4096+(KS)*1024)); vhi[s]=vtr(vp_+((DB)*4096+(KS)*1024+512)); }while(0)
  #define KRDP(DST,j) do{ DST[0]=*(const __attribute__((address_space(3))) bf16x8*)(kp_+(j)*2048); DST[1]=*(const __attribute__((address_space(3))) bf16x8*)(kp_+(j)*2048+512); }while(0)
  #define MF32(A,B,C) __builtin_amdgcn_mfma_f32_32x32x16_bf16(A,B,C,0,0,0)
  #define STEP128(C0,C1,P0,P1,t,GK,GV) do{ SBAR(); \
    if(GK){DMA_K((t)+2,sl_prev);} if(GV){DMA_V((t)+1,sl_next);} \
    const lds_cptr vp_=vp0+2*sl_prev; const lds_cptr kp_=kp0+sl_cur; \
    KRDP(kfa,0); KRDP(kfb,1); SBAR(); \
    VRDX(0,0,0); SBAR(); float sacc=(P0[0]+P0[1]); \
    GAPA(C0=MF32(kfa[0],qr[0],negm), P0[2],P0[3],P0[4],P0[5],     pw0[0]=PKW(P0,0), pw0[1]=PKW(P0,2), pw0); \
    VRDX(1,1,0); SBAR(); GAPA(C1=MF32(kfa[1],qr[0],negm), P0[6],P0[7],P0[8],P0[9],     pw0[2]=PKW(P0,4), pw0[3]=PKW(P0,6), pw0); \
    KRDP(kfa,2); SBAR(); \
    VRDX(2,2,0); SBAR(); GAPA(C0=MF32(kfb[0],qr[1],C0),   P0[10],P0[11],P0[12],P0[13], pw1[0]=PKW(P0,8), pw1[1]=PKW(P0,10), pw1); \
    VRDX(3,3,0); SBAR(); GAPA(C1=MF32(kfb[1],qr[1],C1),   P0[14],P0[15],P1[0],P1[1],   pw1[2]=PKW(P0,12),pw1[3]=PKW(P0,14), pw1); \
    KRDP(kfb,3); SBAR(); \
    GAPA(C0=MF32(kfa[0],qr[2],C0),   P1[2],P1[3],P1[4],P1[5],     pw2[0]=PKW(P1,0), pw2[1]=PKW(P1,2), pw2); \
    GAPA(C1=MF32(kfa[1],qr[2],C1),   P1[6],P1[7],P1[8],P1[9],     pw2[2]=PKW(P1,4), pw2[3]=PKW(P1,6), pw2); \
    GAPA(C0=MF32(kfb[0],qr[3],C0),   P1[10],P1[11],P1[12],P1[13], pw3[0]=PKW(P1,8), pw3[1]=PKW(P1,10), pw3); \
    GAPA(C1=MF32(kfb[1],qr[3],C1),   P1[14],P1[15],0.f,0.f,       pw3[2]=PKW(P1,12),pw3[3]=PKW(P1,14), pw3); \
    l_reg+=sacc; \
    { float a=MX3(C0[0],C0[1],C1[0]),b=MX3(C0[2],C0[3],C1[1]); a=MX3(a,C1[2],C1[3]); \
      _Pragma("unroll") for(int r=4;r<16;r+=4){a=MX3(a,C0[r],C0[r+1]);b=MX3(b,C0[r+2],C0[r+3]);a=MX3(a,C1[r],C1[r+1]);b=MX3(b,C1[r+2],C1[r+3]);} \
      float rm=__builtin_fmaxf(a,b); { auto rr=__builtin_amdgcn_permlane32_swap(__float_as_uint(rm),__float_as_uint(rm),false,false); rm=__builtin_fmaxf(__uint_as_float(rr[0]),__uint_as_float(rr[1])); } \
      resc=false; \
      if(__builtin_expect(__any(rm>(float)THRL),0)){ const float dl=__builtin_fmaxf(rm,0.f); mhat+=dl; \
        _Pragma("unroll") for(int r=0;r<16;++r){C0[r]-=dl;C1[r]-=dl;} \
        _Pragma("unroll") for(int r=0;r<16;++r)negm[r]=-mhat; asm volatile("":"+v"(negm)); \
        const float f=__builtin_amdgcn_exp2f(-dl); l_reg*=f; if(hi==0)wsf[r32]=f; resc=true; } } \
    SBAR(); \
    GAPB2(o[0]=MF32(PAF(0),VFR(0),o[0]), C0,0);  VRDX(0,0,1); SBAR(); \
    GAPB2(o[1]=MF32(PAF(0),VFR(1),o[1]), C0,2);  VRDX(1,1,1); SBAR(); \
    GAPB2(o[2]=MF32(PAF(0),VFR(2),o[2]), C0,4);  VRDX(2,2,1); SBAR(); \
    GAPB2(o[3]=MF32(PAF(0),VFR(3),o[3]), C0,6);  VRDX(3,3,1); SBAR(); \
    GAPB2(o[0]=MF32(PAF(1),VFR(0),o[0]), C0,8);  VRDX(0,0,2); SBAR(); \
    GAPB2(o[1]=MF32(PAF(1),VFR(1),o[1]), C0,10); VRDX(1,1,2); SBAR(); \
    GAPB2(o[2]=MF32(PAF(1),VFR(2),o[2]), C0,12); VRDX(2,2,2); SBAR(); \
    GAPB2(o[3]=MF32(PAF(1),VFR(3),o[3]), C0,14); VRDX(3,3,2); SBAR(); \
    GAPB2(o[0]=MF32(PAF(2),VFR(0),o[0]), C1,0);  VRDX(0,0,3); SBAR(); \
    GAPB2(o[1]=MF32(PAF(2),VFR(1),o[1]), C1,2);  VRDX(1,1,3); SBAR(); \
    GAPB2(o[2]=MF32(PAF(2),VFR(2),o[2]), C1,4);  VRDX(2,2,3); SBAR(); \
    GAPB2(o[3]=MF32(PAF(2),VFR(3),o[3]), C1,6);  VRDX(3,3,3); SBAR(); \
    GAPB2(o[0]=MF32(PAF(3),VFR(0),o[0]), C1,8); \
    GAPB2(o[1]=MF32(PAF(3),VFR(1),o[1]), C1,10); \
    GAPB2(o[2]=MF32(PAF(3),VFR(2),o[2]), C1,12); \
    GAPB2(o[3]=MF32(PAF(3),VFR(3),o[3]), C1,14); \
    }while(0)
  #define ENDW128(tt) do{ if((tt)+2<NT){WAIT_BAR(3);} else {WAIT_BAR(0);} }while(0)
  for(int t=1;t+1<NT;t+=2){
    STEP128(pB0,pB1,pA0,pA1,t,(t+2<NT),(t+1<NT));       ENDW128(t);   RESC(); ROT();
    STEP128(pA0,pA1,pB0,pB1,t+1,(t+3<NT),(t+2<NT));     ENDW128(t+1); RESC(); ROT();
  }
  STEP128(pB0,pB1,pA0,pA1,NT-1,false,false); RESC();
  { float sacc=pB0[0]+pB0[1]; _Pragma("unroll") for(int r=2;r<16;++r)sacc+=pB0[r]; _Pragma("unroll") for(int r=0;r<16;++r)sacc+=pB1[r]; l_reg+=sacc;
    pw0=(u32x4){PKW(pB0,0),PKW(pB0,2),PKW(pB0,4),PKW(pB0,6)};pw1=(u32x4){PKW(pB0,8),PKW(pB0,10),PKW(pB0,12),PKW(pB0,14)};pw2=(u32x4){PKW(pB1,0),PKW(pB1,2),PKW(pB1,4),PKW(pB1,6)};pw3=(u32x4){PKW(pB1,8),PKW(pB1,10),PKW(pB1,12),PKW(pB1,14)};
    SBAR(); pv128(o,vb0+2*sl_cur,PAF(0),PAF(1),PAF(2),PAF(3)); }
  #undef PKW
  #undef PAF
  #undef VFR
  #undef PIN
  #undef MX3
  #undef GAPA
  #undef GAPB2
  #undef EX
  #undef VRDX
  #undef KRDP
  #undef MF32
  #undef STEP128
  #undef ENDW128
  {auto rr=__builtin_amdgcn_permlane32_swap(__float_as_uint(l_reg),__float_as_uint(l_reg),false,false);l_reg=__uint_as_float(rr[0])+__uint_as_float(rr[1]);}
  if(hi==0)wsf[32+r32]=l_reg;asm volatile("s_waitcnt lgkmcnt(0)":::"memory");
  #pragma unroll
  for(int r=0;r<16;++r){const float rl=__builtin_amdgcn_rcpf(wsf[32+crow(r,hi)]);
    #pragma unroll
    for(int d_=0;d_<4;++d_)o[d_][r]*=rl;}
  asm volatile("s_waitcnt lgkmcnt(0)\n\ts_barrier":::"memory");
  #undef DMA_K
  #undef DMA_V
  #undef START
  #undef RESC
  #undef ROT
}

#undef SBAR
#undef WAIT_BAR
}

constexpr int NWAVES = 8;
constexpr int DM = 1024, NB = 32, SEQ = 2048, NTOK = NB * SEQ, DEPTH = 4, NE = 16, CAP = 256, FF = 2048, NROWS_E = NB * NE * CAP;
constexpr float RMS_EPS = 1e-6f;
constexpr float YE_SCALE = 32.0f, YE_INV = 1.0f / 32.0f;
constexpr float QSCALE = 0.125f * 1.4426950408889634f;
constexpr size_t MiB = 1u << 20;
constexpr size_t WS_CTL = 0, CTL_ZERO_BYTES = 64 * 1024;
constexpr size_t WS_TAB = 1 * MiB;
constexpr size_t WS_MISC = 2 * MiB;
constexpr size_t WS_AFF = 3 * MiB;
constexpr size_t WS_GATE = 7 * MiB;
constexpr size_t WS_TOK = 2 * MiB + 512 * 1024;
constexpr size_t WS_SLOT = 8 * MiB;
constexpr size_t WS_WATT = 10 * MiB, WATT_STRIDE = 8 * MiB, WATT_O = 6 * MiB;
constexpr size_t WS_WMOE = 42 * MiB, WMOE_STRIDE = 96 * MiB, WMOE_D = 64 * MiB;
constexpr size_t WS_H = 426 * MiB;
constexpr size_t WS_H8 = 554 * MiB;
constexpr size_t WS_BIG = 618 * MiB;
constexpr size_t WS_ATT = WS_BIG + 384 * MiB;
constexpr size_t WS_XE = 1130 * MiB;
constexpr size_t WS_XB = 1386 * MiB;
constexpr size_t WS_HID = 1514 * MiB;
constexpr size_t WS_END = 1770 * MiB;
constexpr int CW_BAR = 1024;
constexpr int RING_BYTES = 131072, LDSCTL_OFF = 146432, MISC_OFF = LDSCTL_OFF + 320, LDS_BYTES = 147456;

#define GAS __attribute__((address_space(1)))
#define LAS __attribute__((address_space(3)))
typedef unsigned short bf16;
typedef unsigned v4u __attribute__((ext_vector_type(4)));
typedef unsigned v2u __attribute__((ext_vector_type(2)));
typedef float f32x4 __attribute__((ext_vector_type(4)));
#define LDS_WAIT() asm volatile("s_waitcnt lgkmcnt(0)" ::: "memory")
#define VM_WAIT() asm volatile("s_waitcnt vmcnt(0)" ::: "memory")
__device__ __forceinline__ unsigned pk2(float lo, float hi) { unsigned r; asm volatile("v_cvt_pk_bf16_f32 %0, %1, %2" : "=v"(r) : "v"(lo), "v"(hi)); return r; }
__device__ __forceinline__ float bflo(unsigned w) { return __uint_as_float(w << 16); }
__device__ __forceinline__ float bfhi(unsigned w) { return __uint_as_float(w & 0xffff0000u); }


struct Args {
    const float* x; const float* attn_g; const float* ffn_g; const float* final_g;
    const float* w_in[4]; const float* w_o[4];
    const float* lq1[4]; const float* lk1[4]; const float* lq2[4]; const float* lk2[4]; const float* subln[4];
    const float* qn[4]; const float* kn[4];
    const float* sinks[4];
    const float* w_router; const float* w_gate; const float* w_up; const float* w_down;
    float* out; unsigned char* ws;
};

__device__ __forceinline__ float wave_sum(float v) { return sum64(v); }
__host__ __device__ __forceinline__ int dmap_axial(int u) { const int t = u >> 5, i = u & 31; return i < 16 ? i + 16 * t : 32 + (i - 16) + 16 * t; }

__device__ __forceinline__ void transpose_item(const float* W, size_t ldw, int srccol, bf16* WT, int K, int p0, int k0, LAS float* scr, int lane, const float* kscale = nullptr) {
    const float* src = W + (size_t)k0 * ldw + srccol;
    if (kscale) {
#pragma unroll 16
        for (int kk = 0; kk < 64; ++kk) scr[kk * 65 + lane] = __builtin_nontemporal_load(&src[(size_t)kk * ldw]) * kscale[k0 + kk];
    } else {
#pragma unroll 16
    for (int kk = 0; kk < 64; ++kk) scr[kk * 65 + lane] = __builtin_nontemporal_load(&src[(size_t)kk * ldw]);
    }
    LDS_WAIT(); asm volatile("" ::: "memory");
    const int c = lane & 7;
#pragma unroll
    for (int j = 0; j < 8; ++j) { const int n = (lane >> 3) + 8 * j; const LAS float* s = scr + (8 * c) * 65 + n;
        v4u o; o.x = pk2(s[0 * 65], s[1 * 65]); o.y = pk2(s[2 * 65], s[3 * 65]); o.z = pk2(s[4 * 65], s[5 * 65]); o.w = pk2(s[6 * 65], s[7 * 65]);
        *(v4u*)(WT + (size_t)(p0 + n) * K + k0 + 8 * c) = o; }
    LDS_WAIT(); asm volatile("" ::: "memory");
}

__device__ __forceinline__ void transpose_item_f8(const float* W, size_t ldw, int srccol, unsigned char* WT, int KB, int p0, int k0, LAS float* scr, int lane, float scale) {
    const float* src = W + (size_t)k0 * ldw + srccol;
#pragma unroll 16
    for (int kk = 0; kk < 64; ++kk) scr[kk * 65 + lane] = __builtin_nontemporal_load(&src[(size_t)kk * ldw]);
    LDS_WAIT(); asm volatile("" ::: "memory");
    const int c = lane & 3;
#pragma unroll
    for (int j = 0; j < 4; ++j) { const int n = (lane >> 2) + 16 * j; const LAS float* t = scr + (16 * c) * 65 + n;
        v4u o;
        o.x = pg8::cvt4_fp8(t[0 * 65] * scale, t[1 * 65] * scale, t[2 * 65] * scale, t[3 * 65] * scale);
        o.y = pg8::cvt4_fp8(t[4 * 65] * scale, t[5 * 65] * scale, t[6 * 65] * scale, t[7 * 65] * scale);
        o.z = pg8::cvt4_fp8(t[8 * 65] * scale, t[9 * 65] * scale, t[10 * 65] * scale, t[11 * 65] * scale);
        o.w = pg8::cvt4_fp8(t[12 * 65] * scale, t[13 * 65] * scale, t[14 * 65] * scale, t[15 * 65] * scale);
        *(v4u*)(WT + (size_t)(p0 + n) * KB + k0 + 16 * c) = o; }
    LDS_WAIT(); asm volatile("" ::: "memory");
}

__device__ __forceinline__ float row_rstd(const f32x4 (&v)[4]) {
    float s = 0.f;
#pragma unroll
    for (int j = 0; j < 4; ++j) s += (v[j].x * v[j].x + v[j].y * v[j].y) + (v[j].z * v[j].z + v[j].w * v[j].w);
    return __builtin_amdgcn_rsqf(wave_sum(s) * (1.0f / DM) + RMS_EPS);
}
__device__ __forceinline__ void store_row_bf16(bf16* orow, const f32x4 (&v)[4], int lane) {
    v2u* o8 = (v2u*)orow + lane;
#pragma unroll
    for (int j = 0; j < 4; ++j) { v2u w; w.x = pk2(v[j].x, v[j].y); w.y = pk2(v[j].z, v[j].w); o8[64 * j] = w; }
}


__device__ __forceinline__ void acc_fp8x4(f32x4& v, unsigned w) {
    typedef float f32x2 __attribute__((ext_vector_type(2)));
    const f32x2 lo = __builtin_amdgcn_cvt_pk_f32_fp8((int)w, false), hi = __builtin_amdgcn_cvt_pk_f32_fp8((int)w, true);
    v.x += lo.x * YE_INV; v.y += lo.y * YE_INV; v.z += hi.x * YE_INV; v.w += hi.y * YE_INV;
}
__device__ __forceinline__ void load_row_bf16(f32x4 (&v)[4], const bf16* row, int lane) {
    const v2u* r8 = (const v2u*)row + lane;
#pragma unroll
    for (int j = 0; j < 4; ++j) { const v2u w = r8[64 * j]; v[j].x = bflo(w.x); v[j].y = bfhi(w.x); v[j].z = bflo(w.y); v[j].w = bfhi(w.y); }
}
__device__ __forceinline__ void add_expert_rows(f32x4 (&v)[4], int sl, unsigned mask, int b, const unsigned char* YE, int lane) {
    while (mask) {
        unsigned w[4][4]; bool ok[4];
#pragma unroll
        for (int k = 0; k < 4; ++k) {
            ok[k] = mask != 0u;
            if (ok[k]) { const int e = __builtin_ctz(mask); mask &= mask - 1u; const int c = __builtin_amdgcn_readlane(sl, e);
                const unsigned* yr = (const unsigned*)(YE + ((size_t)((e * 32 + b) * 256 + c)) * DM) + lane;
#pragma unroll
                for (int j = 0; j < 4; ++j) w[k][j] = yr[64 * j]; }
        }
#pragma unroll
        for (int k = 0; k < 4; ++k)
            if (ok[k]) {
#pragma unroll
                for (int j = 0; j < 4; ++j) acc_fp8x4(v[j], w[k][j]); }
    }
}

__device__ __forceinline__ void load_combine2(f32x4 (&va)[4], f32x4 (&vb)[4], const bf16* xa, const bf16* xb, int sla, int slb, int ba, int bb, const unsigned char* YE, int lane) {
    unsigned ma = (unsigned)__ballot(sla >= 0) & 0xffffu, mb = (unsigned)__ballot(slb >= 0) & 0xffffu;
#pragma unroll
    for (int j = 0; j < 4; ++j) { va[j] = (f32x4){0.f, 0.f, 0.f, 0.f}; vb[j] = va[j]; }
    v2u xra[4], xrb[4];
#pragma unroll
    for (int j = 0; j < 4; ++j) { xra[j] = ((const v2u*)xa + lane)[64 * j]; xrb[j] = ((const v2u*)xb + lane)[64 * j]; }
    unsigned wa[3][4], wb[3][4]; bool oa[3], ob[3];
#pragma unroll
    for (int k = 0; k < 3; ++k) { oa[k] = ma != 0u;
        if (oa[k]) { const int e = __builtin_ctz(ma); ma &= ma - 1u; const int c = __builtin_amdgcn_readlane(sla, e); const unsigned* yr = (const unsigned*)(YE + ((size_t)((e * 32 + ba) * 256 + c)) * DM) + lane;
#pragma unroll
            for (int j = 0; j < 4; ++j) wa[k][j] = yr[64 * j]; } }
#pragma unroll
    for (int k = 0; k < 3; ++k) { ob[k] = mb != 0u;
        if (ob[k]) { const int e = __builtin_ctz(mb); mb &= mb - 1u; const int c = __builtin_amdgcn_readlane(slb, e); const unsigned* yr = (const unsigned*)(YE + ((size_t)((e * 32 + bb) * 256 + c)) * DM) + lane;
#pragma unroll
            for (int j = 0; j < 4; ++j) wb[k][j] = yr[64 * j]; } }
#pragma unroll
    for (int j = 0; j < 4; ++j) { va[j].x = bflo(xra[j].x); va[j].y = bfhi(xra[j].x); va[j].z = bflo(xra[j].y); va[j].w = bfhi(xra[j].y);
                                  vb[j].x = bflo(xrb[j].x); vb[j].y = bfhi(xrb[j].x); vb[j].z = bflo(xrb[j].y); vb[j].w = bfhi(xrb[j].y); }
#pragma unroll
    for (int k = 0; k < 3; ++k) if (oa[k]) {
#pragma unroll
        for (int j = 0; j < 4; ++j) acc_fp8x4(va[j], wa[k][j]); }
#pragma unroll
    for (int k = 0; k < 3; ++k) if (ob[k]) {
#pragma unroll
        for (int j = 0; j < 4; ++j) acc_fp8x4(vb[j], wb[k][j]); }
    if (ma) add_expert_rows(va, sla, ma, ba, YE, lane);
    if (mb) add_expert_rows(vb, slb, mb, bb, YE, lane);
}


#define XB_TMO      128
#define XB_XCNT(j)  (256  + 64 * (j))
#define XB_XSUB(j)  (1280 + 64 * (j))
#define XB_XGEN(j)  (2304 + 64 * (j))
#define XB_TOP      3328
#define XB_TOPGEN   3392
#define XCD_BAR_WORDS 3456
#define XB_SPIN_CAP (1u << 18)

__device__ __forceinline__ unsigned xb_ld(unsigned* p)              { return __hip_atomic_load(p, __ATOMIC_RELAXED, __HIP_MEMORY_SCOPE_AGENT); }
__device__ __forceinline__ unsigned xb_add(unsigned* p, unsigned v) { return __hip_atomic_fetch_add(p, v, __ATOMIC_RELAXED, __HIP_MEMORY_SCOPE_AGENT); }
__device__ __forceinline__ unsigned xb_xcc_id() { return (unsigned)__builtin_amdgcn_s_getreg((3 << 11) | 20) & 0xFu; }
#define XB_SPIN(cond, bar) do { unsigned _sp = 0; while (cond) { __builtin_amdgcn_s_sleep(1); \
    if ((++_sp & 255u) == 0u) { if (xb_ld(&(bar)[XB_TMO])) break; if (_sp > XB_SPIN_CAP) { atomicAdd(&(bar)[XB_TMO], 1u); break; } } } } while (0)

struct XcdBarrier {
    unsigned* bar; unsigned x;
    volatile LAS unsigned* st;
};

__device__ __forceinline__ XcdBarrier xcd_barrier_post(unsigned* bar, volatile LAS unsigned* st) {
    XcdBarrier b; b.bar = bar; b.x = xb_xcc_id(); b.st = st;
    if (threadIdx.x == 0) st[2] = xb_add(&bar[XB_XCNT(b.x)], 1u);
    return b;
}
__device__ __forceinline__ void xcd_barrier_complete(unsigned* bar, unsigned x, unsigned& nloc, unsigned& nx, unsigned& even) {
    const unsigned G = gridDim.x * gridDim.y * gridDim.z;
    unsigned sum, cnt, mine, sp = 0u, c32;
    for (;;) {
        sum = 0u; cnt = 0u; mine = 0u; c32 = 0u;
#pragma unroll
        for (unsigned j = 0; j < 16; ++j) { const unsigned c = xb_ld(&bar[XB_XCNT(j)]); sum += c; cnt += (c > 0u) ? 1u : 0u; c32 += (j < 8u && c == 32u) ? 1u : 0u; mine = (j == x) ? c : mine; }
        if (sum == G) break;
        __builtin_amdgcn_s_sleep(1);
        if ((++sp & 255u) == 0u) { if (xb_ld(&bar[XB_TMO])) break; if (sp > XB_SPIN_CAP) { atomicAdd(&bar[XB_TMO], 1u); break; } }
    }
    nloc = mine > 0u ? mine : 1u; nx = cnt > 0u ? cnt : 1u;
    even = (sum == G && G == 256u && c32 == 8u) ? 1u : 0u;
}

__device__ __forceinline__ void xcd_barrier(const XcdBarrier& b, bool local_only = false) {
    asm volatile("s_waitcnt vmcnt(0)" ::: "memory");
    __syncthreads();
    if (threadIdx.x == 0) {
        size_t zb_ = 0; asm volatile("" : "+s"(zb_)); unsigned* bar = b.bar + zb_; unsigned bx_ = b.x; asm volatile("" : "+s"(bx_));
        __builtin_amdgcn_s_waitcnt(0);
        unsigned nloc = b.st[0], nx = b.st[1];
        const unsigned old = xb_add(&bar[XB_XSUB(bx_)], 1u);
        const unsigned gen = old / nloc;
        if (old + 1u == (gen + 1u) * nloc) {
            __builtin_amdgcn_fence(__ATOMIC_RELEASE, "agent");
            asm volatile("s_waitcnt vmcnt(0)" ::: "memory");
            if (!local_only) {
            const unsigned og = xb_add(&bar[XB_TOP], 1u);
            const unsigned tg = og / nx;
            if (og + 1u == (tg + 1u) * nx) xb_add(&bar[XB_TOPGEN], 1u);
            else XB_SPIN(xb_ld(&bar[XB_TOPGEN]) == tg, bar);
            }
            __builtin_amdgcn_fence(__ATOMIC_ACQUIRE, "agent");
            xb_add(&bar[XB_XGEN(bx_)], 1u);
            asm volatile("s_waitcnt vmcnt(0)" ::: "memory");
        } else {
            XB_SPIN(xb_ld(&bar[XB_XGEN(bx_)]) == gen, bar);
            __builtin_amdgcn_fence(__ATOMIC_ACQUIRE, "agent");
            asm volatile("s_waitcnt vmcnt(0)" ::: "memory");
        }
    }
    __syncthreads();
}


__global__ void __launch_bounds__(NWAVES * 64, 2) mk_fwd(Args args) {
    extern __shared__ __attribute__((aligned(16))) unsigned char lds[];
    LAS unsigned char* ldsl = (LAS unsigned char*)lds;
    const int G = gridDim.x;
    const int wave0 = __builtin_amdgcn_readfirstlane((int)threadIdx.x >> 6);
    const int NGW = G * NWAVES;
#define PHASE_IDS() const int tid = fresh_tid(wave0), lane = tid & 63, wave = __builtin_amdgcn_readfirstlane(tid >> 6), gw = vcu * NWAVES + wave; (void)gw; (void)lane; (void)tid; size_t zero_ = 0; asm volatile("" : "+s"(zero_)); unsigned char* ws = args.ws + zero_; float* XR = args.out + zero_; (void)XR
    unsigned* ctl = (unsigned*)(args.ws + WS_CTL);
#define tab ((float*)(ws + WS_TAB))
#define gperm ((float*)(ws + WS_MISC))
#define AFF ((float*)(ws + WS_AFF))
#define GATE ((float*)(ws + WS_GATE))
#define SLOT ((short*)(ws + WS_SLOT))
#define TOK ((int*)(ws + WS_TOK))
#define H ((bf16*)(ws + WS_H))
#define QKV ((bf16*)(ws + WS_BIG))
#define ATT ((bf16*)(ws + WS_ATT))
#define HID8 (ws + WS_HID)
#define XE ((bf16*)(ws + WS_XE))
#define XE8 (ws + WS_XE)
#define H8 (ws + WS_H8)
#define XB ((bf16*)(ws + WS_XB))
#define RSTD ((float*)(ws + WS_MISC + 65536))
    for (int u = threadIdx.x; u < (LDS_BYTES - LDSCTL_OFF) / 4; u += NWAVES * 64) ((LAS unsigned*)(ldsl + LDSCTL_OFF))[u] = 0u;
    __syncthreads();
    volatile LAS unsigned* MISC = (volatile LAS unsigned*)(ldsl + MISC_OFF);
    XcdBarrier bar = xcd_barrier_post(ctl + CW_BAR, MISC + 8);
    if (threadIdx.x == 0) { unsigned nloc_, nx_, even_; xcd_barrier_complete(bar.bar, bar.x, nloc_, nx_, even_); MISC[8] = nloc_; MISC[9] = nx_; MISC[11] = even_; }
    __syncthreads();
    const int gmode = __builtin_amdgcn_readfirstlane((int)MISC[11]);
    const int bx = gmode ? __builtin_amdgcn_readfirstlane((int)MISC[10]) * 8 + (int)bar.x : (int)blockIdx.x;
    const int vcu = (G % 8 == 0) ? (bx % 8) * (G / 8) + bx / 8 : bx;
#define PHASE_ON() true
    if (PROBE_TYPE >= 0 && blockIdx.x == 0 && threadIdx.x == 0) __hip_atomic_store(ctl + 2049, (unsigned)__builtin_amdgcn_s_memrealtime(), __ATOMIC_RELAXED, __HIP_MEMORY_SCOPE_AGENT);
#ifndef EN_P0
#define EN_P0 1
#endif
#ifndef EN_N1
#define EN_N1 1
#endif
#ifndef EN_G1
#define EN_G1 1
#endif
#ifndef EN_AT
#define EN_AT 1
#endif
#ifndef EN_ATA
#define EN_ATA 1
#endif
#ifndef EN_ATB
#define EN_ATB 1
#endif
#ifndef EN_G2
#define EN_G2 1
#endif
#ifndef EN_N2
#define EN_N2 1
#endif
#ifndef EN_TK
#define EN_TK 1
#endif
#ifndef EN_G3
#define EN_G3 1
#endif
#ifndef EN_G4
#define EN_G4 1
#endif
#ifndef EN_FIN
#define EN_FIN 1
#endif
#define PHASE_END(KIND) do { xcd_barrier(bar, (KIND) != 0 && gmode != 0); if (PROBE_TYPE >= 0 && blockIdx.x == 0 && threadIdx.x == 0) { const unsigned t_ = (unsigned)__builtin_amdgcn_s_memrealtime(); \
    const unsigned p_ = __hip_atomic_load(ctl + 2049, __ATOMIC_RELAXED, __HIP_MEMORY_SCOPE_AGENT); __hip_atomic_store(ctl + 2049, t_, __ATOMIC_RELAXED, __HIP_MEMORY_SCOPE_AGENT); \
    if ((KIND) == PROBE_TYPE) __hip_atomic_fetch_add(ctl + 2048, t_ - p_, __ATOMIC_RELAXED, __HIP_MEMORY_SCOPE_AGENT); } } while (0)

    if (EN_P0 && PHASE_ON()) {
            PHASE_IDS();
        for (int i = gw * 64 + lane; i < 2 * SEQ * 32; i += NGW * 64) {
            const int which = i >> 16, s = (i >> 5) & 2047, f = i & 31; float ang;
            if (which == 0) ang = (float)s * exp2f(-(float)f * (13.287712379549449f / 32.0f));
            else ang = (float)(f < 16 ? (s >> 6) : (s & 63)) * exp2f(-(float)(f & 15) * (13.287712379549449f / 16.0f));
            tab[which * 131072 + s * 32 + f] = cosf(ang); tab[which * 131072 + 65536 + s * 32 + f] = sinf(ang);
        }
        if (gw == 0) { gperm[lane] = args.qn[1][dmap_axial(lane)]; gperm[64 + lane] = args.kn[1][dmap_axial(lane)]; }
        LAS float* scr = (LAS float*)(ldsl + wave * 16640);
        {
            constexpr int IT_A = 16 * 48 + 256, IT_B = 16 * 24 + 256, IT_ALL = 2 * IT_A + 2 * IT_B;
            for (int it = gw; it < IT_ALL; it += NGW) {
                int l, r = it;
                if (r < IT_A) l = 0; else { r -= IT_A; if (r < IT_B) l = 1; else { r -= IT_B; if (r < IT_B) l = 2; else { r -= IT_B; l = 3; } } }
                const int m = l % 3, n1 = (m == 0) ? 3072 : 1536, nin = 16 * (n1 / 64);
                bf16* wt = (bf16*)(ws + WS_WATT + (size_t)l * WATT_STRIDE);
                if (r < nin) { const int kb = r / (n1 / 64), pb = r % (n1 / 64), p = pb * 64 + lane;
                    const int pn = p >> 8, bj = (p >> 7) & 1, wc = (p >> 5) & 3, i = p & 31, hd = 4 * pn + wc, u = 32 * bj + i;
                    const int d = (m == 1 && hd < 20) ? dmap_axial(u) : u;
                    transpose_item(args.w_in[l], (size_t)n1, 64 * hd + d, wt, DM, pb * 64, kb * 64, scr, lane, args.attn_g + l * DM);
                } else { r -= nin; const int kb = r / 16, pb = r % 16;
                    transpose_item(args.w_o[l], (size_t)DM, pb * 64 + lane, (bf16*)((unsigned char*)wt + WATT_O), DM, pb * 64, kb * 64, scr, lane); }
            }
        }
        for (int it = gw; it < DEPTH * NE * 1536; it += NGW) {
            const int le = it / 1536, r = it % 1536, l = le >> 4, e = le & 15;
            unsigned char* wgu = ws + WS_WMOE + (size_t)l * WMOE_STRIDE + (size_t)e * 4096 * DM;
            unsigned char* wd = ws + WS_WMOE + (size_t)l * WMOE_STRIDE + WMOE_D + (size_t)e * DM * FF;
            if (r < 1024) { const int kb = r >> 6, pb = r & 63, bjj = (pb >> 1) & 1;
                const float* srcm = (bjj ? args.w_up : args.w_gate) + (size_t)le * DM * FF;
                transpose_item_f8(srcm, (size_t)FF, 128 * (pb >> 2) + 64 * (pb & 1) + lane, wgu, DM, pb * 64, kb * 64, scr, lane, pg8::W8_SCALE);
            } else { const int r2 = r - 1024, kb = r2 >> 4, pb = r2 & 15;
                transpose_item_f8(args.w_down + (size_t)le * FF * DM, (size_t)DM, 256 * (pb >> 2) + 64 * (2 * (pb & 1) + (lane >> 5)) + 32 * ((pb >> 1) & 1) + (lane & 31), wd, FF, pb * 64, kb * 64, scr, lane, pg8::W8_SCALE); }
        }
        {
            f32x4 g[4];
#pragma unroll
            for (int j = 0; j < 4; ++j) g[j] = ((const f32x4*)args.attn_g)[lane + 64 * j];
            for (int m = gw; m < NTOK; m += NGW) {
                const f32x4* xr = (const f32x4*)(args.x + (size_t)m * DM) + lane; f32x4 v[4];
#pragma unroll
                for (int j = 0; j < 4; ++j) v[j] = __builtin_nontemporal_load(&xr[64 * j]);
                store_row_bf16(XB + (size_t)m * DM, v, lane);
                const float rstd = row_rstd(v);
                if (lane == 0) RSTD[m] = rstd;
            }
        }
    }
    PHASE_END(0);

    for (int layer = 0; layer < DEPTH; ++layer) {
        const int mix = layer % 3;
        const int n1 = (mix == 0) ? 3072 : 1536;
#define Win_t ((const bf16*)(ws + WS_WATT + (size_t)layer * WATT_STRIDE))
#define Wo_t ((const bf16*)(ws + WS_WATT + (size_t)layer * WATT_STRIDE + WATT_O))
#define Wgu8 (ws + WS_WMOE + (size_t)layer * WMOE_STRIDE)
#define Wd8 (ws + WS_WMOE + (size_t)layer * WMOE_STRIDE + WMOE_D)

        if (layer > 0) {
            if (EN_N1 && PHASE_ON()) {
            PHASE_IDS();
                f32x4 g[4];
#pragma unroll
                for (int j = 0; j < 4; ++j) g[j] = ((const f32x4*)(args.attn_g + layer * DM))[lane + 64 * j];
              for (int rbk = vcu; rbk < NTOK / 256; rbk += G) {
                const int mbeg = rbk * 256 + wave, mend = rbk * 256 + 256;
                int sla = (lane < 16) ? (int)SLOT[(size_t)mbeg * 16 + lane] : -1, slb = (lane < 16) ? (int)SLOT[(size_t)(mbeg + 8) * 16 + lane] : -1;
                for (int m = mbeg; m < mend; m += 16) {
                    const int m2 = m + 8;
                    const int mn = m + 16; int sna = -1, snb = -1;
                    if (mn < mend) { sna = (lane < 16) ? (int)SLOT[(size_t)mn * 16 + lane] : -1; snb = (lane < 16) ? (int)SLOT[(size_t)(mn + 8) * 16 + lane] : -1; }
                    f32x4 va[4], vb[4];
                    load_combine2(va, vb, XB + (size_t)m * DM, XB + (size_t)m2 * DM, sla, slb, m >> 11, m2 >> 11, XE8, lane);
                    store_row_bf16(XB + (size_t)m * DM, va, lane);
                    const float ra = row_rstd(va);
                    if (lane == 0) RSTD[m] = ra;
                    if (m2 != m) {
                        store_row_bf16(XB + (size_t)m2 * DM, vb, lane);
                        const float rb = row_rstd(vb);
                        if (lane == 0) RSTD[m2] = rb;
                    }
                    sla = sna; slb = snb;
                }
              }
            }
            PHASE_END(1);
        }

        if (EN_G1 && PHASE_ON()) {
            PHASE_IDS();
              pg8::Gemm g{XB, Win_t, NTOK, n1, DM}; pg8::StaticOrder S; S.init(NTOK, n1, G, bx);
            const float* tc = tab + (mix == 1 ? 131072 : 0);
            LAS float* gl = (LAS float*)(ldsl + RING_BYTES);
            if (mix == 1 && tid < 128) gl[tid] = gperm[tid];
            __syncthreads();
            pg8::EpiQKV E{QKV, 3072  , tc, tc + 65536, (mix == 0) ? 8 : 5, 4, (mix == 1) ? gl : nullptr, (mix == 1) ? gl + 64 : nullptr, QSCALE, RSTD};
            pg8::gemm_phase<pg8::EpiQKV, pg8::StaticOrder, true, true>(ldsl, g, S, E, wave0);
        }
        PHASE_END(2);

        if (EN_AT && PHASE_ON()) {
            PHASE_IDS();
          for (int rb = vcu; rb < NTOK / 256; rb += G) {
            const int b = rb >> 3, qb = rb & 7;
            const int tid = fresh_tid(wave0), lane = tid & 63, wave = __builtin_amdgcn_readfirstlane(tid >> 6); (void)lane; (void)wave; (void)tid; size_t zs_ = 0; asm volatile("" : "+s"(zs_)); unsigned char* ws = args.ws + zs_;
            if (EN_ATA && mix == 0) {
                const int jl = layer / 3;
                const float lambda_init = (layer == 0) ? 0.2f : 0.55605820416f;
                const float s1 = wave_sum(args.lq1[layer][lane] * args.lk1[layer][lane]), s2 = wave_sum(args.lq2[layer][lane] * args.lk2[layer][lane]);
                const float lam = __uint_as_float(__builtin_amdgcn_readfirstlane(__float_as_uint(__expf(s1) - __expf(s2) + lambda_init))); (void)jl;
                const float* subg = args.subln[layer];
                LAS unsigned* stash = (LAS unsigned*)(ldsl + 75776) + tid;
                for (int h = 0; h < 8; ++h) {
                    const bf16* base = QKV + (size_t)(b * SEQ) * 3072;
                    att::f32x16 o[4];
#pragma unroll 1
                    for (int c = 0; c < 2; ++c) {
                        __syncthreads();
                        ab2::attn_unit128<8, 3072>(o, (const ab2::bf16*)(base + (size_t)(qb * 256) * 3072 + 64 * (2 * h + c)), (const ab2::bf16*)(base + 1024 + 64 * (2 * h + c)), (const ab2::bf16*)(base + 2048 + 128 * h), SEQ / 64, (char*)lds, wave0);
                        if (c == 0) {
#pragma unroll
                            for (int d = 0; d < 4; ++d)
#pragma unroll
                                for (int q = 0; q < 8; ++q) stash[(d * 8 + q) * 512] = att::cvtpk(o[d][2 * q], o[d][2 * q + 1]);
                        }
                    }
                    float ss[16], gs[4];
#pragma unroll
                    for (int d = 0; d < 4; ++d) gs[d] = subg[32 * d + (lane & 31)] * (1.0f - lambda_init);
#pragma unroll
                    for (int r = 0; r < 16; ++r) ss[r] = 0.f;
#pragma unroll
                    for (int d = 0; d < 4; ++d)
#pragma unroll
                        for (int q = 0; q < 8; ++q) { const unsigned w = stash[(d * 8 + q) * 512];
                            const float a = bflo(w) - lam * o[d][2 * q], bq = bfhi(w) - lam * o[d][2 * q + 1];
                            o[d][2 * q] = a; o[d][2 * q + 1] = bq; ss[2 * q] += a * a; ss[2 * q + 1] += bq * bq; }
#pragma unroll
                    for (int r = 0; r < 16; ++r) { const float s = sum32(ss[r]);
                        const float rstd = __builtin_amdgcn_rsqf(s * (1.0f / 128.0f) + RMS_EPS);
#pragma unroll
                        for (int d = 0; d < 4; ++d) o[d][r] *= rstd * gs[d]; }
                    {
                        const int t2 = fresh_tid(wave0), l2 = t2 & 63, w2 = __builtin_amdgcn_readfirstlane(t2 >> 6);
                        LAS unsigned char* stg = ldsl + 75776 + w2 * 256;
                        att::stage_o<4>(o, stg, 2048, l2);
                        asm volatile("s_waitcnt lgkmcnt(0)" ::: "memory");
                        const LAS unsigned char* sp = stg + (l2 >> 4) * 2048 + (l2 & 15) * 16;
                        bf16* op = ATT + (size_t)(b * SEQ + qb * 256 + w2 * 32 + (l2 >> 4)) * DM + 128 * h + (l2 & 15) * 8;
#pragma unroll
                        for (int i = 0; i < 8; ++i) { const v4u v = *(const LAS v4u*)(sp + i * 8192); *(v4u*)(op + (size_t)i * 4 * DM) = v; }
                        asm volatile("s_waitcnt lgkmcnt(0)" ::: "memory");
                    }
                }
            } else if (EN_ATB && mix == 1) {
                bool pre = false;
                for (int hq = 0; hq < 16; ++hq) { const int kvh = hq >> 2, hn = hq + 1, kvn = hn >> 2;
                    const bf16* base = QKV + (size_t)(b * SEQ) * 3072;
                    __syncthreads();
                    pre = ab2::attn_unit<8, 3072, 1024, false>(pre, (const ab2::bf16*)(base + (size_t)(qb * 256) * 3072 + 64 * hq), (const ab2::bf16*)(base + 1024 + 64 * kvh), (const ab2::bf16*)(base + 1280 + 64 * kvh),
                                                         (ab2::bf16*)(ATT + (size_t)(b * SEQ + qb * 256) * DM + 64 * hq), SEQ / 64, 0, 0, -__builtin_inff(), (char*)lds, wave0, 0.f,
                                                         (const ab2::bf16*)(base + (size_t)(qb * 256) * 3072 + 64 * hn), (const ab2::bf16*)(base + 1024 + 64 * kvn), (const ab2::bf16*)(base + 1280 + 64 * kvn), hn < 16);
                }
            } else if (EN_ATB) {
                bool pre = false;
                for (int u16 = 0; u16 < 16; ++u16) { const int hp = u16 >> 1, qh = u16 & 1, hq = 2 * hp, kvh = hq >> 2, q0 = qb * 256 + qh * 128;
                    const int un = u16 + 1, hqn = 2 * (un >> 1), kvn = hqn >> 2, q0n = qb * 256 + (un & 1) * 128, klon = (q0n - 128) < 0 ? 0 : q0n - 128;
                    const bf16* base = QKV + (size_t)(b * SEQ) * 3072;
                    __syncthreads();
                    const int klo = (q0 - 128) < 0 ? 0 : q0 - 128, khi = (q0 + 256) > SEQ ? SEQ : q0 + 256;
                    pre = ab2::attn_unit<8, 3072, 1024, true, true>(pre, (const ab2::bf16*)(base + (size_t)q0 * 3072 + 64 * hq), (const ab2::bf16*)(base + (size_t)klo * 3072 + 1024 + 64 * kvh), (const ab2::bf16*)(base + (size_t)klo * 3072 + 1280 + 64 * kvh),
                                                        (ab2::bf16*)(ATT + (size_t)(b * SEQ + q0) * DM + 64 * hq), (khi - klo) / 64, q0, klo, args.sinks[layer][hq] * 1.4426950408889634f, (char*)lds, wave0,
                                                        args.sinks[layer][hq + 1] * 1.4426950408889634f,
                                                        (const ab2::bf16*)(base + (size_t)q0n * 3072 + 64 * hqn), (const ab2::bf16*)(base + (size_t)klon * 3072 + 1024 + 64 * kvn), (const ab2::bf16*)(base + (size_t)klon * 3072 + 1280 + 64 * kvn), un < 16);
                }
            }
          }
        }
        PHASE_END(3 + mix);

        if (EN_G2 && PHASE_ON()) {
            PHASE_IDS();
            pg8::Gemm g{ATT, Wo_t, NTOK, DM, DM}; pg8::StaticOrder S; S.init(NTOK, DM, G, bx);
            pg8::EpiResBf16 E{XB, DM};
            pg8::gemm_phase<pg8::EpiResBf16, pg8::StaticOrder, true, true>(ldsl, g, S, E, wave0);
        }
        PHASE_END(6);

        if (EN_N2 && PHASE_ON()) {
            PHASE_IDS();
            LAS float* wr = (LAS float*)ldsl;
            const float* wsrc = args.w_router + (size_t)layer * DM * NE;
            for (int i4 = tid; i4 < DM * NE / 4; i4 += NWAVES * 64) { const f32x4 w = ((const f32x4*)wsrc)[i4]; const int col = i4 >> 2, e0 = (i4 & 3) * 4;
                wr[(e0 + 0) * DM + col] = w.x; wr[(e0 + 1) * DM + col] = w.y; wr[(e0 + 2) * DM + col] = w.z; wr[(e0 + 3) * DM + col] = w.w; }
            __syncthreads();
            f32x4 g[4];
#pragma unroll
            for (int j = 0; j < 4; ++j) g[j] = ((const f32x4*)(args.ffn_g + layer * DM))[lane + 64 * j];
            const bool hb3 = (lane & 8) != 0, hb2 = (lane & 4) != 0, hb1 = (lane & 2) != 0, hb0 = (lane & 1) != 0;
            for (int rbk = vcu; rbk < NTOK / 256; rbk += G)
            for (int m0 = rbk * 256 + wave * 4; m0 < rbk * 256 + 256; m0 += NWAVES * 4) {
                f32x4 v[4][4];
#pragma unroll
                for (int t = 0; t < 4; ++t) load_row_bf16(v[t], XB + (size_t)(m0 + t) * DM, lane);
#pragma unroll
                for (int t = 0; t < 4; ++t) { const float rstd = row_rstd(v[t]); unsigned* o4 = (unsigned*)(H8 + (size_t)(m0 + t) * DM) + lane;
#pragma unroll
                    for (int j = 0; j < 4; ++j) { v[t][j] = v[t][j] * rstd * g[j]; o4[64 * j] = pg8::cvt4_fp8(v[t][j].x, v[t][j].y, v[t][j].z, v[t][j].w); } }
                typedef float f32x2 __attribute__((ext_vector_type(2)));
                f32x2 vp[2][4][4];
#pragma unroll
                for (int p = 0; p < 2; ++p)
#pragma unroll
                    for (int j = 0; j < 4; ++j)
#pragma unroll
                        for (int c = 0; c < 4; ++c) vp[p][j][c] = (f32x2){v[2 * p][j][c], v[2 * p + 1][j][c]};
                float acc[4][16];
#pragma unroll
                for (int e = 0; e < 16; ++e) {
                    f32x2 a2[2] = {(f32x2){0.f, 0.f}, (f32x2){0.f, 0.f}};
#pragma unroll
                    for (int j = 0; j < 4; ++j) { const f32x4 w = *(const LAS f32x4*)(wr + e * DM + 256 * j + 4 * lane);
#pragma unroll
                        for (int p = 0; p < 2; ++p)
#pragma unroll
                            for (int c = 0; c < 4; ++c) a2[p] = __builtin_elementwise_fma(vp[p][j][c], (f32x2){w[c], w[c]}, a2[p]); }
                    acc[0][e] = a2[0].x; acc[1][e] = a2[0].y; acc[2][e] = a2[1].x; acc[3][e] = a2[1].y;
                    if (e & 1) __builtin_amdgcn_sched_barrier(0);
                }
                float a8[4][8], b4[4][4], c2[4][2], d1[4], e2[2];
#pragma unroll
                for (int t = 0; t < 4; ++t)
#pragma unroll
                    for (int e = 0; e < 8; ++e) { auto r = __builtin_amdgcn_permlane32_swap(__float_as_uint(acc[t][e]), __float_as_uint(acc[t][e + 8]), false, false); a8[t][e] = __uint_as_float(r[0]) + __uint_as_float(r[1]); }
#pragma unroll
                for (int t = 0; t < 4; ++t)
#pragma unroll
                    for (int e = 0; e < 4; ++e) { auto r = __builtin_amdgcn_permlane16_swap(__float_as_uint(a8[t][e]), __float_as_uint(a8[t][e + 4]), false, false); b4[t][e] = __uint_as_float(r[0]) + __uint_as_float(r[1]); }
#pragma unroll
                for (int t = 0; t < 4; ++t)
#pragma unroll
                    for (int e = 0; e < 2; ++e) { const float keep = hb3 ? b4[t][e + 2] : b4[t][e], send = hb3 ? b4[t][e] : b4[t][e + 2]; c2[t][e] = keep + dpp_mirror(send); }
#pragma unroll
                for (int t = 0; t < 4; ++t) { const float keep = hb2 ? c2[t][1] : c2[t][0], send = hb2 ? c2[t][0] : c2[t][1]; d1[t] = keep + dpp_hmirror(send); }
#pragma unroll
                for (int t = 0; t < 2; ++t) { const float keep = hb1 ? d1[t + 2] : d1[t], send = hb1 ? d1[t] : d1[t + 2]; e2[t] = keep + dpp_xor2(send); }
                const float lg = (hb0 ? e2[1] : e2[0]) + dpp_xor1(hb0 ? e2[0] : e2[1]);
                float mx = fmaxf(lg, dpp_ror4(lg)); mx = fmaxf(mx, dpp_ror8(mx));
                { auto r = __builtin_amdgcn_permlane16_swap(__float_as_uint(mx), __float_as_uint(mx), false, false); mx = fmaxf(__uint_as_float(r[0]), __uint_as_float(r[1])); }
                { auto r = __builtin_amdgcn_permlane32_swap(__float_as_uint(mx), __float_as_uint(mx), false, false); mx = fmaxf(__uint_as_float(r[0]), __uint_as_float(r[1])); }
                const float p = __expf(lg - mx);
                float sm = p + dpp_ror4(p); sm += dpp_ror8(sm); sm = sum_swap32(sum_swap16(sm));
                AFF[((size_t)(m0 >> 11) * 16 + (lane >> 2)) * SEQ + (m0 & 2047) + (lane & 3)] = p / sm;
            }
            __syncthreads();
        }
        PHASE_END(7);

        if (EN_TK && PHASE_ON()) {
            PHASE_IDS();
            LAS unsigned* red = (LAS unsigned*)ldsl;
            for (int pi = vcu; pi < NTOK / 256; pi += G)
            for (int ee = 0; ee < 2; ++ee) {
                const int b = pi >> 3, e = 2 * (pi & 7) + ee, pair = b * 16 + e;
                const f32x4 av = ((const f32x4*)(AFF + (size_t)pair * SEQ))[tid];
                const unsigned u0 = __float_as_uint(av.x), u1 = __float_as_uint(av.y), u2 = __float_as_uint(av.z), u3 = __float_as_uint(av.w);
                unsigned prefix = 0u;
                for (int bit = 30; bit >= 0; --bit) {
                    const unsigned cand = prefix | (1u << bit);
                    const unsigned cw = (unsigned)__popcll(__ballot(u0 >= cand)) + (unsigned)__popcll(__ballot(u1 >= cand)) + (unsigned)__popcll(__ballot(u2 >= cand)) + (unsigned)__popcll(__ballot(u3 >= cand));
                    LAS unsigned* rb = red + (bit & 1) * 8;
                    if (lane == 0) rb[wave] = cw;
                    __syncthreads();
                    unsigned tot = 0;
#pragma unroll
                    for (int w = 0; w < 8; ++w) tot += rb[w];
                    if (tot >= (unsigned)CAP) prefix = cand;
                }
                const unsigned T = prefix;
                const unsigned g0 = u0 > T, g1 = u1 > T, g2 = u2 > T, g3 = u3 > T, q0 = u0 == T, q1 = u1 == T, q2 = u2 == T, q3 = u3 == T;
                const unsigned long long bg0 = __ballot(g0), bg1 = __ballot(g1), bg2 = __ballot(g2), bg3 = __ballot(g3), bq0 = __ballot(q0), bq1 = __ballot(q1), bq2 = __ballot(q2), bq3 = __ballot(q3);
#define MBC(m) __builtin_amdgcn_mbcnt_hi((unsigned)((m) >> 32), __builtin_amdgcn_mbcnt_lo((unsigned)(m), 0u))
                const unsigned pre = (MBC(bg0) + MBC(bg1) + MBC(bg2) + MBC(bg3)) | ((MBC(bq0) + MBC(bq1) + MBC(bq2) + MBC(bq3)) << 16);
#undef MBC
                const unsigned wtot = (unsigned)(__popcll(bg0) + __popcll(bg1) + __popcll(bg2) + __popcll(bg3)) | ((unsigned)(__popcll(bq0) + __popcll(bq1) + __popcll(bq2) + __popcll(bq3)) << 16);
                LAS unsigned* tot8 = red + 16;
                __syncthreads();
                if (lane == 0) tot8[wave] = wtot;
                __syncthreads();
                unsigned woff = 0, all = 0;
#pragma unroll
                for (int w = 0; w < 8; ++w) { const unsigned t = tot8[w]; all += t; woff += (w < wave) ? t : 0u; }
                const unsigned excl = pre + woff;
                int bg = (int)(excl & 0xffffu), be = (int)(excl >> 16); const int ngt = (int)(all & 0xffffu), need = CAP - ngt;
                const size_t rowbase = (size_t)(e * 32 + b) * 256;
                int sl[4]; const unsigned gg[4] = {g0, g1, g2, g3}, qq[4] = {q0, q1, q2, q3}; const float vv[4] = {av.x, av.y, av.z, av.w};
#pragma unroll
                for (int q = 0; q < 4; ++q) { int s = -1;
                    if (gg[q]) s = bg++; else if (qq[q]) { const int r = be++; s = (r < need) ? ngt + r : -1; }
                    sl[q] = s;
                    if (s >= 0) { TOK[rowbase + s] = b * SEQ + 4 * tid + q; GATE[rowbase + s] = vv[q]; }
                    SLOT[((size_t)(b * SEQ + 4 * tid + q)) * 16 + e] = (short)s; }
                __syncthreads();
            }
        }
        PHASE_END(8);

        if (EN_G3 && PHASE_ON()) {
            PHASE_IDS();
              pg8::Gemm g{(const pg8::bf16_t*)H8, (const pg8::bf16_t*)Wgu8, NROWS_E, NE * 4096, DM, TOK}; pg8::GroupedOrder<16> S; S.init(G, bx);
            pg8::EpiSwiGLU8 E{HID8, FF};
            pg8::gemm_phase<pg8::EpiSwiGLU8, pg8::GroupedOrder<16>, true, true, true, true>(ldsl, g, S, E, wave0);
        }
        PHASE_END(9);

        if (EN_G4 && PHASE_ON()) {
            PHASE_IDS();
            pg8::Gemm g{(const pg8::bf16_t*)HID8, (const pg8::bf16_t*)Wd8, NROWS_E, NE * DM, FF, nullptr, GATE}; pg8::GroupedOrder<4> S; S.init(G, bx);
            pg8::EpiDown E{XE8, DM, (const LAS float*)(ldsl + pg8::STAGE_BYTES + 9216), YE_SCALE};
            pg8::gemm_phase<pg8::EpiDown, pg8::GroupedOrder<4>, true, true, true, false, true>(ldsl, g, S, E, wave0);
        }
        PHASE_END(10);
    }

    if (EN_FIN && PHASE_ON()) {
            PHASE_IDS();
        f32x4 g[4];
#pragma unroll
        for (int j = 0; j < 4; ++j) g[j] = ((const f32x4*)args.final_g)[lane + 64 * j];
        const float pscale_ = (PROBE_TYPE >= 0) ? 1.0f + (float)__hip_atomic_load(ctl + 2048, __ATOMIC_RELAXED, __HIP_MEMORY_SCOPE_AGENT) * 5e-6f : 1.0f;
      for (int rbk = vcu; rbk < NTOK / 256; rbk += G) {
        const int mbeg = rbk * 256 + wave, mend = rbk * 256 + 256;
        int sla = (lane < 16) ? (int)SLOT[(size_t)mbeg * 16 + lane] : -1, slb = (lane < 16) ? (int)SLOT[(size_t)(mbeg + 8) * 16 + lane] : -1;
        for (int m = mbeg; m < mend; m += 16) {
            const int m2 = m + 8;
            const int mn = m + 16; int sna = -1, snb = -1;
            if (mn < mend) { sna = (lane < 16) ? (int)SLOT[(size_t)mn * 16 + lane] : -1; snb = (lane < 16) ? (int)SLOT[(size_t)(mn + 8) * 16 + lane] : -1; }
            f32x4* xa = (f32x4*)(XR + (size_t)m * DM) + lane; f32x4* xb = (f32x4*)(XR + (size_t)m2 * DM) + lane; f32x4 va[4], vb[4];
            load_combine2(va, vb, XB + (size_t)m * DM, XB + (size_t)m2 * DM, sla, slb, m >> 11, m2 >> 11, XE8, lane);
            const float ra = row_rstd(va);
#pragma unroll
            for (int j = 0; j < 4; ++j) xa[64 * j] = va[j] * ra * g[j] * pscale_;
            if (m2 != m) {
                const float rb = row_rstd(vb);
#pragma unroll
                for (int j = 0; j < 4; ++j) xb[64 * j] = vb[j] * rb * g[j] * pscale_;
            }
            sla = sna; slb = snb;
        }
      }
    }
#undef PHASE_ON
#undef PHASE_END
}

extern "C" void kernel_launch(void* const* d_in, const int* in_sizes, int n_in, void* d_out, int out_size, void* d_ws, size_t ws_size, hipStream_t stream) {
    static int grid = 0;
    if (grid == 0) {
        if (n_in != 22 || in_sizes[0] != NTOK * DM || out_size != NTOK * DM || ws_size < WS_END) {
            fprintf(stderr, "kernel_launch: shape/workspace mismatch (n_in %d, in0 %d, out %d, ws %zu < %zu)\n", n_in, n_in > 0 ? in_sizes[0] : -1, out_size, ws_size, (size_t)WS_END); grid = -1; return; }
        int dev = 0, cus = 0;
        if (hipGetDevice(&dev) != hipSuccess || hipDeviceGetAttribute(&cus, hipDeviceAttributeMultiprocessorCount, dev) != hipSuccess) { grid = -1; return; }
        if (hipFuncSetAttribute((const void*)mk_fwd, hipFuncAttributeMaxDynamicSharedMemorySize, LDS_BYTES) != hipSuccess) { fprintf(stderr, "kernel_launch: hipFuncSetAttribute failed\n"); grid = -1; return; }
        int per_cu = 0;
        if (hipOccupancyMaxActiveBlocksPerMultiprocessor(&per_cu, (const void*)mk_fwd, NWAVES * 64, LDS_BYTES) != hipSuccess || per_cu < 1) fprintf(stderr, "kernel_launch: occupancy query says %d\n", per_cu);
        (void)hipGetLastError();
        grid = cus;
    }
    if (grid < 0) return;
    (void)hipMemsetAsync((char*)d_ws + WS_CTL, 0, CTL_ZERO_BYTES, stream);
    Args a{};
    const float* const* in = (const float* const*)d_in;
    a.x = in[0]; a.attn_g = in[1]; a.ffn_g = in[2]; a.final_g = in[3];
    for (int l = 0; l < 4; ++l) {
        const int m = l % 3, j = l / 3;
        a.w_in[l] = m == 0 ? in[4] + (size_t)j * DM * 3072 : (m == 1 ? in[11] + (size_t)j * DM * 1536 : in[15] + (size_t)j * DM * 1536);
        a.w_o[l] = m == 0 ? in[5] + (size_t)j * DM * DM : (m == 1 ? in[12] + (size_t)j * DM * DM : in[16] + (size_t)j * DM * DM);
        a.lq1[l] = in[6] + j * 64; a.lk1[l] = in[7] + j * 64; a.lq2[l] = in[8] + j * 64; a.lk2[l] = in[9] + j * 64; a.subln[l] = in[10] + j * 128;
        a.qn[l] = in[13]; a.kn[l] = in[14]; a.sinks[l] = in[17];
        if (m != 0) { a.lq1[l] = in[6]; a.lk1[l] = in[7]; a.lq2[l] = in[8]; a.lk2[l] = in[9]; a.subln[l] = in[10]; }
    }
    a.w_router = in[18]; a.w_gate = in[19]; a.w_up = in[20]; a.w_down = in[21];
    a.out = (float*)d_out; a.ws = (unsigned char*)d_ws;
    hipLaunchKernelGGL(mk_fwd, dim3(grid), dim3(NWAVES * 64), LDS_BYTES, stream, a);
    const hipError_t le = hipPeekAtLastError();
    if (le != hipSuccess) fprintf(stderr, "kernel_launch: launch failed: %s\n", hipGetErrorName(le));
}
```
